# Optimizing an MI355X kernel written in HIP

```python
import jax, jax.numpy as jnp
from jax import lax
import numpy as np

D_MODEL = 1024
BATCH = 8
SEQ = 2048
DEPTH = 4

HEAD_DIM = 64
D_MIX = D_MODEL
A_HEADS = 4
B_HEADS = 4
C_GROUPS = 4
D_GROUPS = 4
A_W = A_HEADS * HEAD_DIM
B_W = B_HEADS * HEAD_DIM
C_W = C_GROUPS * HEAD_DIM
D_W = D_GROUPS * HEAD_DIM
N_NSA_KV = 6
CMP_LEN = 32
CMP_STRIDE = 16
CMP_HIDDEN = 256
SEL_BLOCK = 64
SEL_TOPK = 16
SEL_Q_CHUNK = 64
WIN = 512
FORCE = 1e4
DILATED_PAIRS = ((128, 1), (512, 4), (2048, 16))
BAND_BLOCK = 128
POOL_SIZES = (2, 4, 8, 16)
SG_CHUNK = 128
RMS_EPS = 1e-6
LN_EPS = 1e-5
NEG = -1e30
SPLITS = (A_W, N_NSA_KV * HEAD_DIM, 3 * A_HEADS, A_W, 3 * B_W, B_W, C_W, C_W, 2 * D_W, D_W)
D_IN = A_W + N_NSA_KV * HEAD_DIM + 3 * A_HEADS + A_W + 3 * B_W + B_W + C_W + C_W + 2 * D_W + D_W

kernel_name = "hybrid_nsa_dilated_pool_sgu"


def rmsnorm(x, g):
    xf = x.astype(jnp.float32)
    y = xf * lax.rsqrt(jnp.mean(xf * xf, axis=-1, keepdims=True) + RMS_EPS)
    return (y * g.astype(jnp.float32)).astype(x.dtype)


def banded_attention(q, k, v, max_dist):
    Bn, H, L, Dh = q.shape
    Hk = k.shape[1]
    rep = H // Hk
    blk = BAND_BLOCK
    n_prev = -(-max_dist // blk)
    nb = -(-L // blk)
    Lp = nb * blk
    pad = Lp - L
    q = jnp.pad(q, ((0, 0), (0, 0), (0, pad), (0, 0)))
    k = jnp.pad(k, ((0, 0), (0, 0), (n_prev * blk, pad), (0, 0)))
    v = jnp.pad(v, ((0, 0), (0, 0), (n_prev * blk, pad), (0, 0)))
    qb = q.reshape(Bn, Hk, rep, nb, blk, Dh)
    kb = k.reshape(Bn, Hk, nb + n_prev, blk, Dh)
    vb = v.reshape(Bn, Hk, nb + n_prev, blk, Dh)
    kw = jnp.concatenate([kb[:, :, r:r + nb] for r in range(n_prev + 1)], axis=3)
    vw = jnp.concatenate([vb[:, :, r:r + nb] for r in range(n_prev + 1)], axis=3)
    s = jnp.einsum('bgrnqd,bgnkd->bgrnqk', qb, kw).astype(jnp.float32) * (Dh ** -0.5)
    qpos = jnp.arange(nb)[:, None, None] * blk + jnp.arange(blk)[None, :, None]
    kpos = jnp.arange(nb)[:, None, None] * blk + jnp.arange((n_prev + 1) * blk)[None, None, :] - n_prev * blk
    dist = qpos - kpos
    mask = (dist >= 0) & (dist <= max_dist) & (kpos >= 0)
    s = jnp.where(mask, s, NEG)
    lse = jax.nn.logsumexp(s, axis=-1)
    p = jnp.exp(s - lse[..., None])
    o = jnp.einsum('bgrnqk,bgnkd->bgrnqd', p.astype(vw.dtype), vw)
    o = o.reshape(Bn, H, Lp, Dh)[:, :, :L]
    lse = lse.reshape(Bn, H, Lp)[:, :, :L]
    return o, lse


def nsa_mixer(q, kv, gates, pe_cmp, w_cmp1, w_cmp2):
    Bn, S, H, Dh = q.shape
    scale = Dh ** -0.5
    t = jnp.arange(S)
    n_cmp = (S - CMP_LEN) // CMP_STRIDE + 1
    cidx = jnp.arange(n_cmp)[:, None] * CMP_STRIDE + jnp.arange(CMP_LEN)[None, :]
    kvc = kv[:, :, 0:2][:, cidx] + pe_cmp.transpose(1, 0, 2)
    flat = kvc.transpose(0, 1, 3, 2, 4).reshape(Bn, n_cmp, 2, CMP_LEN * Dh)
    hid = jax.nn.gelu(jnp.einsum('bnjf,jfh->bnjh', flat, w_cmp1))
    comp = jnp.einsum('bnjh,jhd->bnjd', hid, w_cmp2)
    k_c, v_c = comp[:, :, 0], comp[:, :, 1]
    s_c = jnp.einsum('bshd,bnd->bhsn', q, k_c).astype(jnp.float32) * scale
    valid_c = cidx[:, -1][None, :] <= t[:, None]
    p_c = jax.nn.softmax(jnp.where(valid_c, s_c, NEG), axis=-1) * valid_c
    o_cmp = jnp.einsum('bhsn,bnd->bshd', p_c.astype(v_c.dtype), v_c)
    n_slc = S // SEL_BLOCK
    cmp_start = jnp.arange(n_cmp) * CMP_STRIDE
    sel_start = jnp.arange(n_slc) * SEL_BLOCK
    overlap = ((cmp_start[:, None] < sel_start[None, :] + SEL_BLOCK)
               & (cmp_start[:, None] + CMP_LEN > sel_start[None, :])).astype(jnp.float32)
    imp = jnp.einsum('bhsn,nj->bsj', p_c, overlap)
    cur = t // SEL_BLOCK
    j = jnp.arange(n_slc)
    forced = (j[None, :] == 0) | (j[None, :] == cur[:, None]) | (j[None, :] == cur[:, None] - 1)
    valid_s = j[None, :] <= cur[:, None]
    imp = jnp.where(forced, FORCE, jnp.where(valid_s, imp, -FORCE))
    k_top = min(SEL_TOPK, n_slc)
    _, sel_idx = lax.top_k(imp, k_top)
    kb = kv[:, :, 2].reshape(Bn, n_slc, SEL_BLOCK, Dh)
    vb = kv[:, :, 3].reshape(Bn, n_slc, SEL_BLOCK, Dh)
    nq = S // SEL_Q_CHUNK
    qc = q.reshape(Bn, nq, SEL_Q_CHUNK, H, Dh).transpose(1, 0, 2, 3, 4)
    ic = sel_idx.reshape(Bn, nq, SEL_Q_CHUNK, k_top).transpose(1, 0, 2, 3)
    tc = t.reshape(nq, SEL_Q_CHUNK)

    def sel_chunk(args):
        qq, ii, tt = args
        kg = jax.vmap(lambda a, b: a[b])(kb, ii)
        vg = jax.vmap(lambda a, b: a[b])(vb, ii)
        kpos = ii[..., None] * SEL_BLOCK + jnp.arange(SEL_BLOCK)
        ok = kpos <= tt[None, :, None, None]
        s = jnp.einsum('bchd,bckld->bhckl', qq, kg).astype(jnp.float32) * scale
        s = jnp.where(ok[:, None], s, NEG).reshape(Bn, H, SEL_Q_CHUNK, k_top * SEL_BLOCK)
        p = jax.nn.softmax(s, axis=-1)
        return jnp.einsum('bhcn,bcnd->bchd', p.astype(vg.dtype),
                          vg.reshape(Bn, SEL_Q_CHUNK, k_top * SEL_BLOCK, Dh))

    o_slc = lax.map(sel_chunk, (qc, ic, tc))
    o_slc = o_slc.transpose(1, 0, 2, 3, 4).reshape(Bn, S, H, Dh)
    o_win, _ = banded_attention(q.transpose(0, 2, 1, 3), kv[:, :, 4][:, None], kv[:, :, 5][:, None], WIN - 1)
    o_win = o_win.transpose(0, 2, 1, 3)
    g = jax.nn.sigmoid(gates.astype(jnp.float32))[..., None]
    o = (g[:, :, 0] * o_cmp.astype(jnp.float32) + g[:, :, 1] * o_slc.astype(jnp.float32)
         + g[:, :, 2] * o_win.astype(jnp.float32))
    return o.reshape(Bn, S, H * Dh)


def dilated_mixer(q, k, v):
    Bn, H, S, Dh = q.shape
    outs, lses = [], []
    for window, dil in DILATED_PAIRS:
        L = S // dil

        def by_stride(a):
            return a.reshape(Bn, H, L, dil, Dh).transpose(0, 1, 3, 2, 4).reshape(Bn, H * dil, L, Dh)

        o, lse = banded_attention(by_stride(q), by_stride(k), by_stride(v), window // dil)
        outs.append(o.reshape(Bn, H, dil, L, Dh).transpose(0, 1, 3, 2, 4).reshape(Bn, H, S, Dh))
        lses.append(lse.reshape(Bn, H, dil, L).transpose(0, 1, 3, 2).reshape(Bn, H, S))
    w = jax.nn.softmax(jnp.stack(lses, axis=0), axis=0)
    o = jnp.sum(w[..., None] * jnp.stack(outs, axis=0).astype(jnp.float32), axis=0)
    return o.transpose(0, 2, 1, 3).reshape(Bn, S, H * Dh)


def pool_mixer(c, w_pool, pool_scale):
    Bn, S, _ = c.shape
    cf = c.astype(jnp.float32).reshape(Bn, S, C_GROUPS, HEAD_DIM)
    cs = jnp.pad(jnp.cumsum(cf, axis=1), ((0, 0), (1, 0), (0, 0), (0, 0)))
    t = jnp.arange(S)
    outs = []
    for g, w in enumerate(POOL_SIZES):
        lo = jnp.maximum(t + 1 - w, 0)
        win_sum = cs[:, 1:, g] - cs[:, lo, g]
        cnt = (t + 1 - lo).astype(jnp.float32)
        outs.append(win_sum / cnt[None, :, None] - cf[:, :, g])
    pooled = jnp.stack(outs, axis=2)
    mixed = jnp.einsum('bsgc,gcd->bsgd', pooled, w_pool.astype(jnp.float32))
    return mixed.reshape(Bn, S, C_W) * pool_scale.astype(jnp.float32)


def spatial_gating(uv, ln_g, ln_b, w_sp, b_sp):
    Bn, S, _ = uv.shape
    u, v = jnp.split(uv, 2, axis=-1)
    vf = v.astype(jnp.float32)
    mu = jnp.mean(vf, axis=-1, keepdims=True)
    var = jnp.mean(jnp.square(vf - mu), axis=-1, keepdims=True)
    vn = (vf - mu) * lax.rsqrt(var + LN_EPS) * ln_g.astype(jnp.float32) + ln_b.astype(jnp.float32)
    nc = S // SG_CHUNK
    vn = vn.reshape(Bn, nc, SG_CHUNK, D_GROUPS, HEAD_DIM)
    w = w_sp.astype(jnp.float32) * jnp.tril(jnp.ones((SG_CHUNK, SG_CHUNK), jnp.float32))
    z = jnp.einsum('gij,bnjgc->bnigc', w, vn) + b_sp.astype(jnp.float32).T[None, None, :, :, None]
    return u.astype(jnp.float32) * z.reshape(Bn, S, D_W)


def hybrid_layer(x, g_pre, w_in, pe_cmp, w_cmp1, w_cmp2, w_pool, pool_scale,
                 sg_ln_g, sg_ln_b, w_sp, b_sp, w_out, g_post):
    Bn, S, _ = x.shape
    h = rmsnorm(x, g_pre)
    proj = h @ w_in
    split_points = np.cumsum(np.array(SPLITS))[:-1].tolist()
    a_q, a_kv, a_g, a_z, b_qkv, b_z, c_in, c_z, d_uv, d_z = jnp.split(proj, split_points, axis=-1)
    y_a = nsa_mixer(a_q.reshape(Bn, S, A_HEADS, HEAD_DIM), a_kv.reshape(Bn, S, N_NSA_KV, HEAD_DIM),
                    a_g.reshape(Bn, S, 3, A_HEADS), pe_cmp, w_cmp1, w_cmp2)
    bqkv = b_qkv.reshape(Bn, S, 3, B_HEADS, HEAD_DIM).transpose(2, 0, 3, 1, 4)
    y_b = dilated_mixer(bqkv[0], bqkv[1], bqkv[2])
    y_c = pool_mixer(c_in, w_pool, pool_scale)
    y_d = spatial_gating(d_uv, sg_ln_g, sg_ln_b, w_sp, b_sp)
    y = jnp.concatenate([
        (y_a * jax.nn.silu(a_z.astype(jnp.float32))).astype(x.dtype),
        (y_b * jax.nn.silu(b_z.astype(jnp.float32))).astype(x.dtype),
        (y_c * jax.nn.silu(c_z.astype(jnp.float32))).astype(x.dtype),
        (y_d * jax.nn.silu(d_z.astype(jnp.float32))).astype(x.dtype),
    ], axis=-1)
    out = y @ w_out
    return x + rmsnorm(out, g_post)


def setup_inputs(seed: int = 0) -> dict:
    key = jax.random.key(seed)
    ks = jax.random.split(key, 16)
    f32 = jnp.float32
    n = lambda k, shape: jax.random.normal(k, shape, f32)
    return {
        "x": n(ks[0], (BATCH, SEQ, D_MODEL)),
        "g_pre": 1.0 + 0.1 * n(ks[1], (DEPTH, D_MODEL)),
        "w_in": n(ks[2], (DEPTH, D_MODEL, D_IN)) * D_MODEL ** -0.5,
        "pe_cmp": 0.2 * n(ks[3], (DEPTH, 2, CMP_LEN, HEAD_DIM)),
        "w_cmp1": n(ks[4], (DEPTH, 2, CMP_LEN * HEAD_DIM, CMP_HIDDEN)) * (CMP_LEN * HEAD_DIM) ** -0.5,
        "w_cmp2": n(ks[5], (DEPTH, 2, CMP_HIDDEN, HEAD_DIM)) * CMP_HIDDEN ** -0.5,
        "w_pool": n(ks[6], (DEPTH, C_GROUPS, HEAD_DIM, HEAD_DIM)) * HEAD_DIM ** -0.5,
        "pool_scale": 1.0 + 0.1 * n(ks[7], (DEPTH, C_W)),
        "sg_ln_g": 1.0 + 0.1 * n(ks[8], (DEPTH, D_W)),
        "sg_ln_b": 0.02 * n(ks[9], (DEPTH, D_W)),
        "w_sp": n(ks[10], (DEPTH, D_GROUPS, SG_CHUNK, SG_CHUNK)) * SG_CHUNK ** -0.5,
        "b_sp": 1.0 + 0.1 * n(ks[11], (DEPTH, D_GROUPS, SG_CHUNK)),
        "w_out": n(ks[12], (DEPTH, D_MIX, D_MODEL)) * D_MIX ** -0.5,
        "g_post": 1.0 + 0.1 * n(ks[13], (DEPTH, D_MODEL)),
    }


def reference(x, g_pre, w_in, pe_cmp, w_cmp1, w_cmp2, w_pool, pool_scale,
              sg_ln_g, sg_ln_b, w_sp, b_sp, w_out, g_post):
    for l in range(DEPTH):
        x = hybrid_layer(x, g_pre[l], w_in[l], pe_cmp[l], w_cmp1[l], w_cmp2[l], w_pool[l], pool_scale[l],
                         sg_ln_g[l], sg_ln_b[l], w_sp[l], b_sp[l], w_out[l], g_post[l])
    return x
```

```cpp
#include <hip/hip_runtime.h>
#include <hip/hip_cooperative_groups.h>
#include <cstdio>
namespace cg = cooperative_groups;

typedef unsigned short u16;
using bf16x8 = __attribute__((ext_vector_type(8))) short;
using s16x4 = __attribute__((ext_vector_type(4))) short;
using f32x16 = __attribute__((ext_vector_type(16))) float;
using f32x4 = __attribute__((ext_vector_type(4))) float;
using u32x4 = __attribute__((ext_vector_type(4))) unsigned;
using u32x2 = __attribute__((ext_vector_type(2))) unsigned;
typedef short v4i16_t __attribute__((ext_vector_type(4)));
#define DI __device__ __forceinline__
#define MFMA(a, b, c) __builtin_amdgcn_mfma_f32_32x32x16_bf16((a), (b), (c), 0, 0, 0)

constexpr int T_ = 16384, S_ = 2048, NP = 3328;
constexpr float C2 = 0.125f * 1.4426950408889634f;
constexpr float NEGB = -1e30f;

constexpr int C_AQ = 0, C_KCMP = 256, C_KSLC = 384, C_VSLC = 448, C_KWIN = 512, C_VWIN = 576, C_AZ = 640;
constexpr int C_BQ = 896, C_BK = 1152, C_BV = 1408, C_BZ = 1664, C_CIN = 1920, C_CZ = 2176, C_DU = 2432, C_DV = 2688, C_DZ = 2944, C_AG = 3200;

constexpr size_t al(size_t x) { return (x + 255) & ~(size_t)255; }
constexpr size_t OFF_WIN = 0;
constexpr size_t OFF_WOUT = OFF_WIN + al((size_t)4 * NP * 1024 * 2);
constexpr size_t OFF_W1 = OFF_WOUT + al((size_t)4 * 1024 * 1024 * 2);
constexpr size_t OFF_W2 = OFF_W1 + al((size_t)4 * 2 * 256 * 2048 * 2);
constexpr size_t OFF_XB = OFF_W2 + al((size_t)4 * 2 * 64 * 256 * 2);
constexpr size_t OFF_RN = OFF_XB + al((size_t)T_ * 1024 * 2);
constexpr size_t OFF_PROJ = OFF_RN + al((size_t)T_ * 4);
constexpr size_t OFF_SSQ = OFF_PROJ + al((size_t)T_ * NP * 2);
constexpr size_t OFF_KC = OFF_SSQ + al((size_t)T_ * 16 * 4);
constexpr size_t OFF_VCT = OFF_KC + al((size_t)8 * 128 * 64 * 2);
constexpr size_t OFF_OWIN = OFF_VCT + al((size_t)8 * 128 * 64 * 2);
constexpr size_t OFF_ODIL = OFF_OWIN + al((size_t)T_ * 256 * 2);
constexpr size_t OFF_LSE = OFF_ODIL + al((size_t)3 * T_ * 256 * 2);
constexpr size_t OFF_WPT = OFF_LSE + al((size_t)3 * T_ * 4 * 4);
constexpr size_t OFF_WSP = OFF_WPT + al((size_t)16 * 64 * 64 * 2);
constexpr size_t OFF_OUTB = OFF_WSP + al((size_t)16 * 128 * 128 * 2);
constexpr size_t OFF_BAR = OFF_OUTB + al((size_t)T_ * 1024 * 2);
constexpr size_t WS_TOTAL = OFF_BAR + 16384;
static_assert(WS_TOTAL <= (size_t)256 * 1024 * 1024, "workspace layout exceeds the guaranteed 256 MiB");

struct Params {
  const float *x, *g_pre, *w_in, *pe_cmp, *w_cmp1, *w_cmp2, *w_pool, *pool_scale, *sg_ln_g, *sg_ln_b, *w_sp, *b_sp, *w_out, *g_post;
  float* out;
  char* ws;
};

DI char* opq(char* q) { size_t z = 0; asm volatile("" : "+s"(z)); return q + z; }
DI int tidx() { int t = threadIdx.x; asm volatile("" : "+v"(t)); return t; }
DI float bf2f(u16 v) { return __uint_as_float((unsigned)v << 16); }
DI unsigned pk2(float a, float b) {
  typedef __bf16 bf2 __attribute__((ext_vector_type(2)));
  typedef float f2 __attribute__((ext_vector_type(2)));
  f2 v = {a, b};
  bf2 r = __builtin_convertvector(v, bf2);
  return __builtin_bit_cast(unsigned, r);
}
DI u16 f2bf(float x) { return (u16)(pk2(x, 0.f) & 0xffffu); }
DI float lo16(unsigned w) { return __uint_as_float(w << 16); }
DI float hi16(unsigned w) { return __uint_as_float(w & 0xffff0000u); }
DI int crow(int r, int hi) { return (r & 3) + 8 * (r >> 2) + 4 * hi; }
DI float ex2(float x) { return __builtin_amdgcn_exp2f(x); }
DI float sigmoidf_(float x) { return 1.f / (1.f + __expf(-x)); }
DI float siluf_(float x) { return x / (1.f + __expf(-x)); }
DI float wave_sum(float v) {
#pragma unroll
  for (int o = 32; o >= 1; o >>= 1) v += __shfl_xor(v, o, 64);
  return v;
}
DI bf16x8 pack8(const f32x16& x, int s8) {
  u32x4 p;
  p[0] = pk2(x[8 * s8 + 0], x[8 * s8 + 1]); p[1] = pk2(x[8 * s8 + 2], x[8 * s8 + 3]);
  p[2] = pk2(x[8 * s8 + 4], x[8 * s8 + 5]); p[3] = pk2(x[8 * s8 + 6], x[8 * s8 + 7]);
  return __builtin_bit_cast(bf16x8, p);
}
DI s16x4 trread(const char* p) {
  return __builtin_bit_cast(s16x4, __builtin_amdgcn_ds_read_tr16_b64_v4i16((__attribute__((address_space(3))) v4i16_t*)p));
}


#define XB_TMO      128
#define XB_XCNT(j)  (256  + 64 * (j))
#define XB_XSUB(j)  (1280 + 64 * (j))
#define XB_XGEN(j)  (2304 + 64 * (j))
#define XB_TOP      3328
#define XB_TOPGEN   3392
#define XCD_BAR_WORDS 3456
#define XB_SPIN_CAP (1u << 22)
#define LAS __attribute__((address_space(3)))
DI unsigned xb_ld(unsigned* p)              { return __hip_atomic_load(p, __ATOMIC_RELAXED, __HIP_MEMORY_SCOPE_AGENT); }
DI unsigned xb_add(unsigned* p, unsigned v) { return __hip_atomic_fetch_add(p, v, __ATOMIC_RELAXED, __HIP_MEMORY_SCOPE_AGENT); }
DI unsigned xb_xcc_id() { return (unsigned)__builtin_amdgcn_s_getreg((3 << 11) | 20) & 0xFu; }
#define XB_SPIN(cond, bar) do { unsigned _sp = 0; while (cond) { __builtin_amdgcn_s_sleep(1); \
    if ((++_sp & 255u) == 0u) { if (xb_ld(&(bar)[XB_TMO])) break; if (_sp > XB_SPIN_CAP) { atomicAdd(&(bar)[XB_TMO], 1u); break; } } } } while (0)
struct XcdBarrier { unsigned* bar; unsigned x; volatile LAS unsigned* st; };
DI XcdBarrier xcd_barrier_post(unsigned* bar, volatile LAS unsigned* st) {
    XcdBarrier b; b.bar = bar; b.x = xb_xcc_id(); b.st = st;
    if (threadIdx.x == 0) (void)xb_add(&bar[XB_XCNT(b.x)], 1u);
    return b;
}
DI void xcd_barrier_complete(unsigned* bar, unsigned x, unsigned& nloc, unsigned& nx) {
    const unsigned G = gridDim.x * gridDim.y * gridDim.z;
    unsigned sum, cnt, mine, sp = 0u;
    for (;;) {
        sum = 0u; cnt = 0u; mine = 0u;
#pragma unroll
        for (unsigned j = 0; j < 16; ++j) { const unsigned c = xb_ld(&bar[XB_XCNT(j)]); sum += c; cnt += (c > 0u) ? 1u : 0u; mine = (j == x) ? c : mine; }
        if (sum == G) break;
        __builtin_amdgcn_s_sleep(1);
        if ((++sp & 255u) == 0u) { if (xb_ld(&bar[XB_TMO])) break; if (sp > XB_SPIN_CAP) { atomicAdd(&bar[XB_TMO], 1u); break; } }
    }
    nloc = mine > 0u ? mine : 1u; nx = cnt > 0u ? cnt : 1u;
}
DI void xcd_barrier(const XcdBarrier& b) {
    asm volatile("s_waitcnt vmcnt(0)" ::: "memory");
    __syncthreads();
    if (threadIdx.x == 0) {
        unsigned* bar = b.bar;
        __builtin_amdgcn_s_waitcnt(0);
        unsigned nloc = b.st[0], nx = b.st[1];
        if (nloc == 0u) { xcd_barrier_complete(bar, b.x, nloc, nx); b.st[0] = nloc; b.st[1] = nx; }
        const unsigned old = xb_add(&bar[XB_XSUB(b.x)], 1u);
        const unsigned gen = old / nloc;
        if (old + 1u == (gen + 1u) * nloc) {
            __builtin_amdgcn_fence(__ATOMIC_RELEASE, "agent");
            asm volatile("s_waitcnt vmcnt(0)" ::: "memory");
            const unsigned og = xb_add(&bar[XB_TOP], 1u);
            const unsigned tg = og / nx;
            if (og + 1u == (tg + 1u) * nx) xb_add(&bar[XB_TOPGEN], 1u);
            else XB_SPIN(xb_ld(&bar[XB_TOPGEN]) == tg, bar);
            __builtin_amdgcn_fence(__ATOMIC_ACQUIRE, "agent");
            xb_add(&bar[XB_XGEN(b.x)], 1u);
            asm volatile("s_waitcnt vmcnt(0)" ::: "memory");
        } else {
            XB_SPIN(xb_ld(&bar[XB_XGEN(b.x)]) == gen, bar);
            __builtin_amdgcn_fence(__ATOMIC_ACQUIRE, "agent");
            asm volatile("s_waitcnt vmcnt(0)" ::: "memory");
        }
    }
    __syncthreads();
}

template <int WGN, int INS, int IMS, bool DB, class LdW, class LdX>
DI void gemm_core(f32x16 (&acc)[INS][IMS], const int KT, LdW ldw, LdX ldx, char* lds, const int tid) {
  constexpr int WGM = 4 / WGN;
  constexpr int WROWS = WGN * 32 * INS, XROWS = WGM * 32 * IMS, NROWS = WROWS + XROWS, NCH = NROWS / 32, NCHW = WROWS / 32, BUFB = NROWS * 144;
  const int lane = tid & 63, wid = tid >> 6, l31 = lane & 31, hi = lane >> 5;
  const int wn = (WGN == 2) ? (wid >> 1) : wid, wm = (WGN == 2) ? (wid & 1) : 0;
  const int offa = (wn * 32 * INS + l31) * 144 + hi * 16;
  const int offb = (WROWS + wm * 32 * IMS + l31) * 144 + hi * 16;
#pragma unroll
  for (int a = 0; a < INS; ++a)
#pragma unroll
    for (int b = 0; b < IMS; ++b)
#pragma unroll
      for (int r = 0; r < 16; ++r) acc[a][b][r] = 0.f;
#define GLOAD(dst, kt_) _Pragma("unroll") for (int i = 0; i < NCH; ++i) { dst[i] = (i < NCHW) ? ldw(i, tid >> 3, (kt_) * 64 + (tid & 7) * 8) : ldx(i - NCHW, tid >> 3, (kt_) * 64 + (tid & 7) * 8); }
#define LSTORE(src, base) _Pragma("unroll") for (int i = 0; i < NCH; ++i) { const int c = tid + 256 * i; *(u32x4*)((base) + (c >> 3) * 144 + (c & 7) * 16) = src[i]; }
#define COMPUTE_PIPE(buf) { const char* pa = (buf) + offa; const char* pb = (buf) + offb; \
    bf16x8 fa[2][INS], fb[2][IMS]; \
    _Pragma("unroll") for (int in = 0; in < INS; ++in) fa[0][in] = *(const bf16x8*)(pa + in * 32 * 144); \
    _Pragma("unroll") for (int im = 0; im < IMS; ++im) fb[0][im] = *(const bf16x8*)(pb + im * 32 * 144); \
    _Pragma("unroll") for (int s = 0; s < 4; ++s) { \
      if (s < 3) { _Pragma("unroll") for (int in = 0; in < INS; ++in) fa[(s + 1) & 1][in] = *(const bf16x8*)(pa + in * 32 * 144 + (s + 1) * 32); \
        _Pragma("unroll") for (int im = 0; im < IMS; ++im) fb[(s + 1) & 1][im] = *(const bf16x8*)(pb + im * 32 * 144 + (s + 1) * 32); } \
      _Pragma("unroll") for (int im = 0; im < IMS; ++im) _Pragma("unroll") for (int in = 0; in < INS; ++in) \
        acc[in][im] = MFMA(fa[s & 1][in], fb[s & 1][im], acc[in][im]); } }
#define COMPUTE_FLAT(buf) { const char* pa = (buf) + offa; const char* pb = (buf) + offb; \
    _Pragma("unroll") for (int s = 0; s < 4; ++s) { \
      bf16x8 fa[INS], fb[IMS]; \
      _Pragma("unroll") for (int in = 0; in < INS; ++in) fa[in] = *(const bf16x8*)(pa + in * 32 * 144 + s * 32); \
      _Pragma("unroll") for (int im = 0; im < IMS; ++im) fb[im] = *(const bf16x8*)(pb + im * 32 * 144 + s * 32); \
      _Pragma("unroll") for (int im = 0; im < IMS; ++im) _Pragma("unroll") for (int in = 0; in < INS; ++in) \
        acc[in][im] = MFMA(fa[in], fb[im], acc[in][im]); } }
  if (DB) {
    u32x4 preA[NCH], preB[NCH];
    GLOAD(preA, 0)
    GLOAD(preB, 1)
    __syncthreads();
    LSTORE(preA, lds)
    __syncthreads();
    for (int kt = 0; kt < KT; kt += 2) {
      if (kt + 2 < KT) { GLOAD(preA, kt + 2) }
      COMPUTE_PIPE(lds)
      LSTORE(preB, lds + BUFB)
      __syncthreads();
      if (kt + 3 < KT) { GLOAD(preB, kt + 3) }
      COMPUTE_PIPE(lds + BUFB)
      if (kt + 2 < KT) { LSTORE(preA, lds) }
      __syncthreads();
    }
  } else {
    u32x4 pre[NCH];
    GLOAD(pre, 0)
    for (int kt = 0; kt < KT; ++kt) {
      __syncthreads();
      LSTORE(pre, lds)
      __syncthreads();
      if (kt + 1 < KT) { GLOAD(pre, kt + 1) }
      if (INS >= 4) COMPUTE_FLAT(lds) else COMPUTE_PIPE(lds)
    }
  }
#undef GLOAD
#undef LSTORE
#undef COMPUTE_PIPE
#undef COMPUTE_FLAT
}

constexpr float M_INIT = -1e29f;
template <class MaskF>
DI void attn_tile(const int tid, const char* ldsK, const char* ldsV, const bf16x8 (&qr)[4], f32x16 (&o)[2], float& m, float& l, const bool MASKED, MaskF mask) {
  const int lane = tid & 63, l31 = lane & 31, hi = lane >> 5;
  f32x16 p0, p1;
#pragma unroll
  for (int r = 0; r < 16; ++r) { p0[r] = 0.f; p1[r] = 0.f; }
  const char* kp = ldsK + l31 * 144 + hi * 16;
#pragma unroll
  for (int s = 0; s < 4; ++s) {
    const bf16x8 k0 = *(const bf16x8*)(kp + s * 32), k1 = *(const bf16x8*)(kp + 32 * 144 + s * 32);
    p0 = MFMA(k0, qr[s], p0); p1 = MFMA(k1, qr[s], p1);
  }
  if (MASKED) {
#pragma unroll
    for (int r = 0; r < 16; ++r) {
      const int kr = crow(r, hi);
      p0[r] = mask(kr) ? p0[r] : NEGB; p1[r] = mask(kr + 32) ? p1[r] : NEGB;
    }
  }
  const char* vb = ldsV + (4 * hi + ((lane & 15) >> 2)) * 144 + ((lane >> 4) & 1) * 32 + (lane & 3) * 8;
  s16x4 vlo[8], vhi[8];
#pragma unroll
  for (int s4 = 0; s4 < 4; ++s4)
#pragma unroll
    for (int db = 0; db < 2; ++db) { vlo[s4 * 2 + db] = trread(vb + (16 * s4) * 144 + db * 64); vhi[s4 * 2 + db] = trread(vb + (16 * s4 + 8) * 144 + db * 64); }
  __builtin_amdgcn_sched_barrier(0);
  float mx = fmaxf(p0[0], p1[0]);
#pragma unroll
  for (int r = 1; r < 16; ++r) mx = fmaxf(fmaxf(mx, p0[r]), p1[r]);
  { auto rr = __builtin_amdgcn_permlane32_swap(__float_as_uint(mx), __float_as_uint(mx), false, false); mx = fmaxf(__uint_as_float(rr[0]), __uint_as_float(rr[1])); }
  const float mxs = mx * C2;
  if (__any(mxs > m + 8.f)) {
    const float mn = fmaxf(m, mxs), alpha = ex2(m - mn);
    m = mn; l *= alpha;
#pragma unroll
    for (int r = 0; r < 16; ++r) { o[0][r] *= alpha; o[1][r] *= alpha; }
  }
  const float nm = -m;
  float rs = 0.f;
#pragma unroll
  for (int r = 0; r < 16; ++r) { p0[r] = ex2(__builtin_fmaf(p0[r], C2, nm)); p1[r] = ex2(__builtin_fmaf(p1[r], C2, nm)); rs += p0[r] + p1[r]; }
  l += rs;
  bf16x8 pw[4];
  pw[0] = pack8(p0, 0); pw[1] = pack8(p0, 1); pw[2] = pack8(p1, 0); pw[3] = pack8(p1, 1);
#pragma unroll
  for (int s4 = 0; s4 < 4; ++s4) {
#pragma unroll
    for (int db = 0; db < 2; ++db) {
      const s16x4 lo = vlo[s4 * 2 + db], hh = vhi[s4 * 2 + db];
      const bf16x8 vf = {lo[0], lo[1], lo[2], lo[3], hh[0], hh[1], hh[2], hh[3]};
      o[db] = MFMA(vf, pw[s4], o[db]);
    }
  }
}

template <class RowF>
DI void kv_load(const int tid, u32x4 (&pre)[4], RowF rowtok, const u16* proj, int kcol, int vcol) {
#pragma unroll
  for (int i = 0; i < 2; ++i) {
    const int c = tid + 256 * i, row = c >> 3, ch = c & 7;
    const u16* p = proj + (size_t)rowtok(row) * NP + ch * 8;
    pre[i] = *(const u32x4*)(p + kcol); pre[2 + i] = *(const u32x4*)(p + vcol);
  }
}
DI void kv_store(const int tid, const u32x4 (&pre)[4], char* ldsK, char* ldsV) {
#pragma unroll
  for (int i = 0; i < 2; ++i) {
    const int c = tid + 256 * i, row = c >> 3, ch = c & 7;
    *(u32x4*)(ldsK + row * 144 + ch * 16) = pre[i]; *(u32x4*)(ldsV + row * 144 + ch * 16) = pre[2 + i];
  }
}

template <class RowF, class FullF, class MaskF>
DI void attn_stream(const int tid, const u16* proj, const int kcol, const int vcol, const int nt, RowF rowtok, FullF full, MaskF mask,
                    const bf16x8 (&qr)[4], f32x16 (&o)[2], float& m, float& l, char* lds) {
  u32x4 preA[4], preB[4];
  if (nt > 0) kv_load(tid, preA, [&](int row) { return rowtok(0, row); }, proj, kcol, vcol);
  if (nt > 1) kv_load(tid, preB, [&](int row) { return rowtok(1, row); }, proj, kcol, vcol);
  for (int ti = 0; ti < nt; ti += 2) {
    kv_store(tid, preA, lds, lds + 9216);
    __syncthreads();
    if (ti + 2 < nt) kv_load(tid, preA, [&](int row) { return rowtok(ti + 2, row); }, proj, kcol, vcol);
    attn_tile(tid, lds, lds + 9216, qr, o, m, l, !full(ti), [&](int kr) { return mask(ti, kr); });
    if (ti + 1 < nt) {
      kv_store(tid, preB, lds + 18432, lds + 27648);
      __syncthreads();
      if (ti + 3 < nt) kv_load(tid, preB, [&](int row) { return rowtok(ti + 3, row); }, proj, kcol, vcol);
      attn_tile(tid, lds + 18432, lds + 27648, qr, o, m, l, !full(ti + 1), [&](int kr) { return mask(ti + 1, kr); });
    }
  }
}

DI int mapcol(int n, int mode) {
  if (mode == 0) return n;
  if (n < 640) return n;
  if (n < 3200) return n + 12;
  if (n < 3212) return n - 3200 + 640;
  return -1;
}
DI void tr_tile(const float* src, int ldsrc, u16* dst, int ldd, int k0, int n0, const float* g, int mode, char* lds) {
  float* t = (float*)lds;
  const int tid = threadIdx.x;
  float v[16];
#pragma unroll
  for (int i = 0; i < 16; ++i) {
    const int e = tid + 256 * i, kk = e >> 6, nn = e & 63;
    const int sc = mapcol(n0 + nn, mode);
    v[i] = sc >= 0 ? src[(size_t)(k0 + kk) * ldsrc + sc] : 0.f;
  }
  if (g) {
#pragma unroll
    for (int i = 0; i < 16; ++i) v[i] *= g[k0 + ((tid + 256 * i) >> 6)];
  }
#pragma unroll
  for (int i = 0; i < 16; ++i) { const int e = tid + 256 * i, kk = e >> 6, nn = e & 63; t[kk * 65 + nn] = v[i]; }
  __syncthreads();
#pragma unroll
  for (int i = 0; i < 2; ++i) {
    const int e = tid + 256 * i, nn = e >> 3, k8 = (e & 7) * 8;
    u32x4 o;
    o[0] = pk2(t[(k8 + 0) * 65 + nn], t[(k8 + 1) * 65 + nn]); o[1] = pk2(t[(k8 + 2) * 65 + nn], t[(k8 + 3) * 65 + nn]);
    o[2] = pk2(t[(k8 + 4) * 65 + nn], t[(k8 + 5) * 65 + nn]); o[3] = pk2(t[(k8 + 6) * 65 + nn], t[(k8 + 7) * 65 + nn]);
    *(u32x4*)(dst + (size_t)(n0 + nn) * ldd + k0 + k8) = o;
  }
  __syncthreads();
}

template <int NR>
DI void rows_convert(const float* x0, u16* xb0, float* rn0) {
  const int lane = tidx() & 63;
  f32x4 v[NR][4];
#pragma unroll
  for (int r = 0; r < NR; ++r)
#pragma unroll
    for (int i = 0; i < 4; ++i) v[r][i] = *(const f32x4*)(x0 + (size_t)r * 1024 + i * 256 + lane * 4);
#pragma unroll
  for (int r = 0; r < NR; ++r) {
    float ss = 0.f;
#pragma unroll
    for (int i = 0; i < 4; ++i) {
      ss += v[r][i][0] * v[r][i][0] + v[r][i][1] * v[r][i][1] + v[r][i][2] * v[r][i][2] + v[r][i][3] * v[r][i][3];
      u32x2 o; o[0] = pk2(v[r][i][0], v[r][i][1]); o[1] = pk2(v[r][i][2], v[r][i][3]);
      *(u32x2*)(xb0 + (size_t)r * 1024 + i * 256 + lane * 4) = o;
    }
    ss = wave_sum(ss);
    if (lane == 0) rn0[r] = rsqrtf(ss * (1.f / 1024.f) + 1e-6f);
  }
}

template <int NTW>
DI void inproj_tile(const Params& p, int l, int mt, int ntile, char* lds) {
  char* const ws_ = opq(p.ws);
  const u16* W = (const u16*)(ws_ + OFF_WIN) + ((size_t)l * NP + ntile * 64 * NTW) * 1024;
  const u16* X = (const u16*)(ws_ + OFF_XB) + (size_t)mt * 128 * 1024;
  f32x16 acc[NTW][2];
  const int tid = tidx();
  gemm_core<2, NTW, 2, (NTW == 2)>(acc, 16, [&](int i, int r0, int k) -> u32x4 { return *(const u32x4*)((W + i * 32768) + (unsigned)(r0 * 1024 + k)); },
               [&](int i, int r0, int k) -> u32x4 { return *(const u32x4*)((X + i * 32768) + (unsigned)(r0 * 1024 + k)); }, lds, tid);
  const int lane = tid & 63, wid = tid >> 6, l31 = lane & 31, hi = lane >> 5, wn = wid >> 1, wm = wid & 1;
  const float* rn = (const float*)(ws_ + OFF_RN);
  u16* proj = (u16*)(ws_ + OFF_PROJ);
  constexpr int NCOLS = 64 * NTW, RS = NCOLS * 2 + 16;
  __syncthreads();
#pragma unroll
  for (int im = 0; im < 2; ++im) {
    const int tl = wm * 64 + im * 32 + l31;
    const float r = rn[(size_t)mt * 128 + tl];
#pragma unroll
    for (int in = 0; in < NTW; ++in)
#pragma unroll
      for (int g = 0; g < 4; ++g) {
        const int n = wn * 32 * NTW + in * 32 + 8 * g + 4 * hi;
        u32x2 o; o[0] = pk2(acc[in][im][4 * g] * r, acc[in][im][4 * g + 1] * r); o[1] = pk2(acc[in][im][4 * g + 2] * r, acc[in][im][4 * g + 3] * r);
        *(u32x2*)(lds + tl * RS + n * 2) = o;
      }
  }
  __syncthreads();
#pragma unroll 4
  for (int i = 0; i < NCOLS / 16; ++i) {
    const int c = tid + 256 * i, tl = c / (NCOLS / 8), ch = c % (NCOLS / 8);
    const u32x4 v = *(const u32x4*)(lds + tl * RS + ch * 16);
    *(u32x4*)(proj + ((size_t)mt * 128 + tl) * NP + ntile * NCOLS + ch * 8) = v;
  }
}

DI void outproj_item(const Params& p, int l, int it, char* lds) {
  char* const ws_ = opq(p.ws);
  const int mt = (it & 7) * 16 + ((it >> 3) & 15), nt = it >> 7;
  const u16* W = (const u16*)(ws_ + OFF_WOUT) + ((size_t)l * 1024 + nt * 256) * 1024;
  const u16* Y = (const u16*)(ws_ + OFF_XB) + (size_t)mt * 128 * 1024;
  f32x16 acc[4][2];
  const int tid = tidx();
  gemm_core<2, 4, 2, false>(acc, 16, [&](int i, int r0, int k) -> u32x4 { return *(const u32x4*)((W + i * 32768) + (unsigned)(r0 * 1024 + k)); },
               [&](int i, int r0, int k) -> u32x4 { return *(const u32x4*)((Y + i * 32768) + (unsigned)(r0 * 1024 + k)); }, lds, tid);
  const int lane = tid & 63, wid = tid >> 6, l31 = lane & 31, hi = lane >> 5, wn = wid >> 1, wm = wid & 1;
  u16* outb = (u16*)(ws_ + OFF_OUTB);
  float* ssq = (float*)(ws_ + OFF_SSQ);
  constexpr int RS = 256 * 2 + 16;
  __syncthreads();
#pragma unroll
  for (int im = 0; im < 2; ++im) {
    const int tl = wm * 64 + im * 32 + l31;
    float ss = 0.f;
#pragma unroll
    for (int in = 0; in < 4; ++in)
#pragma unroll
      for (int g = 0; g < 4; ++g) {
        const int n = wn * 128 + in * 32 + 8 * g + 4 * hi;
        const float o0 = acc[in][im][4 * g], o1 = acc[in][im][4 * g + 1], o2 = acc[in][im][4 * g + 2], o3 = acc[in][im][4 * g + 3];
        ss += o0 * o0 + o1 * o1 + o2 * o2 + o3 * o3;
        u32x2 v; v[0] = pk2(o0, o1); v[1] = pk2(o2, o3);
        *(u32x2*)(lds + tl * RS + n * 2) = v;
      }
    ss += __shfl_xor(ss, 32, 64);
    if (hi == 0) ssq[((size_t)mt * 128 + tl) * 16 + nt * 2 + wn] = ss;
  }
  __syncthreads();
#pragma unroll 4
  for (int i = 0; i < 16; ++i) {
    const int c = tid + 256 * i, tl = c >> 5, ch = c & 31;
    const u32x4 v = *(const u32x4*)(lds + tl * RS + ch * 16);
    *(u32x4*)(outb + ((size_t)mt * 128 + tl) * 1024 + nt * 256 + ch * 8) = v;
  }
}

template <int NR>
DI void resid_rows(const Params& p, int l, int row0, const float* xin) {
  char* const ws_ = opq(p.ws);
  const int lane = tidx() & 63;
  const u16* outb = (const u16*)(ws_ + OFF_OUTB);
  const float* ssq = (const float*)(ws_ + OFF_SSQ);
  u32x2 ob[NR][4]; f32x4 xv[NR][4]; f32x4 sq[NR][2];
#pragma unroll
  for (int r = 0; r < NR; ++r) {
    const size_t row = (size_t)(row0 + r);
    sq[r][0] = *(const f32x4*)(ssq + row * 16); sq[r][1] = *(const f32x4*)(ssq + row * 16 + 4);
#pragma unroll
    for (int i = 0; i < 4; ++i) { const int idx = i * 256 + lane * 4; ob[r][i] = *(const u32x2*)(outb + row * 1024 + idx); xv[r][i] = *(const f32x4*)(xin + row * 1024 + idx); }
  }
  f32x4 gq[4];
#pragma unroll
  for (int i = 0; i < 4; ++i) gq[i] = *(const f32x4*)(p.g_post + l * 1024 + i * 256 + lane * 4);
  u16* xb = (u16*)(ws_ + OFF_XB);
#pragma unroll
  for (int r = 0; r < NR; ++r) {
    const size_t row = (size_t)(row0 + r);
    const float ss = ((sq[r][0][0] + sq[r][0][1]) + (sq[r][0][2] + sq[r][0][3])) + ((sq[r][1][0] + sq[r][1][1]) + (sq[r][1][2] + sq[r][1][3]));
    const float r2 = rsqrtf(ss * (1.f / 1024.f) + 1e-6f);
    float s2 = 0.f;
#pragma unroll
    for (int i = 0; i < 4; ++i) {
      const int idx = i * 256 + lane * 4;
      const f32x4 o = {lo16(ob[r][i][0]), hi16(ob[r][i][0]), lo16(ob[r][i][1]), hi16(ob[r][i][1])};
      f32x4 xn;
#pragma unroll
      for (int e = 0; e < 4; ++e) { xn[e] = xv[r][i][e] + o[e] * r2 * gq[i][e]; s2 += xn[e] * xn[e]; }
      *(f32x4*)(p.out + row * 1024 + idx) = xn;
      if (l < 3) { u32x2 o2; o2[0] = pk2(xn[0], xn[1]); o2[1] = pk2(xn[2], xn[3]); *(u32x2*)(xb + row * 1024 + idx) = o2; }
    }
    s2 = wave_sum(s2);
    if (lane == 0) ((float*)(ws_ + OFF_RN))[row] = rsqrtf(s2 * (1.f / 1024.f) + 1e-6f);
  }
}

DI void cmp_item(const Params& p, int l, int it, char* lds) {
  char* const ws_ = opq(p.ws);
  const int j = it >> 5, mt = it & 31;
  const u16* proj = (const u16*)(ws_ + OFF_PROJ);
  const u16* W1 = (const u16*)(ws_ + OFF_W1) + (size_t)(l * 2 + j) * 256 * 2048;
  const u16* W2 = (const u16*)(ws_ + OFF_W2) + (size_t)(l * 2 + j) * 64 * 256;
  const float* pe = p.pe_cmp + (size_t)(l * 2 + j) * 32 * 64;
  const int kvcol = C_KCMP + 64 * j;
  f32x16 acc[2][1];
  const int tid = tidx();
  gemm_core<4, 2, 1, false>(acc, 32, [&](int i, int r0, int k) -> u32x4 { return *(const u32x4*)((W1 + i * 65536) + (unsigned)(r0 * 2048 + k)); },
   [&](int i, int row, int k) -> u32x4 {
    const int rr = mt * 32 + row, b = rr >> 7; int n = rr & 127; if (n > 126) n = 126;
    const int l32 = k >> 6, d = k & 63;
    const u32x4 raw = *(const u32x4*)(proj + ((size_t)b * S_ + 16 * n + l32) * NP + kvcol + d);
    const f32x4 e0 = *(const f32x4*)(pe + l32 * 64 + d), e1 = *(const f32x4*)(pe + l32 * 64 + d + 4);
    u32x4 o;
    o[0] = pk2(lo16(raw[0]) + e0[0], hi16(raw[0]) + e0[1]); o[1] = pk2(lo16(raw[1]) + e0[2], hi16(raw[1]) + e0[3]);
    o[2] = pk2(lo16(raw[2]) + e1[0], hi16(raw[2]) + e1[1]); o[3] = pk2(lo16(raw[3]) + e1[2], hi16(raw[3]) + e1[3]);
    return o; }, lds, tid);
  const int lane = tid & 63, wid = tid >> 6, l31 = lane & 31, hi = lane >> 5;
#pragma unroll
  for (int a = 0; a < 2; ++a)
#pragma unroll
    for (int r = 0; r < 16; ++r) {
      const float x = acc[a][0][r]; const float u = 0.7978845608028654f * (x + 0.044715f * x * x * x);
      acc[a][0][r] = x / (1.f + __expf(-2.f * u));
    }
  f32x16 c2[2];
#pragma unroll
  for (int r = 0; r < 16; ++r) { c2[0][r] = 0.f; c2[1][r] = 0.f; }
#pragma unroll
  for (int in = 0; in < 2; ++in)
#pragma unroll
    for (int s2 = 0; s2 < 2; ++s2) {
      const bf16x8 h0 = pack8(acc[in][0], s2);
#pragma unroll
      for (int dt = 0; dt < 2; ++dt) {
        const u16* wp = W2 + (size_t)(dt * 32 + l31) * 256 + wid * 64 + in * 32 + 16 * s2 + 4 * hi;
        const s16x4 lo = *(const s16x4*)wp, hh = *(const s16x4*)(wp + 8);
        const bf16x8 wf = {lo[0], lo[1], lo[2], lo[3], hh[0], hh[1], hh[2], hh[3]};
        c2[dt] = MFMA(wf, h0, c2[dt]);
      }
    }
  float* red = (float*)lds;
  __syncthreads();
  for (int w = 0; w < 4; ++w) {
    if (wid == w) {
#pragma unroll
      for (int dt = 0; dt < 2; ++dt)
#pragma unroll
        for (int r = 0; r < 16; ++r) {
          float* q = red + (dt * 32 + crow(r, hi)) * 32 + l31;
          if (w == 0) *q = c2[dt][r]; else *q += c2[dt][r];
        }
    }
    __syncthreads();
  }
  u16* kc = (u16*)(ws_ + OFF_KC); u16* vct = (u16*)(ws_ + OFF_VCT);
#pragma unroll 4
  for (int i = 0; i < 8; ++i) {
    const int e = tid + 256 * i;
    if (j == 0) { const int tok = e >> 6, d = e & 63; const int rr = mt * 32 + tok; kc[(size_t)rr * 64 + d] = f2bf(red[d * 32 + tok]); }
    else { const int d = e >> 5, tok = e & 31; const int rr = mt * 32 + tok, b = rr >> 7, n = rr & 127; vct[((size_t)b * 64 + d) * 128 + n] = f2bf(red[d * 32 + tok]); }
  }
  __syncthreads();
}

DI void win_item(const Params& p, int it, char* lds) {
  char* const ws_ = opq(p.ws);
  const int b = it & 7, qt = it >> 3, q0 = qt * 32;
  const int tid = tidx(), lane = tid & 63, h = tid >> 6, l31 = lane & 31, hi = lane >> 5;
  const u16* proj = (const u16*)(ws_ + OFF_PROJ);
  const int t = q0 + l31; const size_t tok = (size_t)b * S_ + t;
  bf16x8 qr[4];
#pragma unroll
  for (int s = 0; s < 4; ++s) qr[s] = *(const bf16x8*)(proj + tok * NP + C_AQ + h * 64 + 16 * s + 8 * hi);
  char* ldsK = lds; char* ldsV = lds + 9216;
  f32x16 o[2];
#pragma unroll
  for (int r = 0; r < 16; ++r) { o[0][r] = 0.f; o[1][r] = 0.f; }
  float m = M_INIT, lsum = 0.f;
  const int klo = (q0 - 511 > 0 ? q0 - 511 : 0) >> 6, khi = (q0 + 31) >> 6;
  __syncthreads();
  attn_stream(tid, proj, C_KWIN, C_VWIN, khi - klo + 1,
              [&](int ti, int row) { return b * S_ + (klo + ti) * 64 + row; },
              [&](int ti) { const int k0 = (klo + ti) * 64; return (k0 + 63 <= q0) && (k0 >= q0 + 31 - 511); },
              [&](int ti, int kr) { return (unsigned)(t - ((klo + ti) * 64 + kr)) <= 511u; },
              qr, o, m, lsum, lds);
  lsum += __shfl_xor(lsum, 32, 64);
  const float il = 1.f / lsum;
  u16* ow = (u16*)(ws_ + OFF_OWIN);
#pragma unroll
  for (int db = 0; db < 2; ++db)
#pragma unroll
    for (int g = 0; g < 4; ++g) {
      const int d0 = 32 * db + 8 * g + 4 * hi;
      u32x2 v; v[0] = pk2(o[db][4 * g] * il, o[db][4 * g + 1] * il); v[1] = pk2(o[db][4 * g + 2] * il, o[db][4 * g + 3] * il);
      *(u32x2*)(ow + tok * 256 + h * 64 + d0) = v;
    }
}

DI void dil_item(const Params& p, int it, char* lds) {
  char* const ws_ = opq(p.ws);
  const int di = it >> 9, rem = it & 511, b = rem & 7, h = (rem >> 3) & 3, c = rem >> 5;
  const int sh = 2 * di, dil = 1 << sh;
  const int tpr = 16 >> sh;
  const int r = c / tpr, mt = c % tpr, m0 = mt * 128;
  const int tid = tidx(), lane = tid & 63, wid = tid >> 6, l31 = lane & 31, hi = lane >> 5;
  const u16* proj = (const u16*)(ws_ + OFF_PROJ);
  const int mq = m0 + 32 * wid + l31;
  const size_t tok = (size_t)b * S_ + mq * dil + r;
  bf16x8 qr[4];
#pragma unroll
  for (int s = 0; s < 4; ++s) qr[s] = *(const bf16x8*)(proj + tok * NP + C_BQ + h * 64 + 16 * s + 8 * hi);
  const int tt0 = (m0 == 0) ? 2 : 0;
  {
    u32x4 pre[4][4];
#pragma unroll
    for (int tt = 0; tt < 4; ++tt)
      if (tt >= tt0) kv_load(tid, pre[tt], [&](int row) { return b * S_ + (m0 - 128 + 64 * tt + row) * dil + r; }, proj, C_BK + h * 64, C_BV + h * 64);
    __syncthreads();
#pragma unroll
    for (int tt = 0; tt < 4; ++tt)
      if (tt >= tt0) kv_store(tid, pre[tt], lds + tt * 18432, lds + tt * 18432 + 9216);
    __syncthreads();
  }
  f32x16 o[2];
#pragma unroll
  for (int rr = 0; rr < 16; ++rr) { o[0][rr] = 0.f; o[1][rr] = 0.f; }
  float m = M_INIT, lsum = 0.f;
  const int widu = __builtin_amdgcn_readfirstlane(wid);
  const int wlo = m0 + 32 * widu - 128, whi = m0 + 32 * widu + 31;
  for (int tt = tt0; tt < 4; ++tt) {
    const int tk0 = m0 - 128 + 64 * tt;
    if (tk0 + 63 >= wlo && tk0 <= whi) {
      attn_tile(tid, lds + tt * 18432, lds + tt * 18432 + 9216, qr, o, m, lsum, !(tk0 + 63 <= wlo + 128 && tk0 >= whi - 128), [&](int kr) { return (unsigned)(mq - (tk0 + kr)) <= 128u; });
    }
  }
  lsum += __shfl_xor(lsum, 32, 64);
  const float il = 1.f / lsum;
  u16* od = (u16*)(ws_ + OFF_ODIL) + (size_t)di * T_ * 256;
#pragma unroll
  for (int db = 0; db < 2; ++db)
#pragma unroll
    for (int g = 0; g < 4; ++g) {
      const int d0 = 32 * db + 8 * g + 4 * hi;
      u32x2 v; v[0] = pk2(o[db][4 * g] * il, o[db][4 * g + 1] * il); v[1] = pk2(o[db][4 * g + 2] * il, o[db][4 * g + 3] * il);
      *(u32x2*)(od + tok * 256 + h * 64 + d0) = v;
    }
  if (hi == 0) ((float*)(ws_ + OFF_LSE))[((size_t)di * T_ + tok) * 4 + h] = m * 0.6931471805599453f + __logf(lsum);
}

DI void pool_item(const Params& p, int l, int it, char* lds) {
  char* const ws_ = opq(p.ws);
  const int b = it & 7, qt = it >> 3, q0 = qt * 32;
  const int tid = tidx(), lane = tid & 63, g = tid >> 6, l31 = lane & 31, hi = lane >> 5;
  const u16* proj = (const u16*)(ws_ + OFF_PROJ);
  u16* cin = (u16*)lds;
  char* pl = lds + 48 * 512;
  u32x4 cv[6];
#pragma unroll
  for (int i = 0; i < 6; ++i) {
    const int c = tid + 256 * i, row = c >> 5, ch = c & 31; const int t = q0 - 16 + row;
    cv[i] = u32x4{0u, 0u, 0u, 0u};
    if (t >= 0) cv[i] = *(const u32x4*)(proj + ((size_t)b * S_ + t) * NP + C_CIN + ch * 8);
  }
  const u16* wpt = (const u16*)(ws_ + OFF_WPT) + (size_t)(l * 4 + g) * 4096;
  bf16x8 af[8];
#pragma unroll
  for (int q = 0; q < 8; ++q) af[q] = *(const bf16x8*)(wpt + ((q & 1) * 32 + l31) * 64 + 16 * (q >> 1) + 8 * hi);
  const size_t tok = (size_t)b * S_ + q0 + l31;
  f32x4 psv[8]; u32x2 zv[8];
#pragma unroll
  for (int q = 0; q < 8; ++q) {
    const int col = g * 64 + (q >> 2) * 32 + 8 * (q & 3) + 4 * hi;
    psv[q] = *(const f32x4*)(p.pool_scale + l * 256 + col); zv[q] = *(const u32x2*)(proj + tok * NP + C_CZ + col);
  }
  __syncthreads();
#pragma unroll
  for (int i = 0; i < 6; ++i) { const int c = tid + 256 * i, row = c >> 5, ch = c & 31; *(u32x4*)(cin + row * 256 + ch * 8) = cv[i]; }
  __syncthreads();
  {
    const int ch = tid, w = 2 << g;
    float s = 0.f;
    for (int r = 17 - w; r <= 16; ++r) s += bf2f(cin[r * 256 + ch]);
#pragma unroll 4
    for (int i = 0; i < 32; ++i) {
      const int t = q0 + i; const int cnt = (t + 1 < w) ? t + 1 : w;
      const float self = bf2f(cin[(i + 16) * 256 + ch]);
      *(u16*)(pl + i * 528 + ch * 2) = f2bf(s / (float)cnt - self);
      s += bf2f(cin[(i + 17) * 256 + ch]) - bf2f(cin[(i + 17 - w) * 256 + ch]);
    }
  }
  __syncthreads();
  f32x16 acc[2];
#pragma unroll
  for (int r = 0; r < 16; ++r) { acc[0][r] = 0.f; acc[1][r] = 0.f; }
#pragma unroll
  for (int s4 = 0; s4 < 4; ++s4) {
    const bf16x8 bf = *(const bf16x8*)(pl + l31 * 528 + (g * 64 + 16 * s4 + 8 * hi) * 2);
#pragma unroll
    for (int dt = 0; dt < 2; ++dt) acc[dt] = MFMA(af[s4 * 2 + dt], bf, acc[dt]);
  }
  u16* y = (u16*)(ws_ + OFF_XB);
#pragma unroll
  for (int dt = 0; dt < 2; ++dt)
#pragma unroll
    for (int g4 = 0; g4 < 4; ++g4) {
      const int col = g * 64 + dt * 32 + 8 * g4 + 4 * hi;
      const f32x4 ps = psv[dt * 4 + g4];
      const u32x2 z = zv[dt * 4 + g4];
      u32x2 v;
      v[0] = pk2(acc[dt][4 * g4] * ps[0] * siluf_(lo16(z[0])), acc[dt][4 * g4 + 1] * ps[1] * siluf_(hi16(z[0])));
      v[1] = pk2(acc[dt][4 * g4 + 2] * ps[2] * siluf_(lo16(z[1])), acc[dt][4 * g4 + 3] * ps[3] * siluf_(hi16(z[1])));
      *(u32x2*)(y + tok * 1024 + 512 + col) = v;
    }
}

DI void sgu_item(const Params& p, int l, int it, char* lds) {
  char* const ws_ = opq(p.ws);
  const int b = it & 7, c = (it >> 5) & 15, g = (it >> 3) & 3, t0 = c * 128;
  const int tid = tidx(), lane = tid & 63, l31 = lane & 31, hi = lane >> 5;
  const int wid = __builtin_amdgcn_readfirstlane(tid >> 6);
  const u16* proj = (const u16*)(ws_ + OFF_PROJ);
  char* vn = lds;
  __syncthreads();
  {
    const int j = tid >> 1, half = tid & 1;
    const u16* vp = proj + ((size_t)b * S_ + t0 + j) * NP + C_DV + half * 128;
    u32x4 raw[16];
#pragma unroll
    for (int i = 0; i < 16; ++i) raw[i] = *(const u32x4*)(vp + i * 8);
    float s1 = 0.f;
#pragma unroll
    for (int i = 0; i < 16; ++i)
#pragma unroll
      for (int e = 0; e < 4; ++e) s1 += lo16(raw[i][e]) + hi16(raw[i][e]);
    s1 += __shfl_xor(s1, 1, 64);
    const float mu = s1 * (1.f / 256.f);
    float s2 = 0.f;
#pragma unroll
    for (int i = 0; i < 16; ++i)
#pragma unroll
      for (int e = 0; e < 4; ++e) { const float a = lo16(raw[i][e]) - mu, bb = hi16(raw[i][e]) - mu; s2 += a * a + bb * bb; }
    s2 += __shfl_xor(s2, 1, 64);
    const float rstd = rsqrtf(s2 * (1.f / 256.f) + 1e-5f);
    if (half == (g >> 1)) {
      const float* lg = p.sg_ln_g + l * 256 + g * 64; const float* lb = p.sg_ln_b + l * 256 + g * 64;
      auto emit = [&](const u32x4& r, int i) {
        const f32x4 g0 = *(const f32x4*)(lg + i * 8), g1 = *(const f32x4*)(lg + i * 8 + 4), b0 = *(const f32x4*)(lb + i * 8), b1 = *(const f32x4*)(lb + i * 8 + 4);
        u32x4 o;
        o[0] = pk2((lo16(r[0]) - mu) * rstd * g0[0] + b0[0], (hi16(r[0]) - mu) * rstd * g0[1] + b0[1]);
        o[1] = pk2((lo16(r[1]) - mu) * rstd * g0[2] + b0[2], (hi16(r[1]) - mu) * rstd * g0[3] + b0[3]);
        o[2] = pk2((lo16(r[2]) - mu) * rstd * g1[0] + b1[0], (hi16(r[2]) - mu) * rstd * g1[1] + b1[1]);
        o[3] = pk2((lo16(r[3]) - mu) * rstd * g1[2] + b1[2], (hi16(r[3]) - mu) * rstd * g1[3] + b1[3]);
        *(u32x4*)(vn + j * 144 + i * 16) = o;
      };
      if (g & 1) {
#pragma unroll
        for (int i = 0; i < 8; ++i) emit(raw[8 + i], i);
      } else {
#pragma unroll
        for (int i = 0; i < 8; ++i) emit(raw[i], i);
      }
    }
  }
  __syncthreads();
  const int i = wid * 32 + l31;
  const u16* wsp = (const u16*)(ws_ + OFF_WSP) + ((size_t)(l * 4 + g) * 128 + i) * 128;
  f32x16 acc[2];
#pragma unroll
  for (int r = 0; r < 16; ++r) { acc[0][r] = 0.f; acc[1][r] = 0.f; }
  const int nks = 2 * (wid + 1);
  bf16x8 wfr[8];
#pragma unroll
  for (int s = 0; s < 8; ++s) { if (s < nks) wfr[s] = *(const bf16x8*)(wsp + 16 * s + 8 * hi); else wfr[s] = bf16x8{0, 0, 0, 0, 0, 0, 0, 0}; }
  const char* vb = vn + (8 * hi + ((lane & 15) >> 2)) * 144 + ((lane >> 4) & 1) * 32 + (lane & 3) * 8;
#pragma unroll
  for (int s = 0; s < 8; ++s) {
    if (s < nks) {
#pragma unroll
      for (int ct = 0; ct < 2; ++ct) {
        const s16x4 lo = trread(vb + (16 * s) * 144 + ct * 64), hh = trread(vb + (16 * s + 4) * 144 + ct * 64);
        const bf16x8 af = {lo[0], lo[1], lo[2], lo[3], hh[0], hh[1], hh[2], hh[3]};
        acc[ct] = MFMA(af, wfr[s], acc[ct]);
      }
    }
  }
  const size_t tok = (size_t)b * S_ + t0 + i;
  const float bs = p.b_sp[(l * 4 + g) * 128 + i];
  u16* y = (u16*)(ws_ + OFF_XB);
#pragma unroll
  for (int ct = 0; ct < 2; ++ct)
#pragma unroll
    for (int g4 = 0; g4 < 4; ++g4) {
      const int col = g * 64 + ct * 32 + 8 * g4 + 4 * hi;
      const u32x2 u = *(const u32x2*)(proj + tok * NP + C_DU + col), z = *(const u32x2*)(proj + tok * NP + C_DZ + col);
      u32x2 v;
      v[0] = pk2(lo16(u[0]) * (acc[ct][4 * g4] + bs) * siluf_(lo16(z[0])), hi16(u[0]) * (acc[ct][4 * g4 + 1] + bs) * siluf_(hi16(z[0])));
      v[1] = pk2(lo16(u[1]) * (acc[ct][4 * g4 + 2] + bs) * siluf_(lo16(z[1])), hi16(u[1]) * (acc[ct][4 * g4 + 3] + bs) * siluf_(hi16(z[1])));
      *(u32x2*)(y + tok * 1024 + 768 + col) = v;
    }
}

DI void nsa_item(const Params& p, int it, char* lds) {
  char* const ws_ = opq(p.ws);
  const int b = it & 7, qt = 63 - (it >> 3), q0 = qt * 32;
  const int tid = tidx(), lane = tid & 63, h = tid >> 6, l31 = lane & 31, hi = lane >> 5;
  const u16* proj = (const u16*)(ws_ + OFF_PROJ);
  const int t = q0 + l31; const size_t tok = (size_t)b * S_ + t;
  bf16x8 qr[4];
#pragma unroll
  for (int s = 0; s < 4; ++s) qr[s] = *(const bf16x8*)(proj + tok * NP + C_AQ + h * 64 + 16 * s + 8 * hi);
  char* ldsK = lds; char* ldsV = lds + 9216;
  float* impS = (float*)(lds + 36864);
  float* vals = (float*)(lds + 36864 + 16384);
  unsigned* selm = (unsigned*)(lds + 73728 - 256);
  int* jlist = (int*)(lds + 73728 - 128);
  float* yst = (float*)(lds + 36864);
  __syncthreads();
  if (tid < 32) selm[tid] = 0u;
  const float g0 = sigmoidf_(bf2f(proj[tok * NP + C_AG + 0 + h])), g1 = sigmoidf_(bf2f(proj[tok * NP + C_AG + 4 + h])), g2 = sigmoidf_(bf2f(proj[tok * NP + C_AG + 8 + h]));
  f32x16 ya[2];
  {
    const u16* kc = (const u16*)(ws_ + OFF_KC); const u16* vct = (const u16*)(ws_ + OFF_VCT);
    f32x16 sc[4];
    const int nkb = (((q0 + 31 - 31) >> 4) >> 5) + 1;
#pragma unroll
    for (int kb = 0; kb < 4; ++kb) {
#pragma unroll
      for (int r = 0; r < 16; ++r) sc[kb][r] = 0.f;
      if (kb < nkb) {
#pragma unroll
        for (int s = 0; s < 4; ++s) {
          const bf16x8 kf = *(const bf16x8*)(kc + ((size_t)(b * 128 + kb * 32 + l31)) * 64 + 16 * s + 8 * hi);
          sc[kb] = MFMA(kf, qr[s], sc[kb]);
        }
      }
    }
    s16x4 vcl[16], vch[16];
#pragma unroll
    for (int q = 0; q < 16; ++q) {
      const int kb = q >> 2, s2 = (q >> 1) & 1, db = q & 1;
      const u16* vp = vct + ((size_t)(b * 64 + 32 * db + l31)) * 128 + 32 * kb + 16 * s2 + 4 * hi;
      vcl[q] = s16x4{0, 0, 0, 0}; vch[q] = s16x4{0, 0, 0, 0};
      if (kb < nkb) { vcl[q] = *(const s16x4*)vp; vch[q] = *(const s16x4*)(vp + 8); }
    }
    const int nv = (t >= 31) ? ((t - 31) >> 4) : -1;
    float mx = NEGB;
#pragma unroll
    for (int kb = 0; kb < 4; ++kb)
#pragma unroll
      for (int r = 0; r < 16; ++r) { const int n = 32 * kb + crow(r, hi); const float v = (n <= nv) ? sc[kb][r] * C2 : NEGB; sc[kb][r] = v; mx = fmaxf(mx, v); }
    mx = fmaxf(mx, __shfl_xor(mx, 32, 64));
    float sum = 0.f;
#pragma unroll
    for (int kb = 0; kb < 4; ++kb)
#pragma unroll
      for (int r = 0; r < 16; ++r) { const int n = 32 * kb + crow(r, hi); const float e = (n <= nv) ? ex2(sc[kb][r] - mx) : 0.f; sc[kb][r] = e; sum += e; }
    sum += __shfl_xor(sum, 32, 64);
    const float inv = sum > 0.f ? 1.f / sum : 0.f;
#pragma unroll
    for (int kb = 0; kb < 4; ++kb)
#pragma unroll
      for (int r = 0; r < 16; ++r) sc[kb][r] *= inv;
    float* myimp = impS + (h * 32 + l31) * 32;
#pragma unroll
    for (int kb = 0; kb < 4; ++kb)
#pragma unroll
      for (int g = 0; g < 4; ++g) myimp[8 * kb + 2 * g + hi] = ((sc[kb][4 * g] + sc[kb][4 * g + 1]) + sc[kb][4 * g + 2]) + sc[kb][4 * g + 3];
    __syncthreads();
#pragma unroll
    for (int kb = 0; kb < 4; ++kb)
#pragma unroll
      for (int g = 0; g < 4; ++g) { const int j1 = 8 * kb + 2 * g + hi + 1; if (j1 < 32) myimp[j1] += sc[kb][4 * g + 3]; }
    f32x16 oc[2];
#pragma unroll
    for (int r = 0; r < 16; ++r) { oc[0][r] = 0.f; oc[1][r] = 0.f; }
#pragma unroll
    for (int kb = 0; kb < 4; ++kb)
#pragma unroll
      for (int s2 = 0; s2 < 2; ++s2) {
        if (kb >= nkb) continue;
        const bf16x8 pf = pack8(sc[kb], s2);
#pragma unroll
        for (int db = 0; db < 2; ++db) {
          const s16x4 lo = vcl[(kb * 2 + s2) * 2 + db], hh = vch[(kb * 2 + s2) * 2 + db];
          const bf16x8 vf = {lo[0], lo[1], lo[2], lo[3], hh[0], hh[1], hh[2], hh[3]};
          oc[db] = MFMA(vf, pf, oc[db]);
        }
      }
#pragma unroll
    for (int r = 0; r < 16; ++r) { ya[0][r] = oc[0][r] * g0; ya[1][r] = oc[1][r] * g0; }
  }
  __syncthreads();
  const int cur = q0 >> 6;
  {
    const int q = tid >> 3, sub = tid & 7;
#pragma unroll
    for (int jj = 0; jj < 4; ++jj) {
      const int j = sub * 4 + jj;
      float v = ((impS[(0 * 32 + q) * 32 + j] + impS[(1 * 32 + q) * 32 + j]) + impS[(2 * 32 + q) * 32 + j]) + impS[(3 * 32 + q) * 32 + j];
      const bool forced = (j == 0) || (j == cur) || (j == cur - 1);
      v = forced ? 1e4f : ((j <= cur) ? v : -1e4f);
      vals[q * 32 + j] = v;
    }
    __syncthreads();
    f32x4 vv[8];
#pragma unroll
    for (int i = 0; i < 8; ++i) vv[i] = *(const f32x4*)(vals + q * 32 + i * 4);
    unsigned bits = 0u;
#pragma unroll
    for (int jj = 0; jj < 4; ++jj) {
      const int j = sub * 4 + jj; const float v = vals[q * 32 + j];
      int cnt = 0;
#pragma unroll
      for (int j2 = 0; j2 < 32; ++j2) { const float w = vv[j2 >> 2][j2 & 3]; cnt += ((w > v) || (w == v && j2 < j)) ? 1 : 0; }
      if (cnt < 16 && j <= cur) bits |= 1u << j;
    }
    if (bits) atomicOr(&selm[q], bits);
  }
  __syncthreads();
  const unsigned mymask = selm[l31];
  unsigned anym = mymask, allm = mymask;
#pragma unroll
  for (int o = 16; o >= 1; o >>= 1) { anym |= (unsigned)__shfl_xor((int)anym, o, 64); allm &= (unsigned)__shfl_xor((int)allm, o, 64); }
  anym = __builtin_amdgcn_readfirstlane(anym);
  allm = __builtin_amdgcn_readfirstlane(allm);
  if (tid < 32) { if ((anym >> tid) & 1u) jlist[__builtin_popcount(anym & ((1u << tid) - 1u))] = tid; }
  f32x16 o[2];
#pragma unroll
  for (int r = 0; r < 16; ++r) { o[0][r] = 0.f; o[1][r] = 0.f; }
  float m = M_INIT, lsum = 0.f;
#pragma unroll
  for (int r = 0; r < 16; ++r) { yst[r * 256 + tid] = ya[0][r]; yst[(16 + r) * 256 + tid] = ya[1][r]; }
  __syncthreads();
  attn_stream(tid, proj, C_KSLC, C_VSLC, __builtin_popcount(anym),
              [&](int ti, int row) { return b * S_ + jlist[ti] * 64 + row; },
              [&](int ti) { const int jb = jlist[ti]; return (jb < cur) && ((allm >> jb) & 1u); },
              [&](int ti, int kr) { const int jb = jlist[ti]; return ((mymask >> jb) & 1u) && (jb * 64 + kr <= t); },
              qr, o, m, lsum, lds);
#pragma unroll
  for (int r = 0; r < 16; ++r) { ya[0][r] = yst[r * 256 + tid]; ya[1][r] = yst[(16 + r) * 256 + tid]; }
  lsum += __shfl_xor(lsum, 32, 64);
  const float il = g1 / lsum;
  const u16* ow = (const u16*)(ws_ + OFF_OWIN);
  u16* y = (u16*)(ws_ + OFF_XB);
#pragma unroll
  for (int db = 0; db < 2; ++db)
#pragma unroll
    for (int g = 0; g < 4; ++g) {
      const int col = h * 64 + 32 * db + 8 * g + 4 * hi;
      const u32x2 w = *(const u32x2*)(ow + tok * 256 + col), az = *(const u32x2*)(proj + tok * NP + C_AZ + col);
      const float v0 = (ya[db][4 * g] + o[db][4 * g] * il + g2 * lo16(w[0])) * siluf_(lo16(az[0]));
      const float v1 = (ya[db][4 * g + 1] + o[db][4 * g + 1] * il + g2 * hi16(w[0])) * siluf_(hi16(az[0]));
      const float v2 = (ya[db][4 * g + 2] + o[db][4 * g + 2] * il + g2 * lo16(w[1])) * siluf_(lo16(az[1]));
      const float v3 = (ya[db][4 * g + 3] + o[db][4 * g + 3] * il + g2 * hi16(w[1])) * siluf_(hi16(az[1]));
      u32x2 v; v[0] = pk2(v0, v1); v[1] = pk2(v2, v3);
      *(u32x2*)(y + tok * 1024 + col) = v;
    }
}

DI void dilcomb_item(const Params& p, int it) {
  char* const ws_ = opq(p.ws);
  const u16* proj = (const u16*)(ws_ + OFF_PROJ);
  const u16* od = (const u16*)(ws_ + OFF_ODIL);
  const float* lse = (const float*)(ws_ + OFF_LSE);
  u16* y = (u16*)(ws_ + OFF_XB);
#pragma unroll
  for (int i = 0; i < 4; ++i) {
    const int idx = it * 1024 + i * 256 + threadIdx.x;
    const size_t tok = idx >> 5; const int c8 = idx & 31, h = c8 >> 3;
    const float l0 = lse[((size_t)0 * T_ + tok) * 4 + h], l1 = lse[((size_t)1 * T_ + tok) * 4 + h], l2 = lse[((size_t)2 * T_ + tok) * 4 + h];
    const float mx = fmaxf(l0, fmaxf(l1, l2));
    float w0 = __expf(l0 - mx), w1 = __expf(l1 - mx), w2 = __expf(l2 - mx);
    const float iw = 1.f / (w0 + w1 + w2); w0 *= iw; w1 *= iw; w2 *= iw;
    const u32x4 a = *(const u32x4*)(od + ((size_t)0 * T_ + tok) * 256 + c8 * 8), bq = *(const u32x4*)(od + ((size_t)1 * T_ + tok) * 256 + c8 * 8), cq = *(const u32x4*)(od + ((size_t)2 * T_ + tok) * 256 + c8 * 8);
    const u32x4 z = *(const u32x4*)(proj + tok * NP + C_BZ + c8 * 8);
    u32x4 r;
#pragma unroll
    for (int e = 0; e < 4; ++e) {
      const float v0 = (w0 * lo16(a[e]) + w1 * lo16(bq[e]) + w2 * lo16(cq[e])) * siluf_(lo16(z[e]));
      const float v1 = (w0 * hi16(a[e]) + w1 * hi16(bq[e]) + w2 * hi16(cq[e])) * siluf_(hi16(z[e]));
      r[e] = pk2(v0, v1);
    }
    *(u32x4*)(y + tok * 1024 + 256 + c8 * 8) = r;
  }
}

__global__ void __launch_bounds__(256, 2) hybrid_megakernel(Params p) {
  __shared__ __attribute__((aligned(16))) char lds[73728];
  __shared__ uint4 xb_words;
  cg::grid_group grid = cg::this_grid();
  char* const ws_ = p.ws;
  if (p.ws == nullptr) grid.sync();
  if (threadIdx.x == 0) xb_words = make_uint4(0u, 0u, 0u, 0u);
  __syncthreads();
  const XcdBarrier xb = xcd_barrier_post((unsigned*)(ws_ + OFF_BAR), (volatile LAS unsigned*)&xb_words);
  const int nb = gridDim.x, bid = blockIdx.x;
  const int wid = threadIdx.x >> 6;
  for (int it = bid; it < 3328 + 1024 + 1024 + 32 + 16 + 64; it += nb) {
    if (it < 3328) { const int l = it / 832, r = it % 832, ntile = r >> 4, ktile = r & 15;
      tr_tile(p.w_in + (size_t)l * 1024 * 3212, 3212, (u16*)(ws_ + OFF_WIN) + (size_t)l * NP * 1024, 1024, ktile * 64, ntile * 64, p.g_pre + l * 1024, 1, lds); }
    else if (it < 4352) { const int i2 = it - 3328, l = i2 >> 8, r = i2 & 255, ntile = r >> 4, ktile = r & 15;
      tr_tile(p.w_out + (size_t)l * 1024 * 1024, 1024, (u16*)(ws_ + OFF_WOUT) + (size_t)l * 1024 * 1024, 1024, ktile * 64, ntile * 64, nullptr, 0, lds); }
    else if (it < 5376) { const int i2 = it - 4352, mtx = i2 >> 7, r = i2 & 127, ntile = r >> 5, ktile = r & 31;
      tr_tile(p.w_cmp1 + (size_t)mtx * 2048 * 256, 256, (u16*)(ws_ + OFF_W1) + (size_t)mtx * 256 * 2048, 2048, ktile * 64, ntile * 64, nullptr, 0, lds); }
    else if (it < 5408) { const int i2 = it - 5376, mtx = i2 >> 2, ktile = i2 & 3;
      tr_tile(p.w_cmp2 + (size_t)mtx * 256 * 64, 64, (u16*)(ws_ + OFF_W2) + (size_t)mtx * 64 * 256, 256, ktile * 64, 0, nullptr, 0, lds); }
    else if (it < 5424) { const int mtx = it - 5408;
      tr_tile(p.w_pool + (size_t)mtx * 4096, 64, (u16*)(ws_ + OFF_WPT) + (size_t)mtx * 4096, 64, 0, 0, nullptr, 0, lds); }
    else { const int i2 = it - 5424, mtx = i2 >> 2, qd = i2 & 3;
      const float* src = p.w_sp + (size_t)mtx * 16384 + qd * 4096; u16* dst = (u16*)(ws_ + OFF_WSP) + (size_t)mtx * 16384 + qd * 4096;
      f32x4 v[4];
#pragma unroll
      for (int k = 0; k < 4; ++k) v[k] = *(const f32x4*)(src + (threadIdx.x + 256 * k) * 4);
#pragma unroll
      for (int k = 0; k < 4; ++k) {
        const int e = qd * 4096 + (threadIdx.x + 256 * k) * 4, i = e >> 7, j = e & 127;
        u32x2 o; o[0] = pk2(j <= i ? v[k][0] : 0.f, j + 1 <= i ? v[k][1] : 0.f); o[1] = pk2(j + 2 <= i ? v[k][2] : 0.f, j + 3 <= i ? v[k][3] : 0.f);
        *(u32x2*)(dst + (threadIdx.x + 256 * k) * 4) = o;
      } }
  }
  for (int it = bid; it < T_ / 16; it += nb) {
    const int row = it * 16 + wid * 4;
    rows_convert<4>(p.x + (size_t)row * 1024, (u16*)(ws_ + OFF_XB) + (size_t)row * 1024, (float*)(ws_ + OFF_RN) + row);
  }
  xcd_barrier(xb);
  for (int l = 0; l < 4; ++l) {
    for (int it = bid; it < 1536 + 256; it += nb) {
      if (it < 1536) { const int q = it >> 3; inproj_tile<4>(p, l, (it & 7) * 16 + (q & 15), q >> 4, lds); }
      else { const int i2 = it - 1536, q = i2 >> 3; inproj_tile<2>(p, l, (i2 & 7) * 16 + (q & 15), 24 + (q >> 4), lds); }
    }
    xcd_barrier(xb);
    for (int vb = bid; vb < 512; vb += nb) {
      if (vb < 64) cmp_item(p, l, vb, lds);
      else {
        const int j = vb - 64;
        win_item(p, j, lds);
        if (j + 448 < 512) win_item(p, j + 448, lds);
        for (int it = j; it < 1536; it += 448) dil_item(p, it, lds);
      }
    }
    xcd_barrier(xb);
    for (int vb = bid; vb < 512; vb += nb) {
      nsa_item(p, vb, lds);
      const int gi = vb >> 4;
      int start = 0, mine = 0;
      for (int g2 = 0; g2 <= gi; ++g2) {
        const int n = 32 - g2;
        const int d = (n <= 10) ? 2 : (n <= 22) ? 1 : 0;
        if (g2 < gi) start += 16 * d; else mine = d;
      }
      start += (vb & 15) * mine;
      for (int k = 0; k < mine; ++k) { sgu_item(p, l, start + k, lds); pool_item(p, l, start + k, lds); dilcomb_item(p, start + k); }
    }
    xcd_barrier(xb);
    for (int it = bid; it < 512; it += nb) outproj_item(p, l, it, lds);
    xcd_barrier(xb);
    const float* xin = (l == 0) ? p.x : p.out;
    for (int it = bid; it < T_ / 16; it += nb) resid_rows<4>(p, l, it * 16 + wid * 4, xin);
    if (l < 3) xcd_barrier(xb);
  }
}

extern "C" void kernel_launch(void* const* d_in, const int* in_sizes, int n_in, void* d_out, int out_size, void* d_ws, size_t ws_size, hipStream_t stream) {
  static int grid_blocks = 0;
  if (!grid_blocks) {
    int dev = 0, cus = 0, per_cu = 0;
    hipGetDevice(&dev);
    hipDeviceGetAttribute(&cus, hipDeviceAttributeMultiprocessorCount, dev);
    hipOccupancyMaxActiveBlocksPerMultiprocessor(&per_cu, hybrid_megakernel, 256, 0);
    if (per_cu > 2) per_cu = 2;
    if (per_cu < 1) per_cu = 1;
    grid_blocks = cus * per_cu;
  }
  if (ws_size < WS_TOTAL) { fprintf(stderr, "workspace too small: %zu < %zu\n", ws_size, (size_t)WS_TOTAL); return; }
  Params p{};
  p.x = (const float*)d_in[0]; p.g_pre = (const float*)d_in[1]; p.w_in = (const float*)d_in[2]; p.pe_cmp = (const float*)d_in[3];
  p.w_cmp1 = (const float*)d_in[4]; p.w_cmp2 = (const float*)d_in[5]; p.w_pool = (const float*)d_in[6]; p.pool_scale = (const float*)d_in[7];
  p.sg_ln_g = (const float*)d_in[8]; p.sg_ln_b = (const float*)d_in[9]; p.w_sp = (const float*)d_in[10]; p.b_sp = (const float*)d_in[11];
  p.w_out = (const float*)d_in[12]; p.g_post = (const float*)d_in[13];
  p.out = (float*)d_out; p.ws = (char*)d_ws;
  hipMemsetAsync((char*)d_ws + OFF_BAR, 0, 16384, stream);
  void* args[] = {&p};
  hipError_t e = hipLaunchCooperativeKernel((void*)hybrid_megakernel, dim3(grid_blocks), dim3(256), args, 0, stream);
  if (e != hipSuccess) fprintf(stderr, "cooperative launch failed: %s (grid %d)\n", hipGetErrorString(e), grid_blocks);
}
```

```cpp
#include <hip/hip_runtime.h>
#include <hip/hip_cooperative_groups.h>
#include <cstdio>
namespace cg = cooperative_groups;

typedef unsigned short u16;
using bf16x8 = __attribute__((ext_vector_type(8))) short;
using s16x4 = __attribute__((ext_vector_type(4))) short;
using f32x16 = __attribute__((ext_vector_type(16))) float;
using f32x4 = __attribute__((ext_vector_type(4))) float;
using u32x4 = __attribute__((ext_vector_type(4))) unsigned;
using u32x2 = __attribute__((ext_vector_type(2))) unsigned;
typedef short v4i16_t __attribute__((ext_vector_type(4)));
#define DI __device__ __forceinline__
#define MFMA(a, b, c) __builtin_amdgcn_mfma_f32_32x32x16_bf16((a), (b), (c), 0, 0, 0)

constexpr int T_ = 16384, S_ = 2048, NP = 3328;
constexpr float C2 = 0.125f * 1.4426950408889634f;
constexpr float NEGB = -1e30f;

constexpr int C_AQ = 0, C_KCMP = 256, C_KSLC = 384, C_VSLC = 448, C_KWIN = 512, C_VWIN = 576, C_AZ = 640;
constexpr int C_BQ = 896, C_BK = 1152, C_BV = 1408, C_BZ = 1664, C_CIN = 1920, C_CZ = 2176, C_DU = 2432, C_DV = 2688, C_DZ = 2944, C_AG = 3200;

constexpr size_t al(size_t x) { return (x + 255) & ~(size_t)255; }
constexpr size_t OFF_WIN = 0;
constexpr size_t OFF_WOUT = OFF_WIN + al((size_t)4 * NP * 1024 * 2);
constexpr size_t OFF_W1 = OFF_WOUT + al((size_t)4 * 1024 * 1024 * 2);
constexpr size_t OFF_W2 = OFF_W1 + al((size_t)4 * 2 * 256 * 2048 * 2);
constexpr size_t OFF_XB = OFF_W2 + al((size_t)4 * 2 * 64 * 256 * 2);
constexpr size_t OFF_RN = OFF_XB + al((size_t)T_ * 1024 * 2);
constexpr size_t OFF_PROJ = OFF_RN + al((size_t)T_ * 4);
constexpr size_t OFF_SSQ = OFF_PROJ + al((size_t)T_ * NP * 2);
constexpr size_t OFF_KC = OFF_SSQ + al((size_t)T_ * 16 * 4);
constexpr size_t OFF_VCT = OFF_KC + al((size_t)8 * 128 * 64 * 2);
constexpr size_t OFF_OWIN = OFF_VCT + al((size_t)8 * 128 * 64 * 2);
constexpr size_t OFF_ODIL = OFF_OWIN + al((size_t)T_ * 256 * 2);
constexpr size_t OFF_LSE = OFF_ODIL + al((size_t)3 * T_ * 256 * 2);
constexpr size_t OFF_WPT = OFF_LSE + al((size_t)3 * T_ * 4 * 4);
constexpr size_t OFF_WSP = OFF_WPT + al((size_t)16 * 64 * 64 * 2);
constexpr size_t OFF_OUTB = OFF_WSP + al((size_t)16 * 128 * 128 * 2);
constexpr size_t OFF_BAR = OFF_OUTB + al((size_t)T_ * 1024 * 2);
constexpr size_t WS_TOTAL = OFF_BAR + 16384;
static_assert(WS_TOTAL <= (size_t)256 * 1024 * 1024, "workspace layout exceeds the guaranteed 256 MiB");

struct Params {
  const float *x, *g_pre, *w_in, *pe_cmp, *w_cmp1, *w_cmp2, *w_pool, *pool_scale, *sg_ln_g, *sg_ln_b, *w_sp, *b_sp, *w_out, *g_post;
  float* out;
  char* ws;
};

DI char* opq(char* q) { size_t z = 0; asm volatile("" : "+s"(z)); return q + z; }
DI int tidx() { int t = threadIdx.x; asm volatile("" : "+v"(t)); return t; }
DI float bf2f(u16 v) { return __uint_as_float((unsigned)v << 16); }
DI unsigned pk2(float a, float b) {
  typedef __bf16 bf2 __attribute__((ext_vector_type(2)));
  typedef float f2 __attribute__((ext_vector_type(2)));
  f2 v = {a, b};
  bf2 r = __builtin_convertvector(v, bf2);
  return __builtin_bit_cast(unsigned, r);
}
DI u16 f2bf(float x) { return (u16)(pk2(x, 0.f) & 0xffffu); }
DI float lo16(unsigned w) { return __uint_as_float(w << 16); }
DI float hi16(unsigned w) { return __uint_as_float(w & 0xffff0000u); }
DI int crow(int r, int hi) { return (r & 3) + 8 * (r >> 2) + 4 * hi; }
DI float ex2(float x) { return __builtin_amdgcn_exp2f(x); }
DI float sigmoidf_(float x) { return 1.f / (1.f + __expf(-x)); }
DI float siluf_(float x) { return x / (1.f + __expf(-x)); }
DI float wave_sum(float v) {
#pragma unroll
  for (int o = 32; o >= 1; o >>= 1) v += __shfl_xor(v, o, 64);
  return v;
}
DI bf16x8 pack8(const f32x16& x, int s8) {
  u32x4 p;
  p[0] = pk2(x[8 * s8 + 0], x[8 * s8 + 1]); p[1] = pk2(x[8 * s8 + 2], x[8 * s8 + 3]);
  p[2] = pk2(x[8 * s8 + 4], x[8 * s8 + 5]); p[3] = pk2(x[8 * s8 + 6], x[8 * s8 + 7]);
  return __builtin_bit_cast(bf16x8, p);
}
DI s16x4 trread(const char* p) {
  return __builtin_bit_cast(s16x4, __builtin_amdgcn_ds_read_tr16_b64_v4i16((__attribute__((address_space(3))) v4i16_t*)p));
}


#define XB_TMO      128
#define XB_XCNT(j)  (256  + 64 * (j))
#define XB_XSUB(j)  (1280 + 64 * (j))
#define XB_XGEN(j)  (2304 + 64 * (j))
#define XB_TOP      3328
#define XB_TOPGEN   3392
#define XCD_BAR_WORDS 3456
#define XB_SPIN_CAP (1u << 22)
#define LAS __attribute__((address_space(3)))
DI unsigned xb_ld(unsigned* p)              { return __hip_atomic_load(p, __ATOMIC_RELAXED, __HIP_MEMORY_SCOPE_AGENT); }
DI unsigned xb_add(unsigned* p, unsigned v) { return __hip_atomic_fetch_add(p, v, __ATOMIC_RELAXED, __HIP_MEMORY_SCOPE_AGENT); }
DI unsigned xb_xcc_id() { return (unsigned)__builtin_amdgcn_s_getreg((3 << 11) | 20) & 0xFu; }
#define XB_SPIN(cond, bar) do { unsigned _sp = 0; while (cond) { __builtin_amdgcn_s_sleep(1); \
    if ((++_sp & 255u) == 0u) { if (xb_ld(&(bar)[XB_TMO])) break; if (_sp > XB_SPIN_CAP) { atomicAdd(&(bar)[XB_TMO], 1u); break; } } } } while (0)
struct XcdBarrier { unsigned* bar; unsigned x; volatile LAS unsigned* st; };
DI XcdBarrier xcd_barrier_post(unsigned* bar, volatile LAS unsigned* st) {
    XcdBarrier b; b.bar = bar; b.x = xb_xcc_id(); b.st = st;
    if (threadIdx.x == 0) (void)xb_add(&bar[XB_XCNT(b.x)], 1u);
    return b;
}
DI void xcd_barrier_complete(unsigned* bar, unsigned x, unsigned& nloc, unsigned& nx) {
    const unsigned G = gridDim.x * gridDim.y * gridDim.z;
    unsigned sum, cnt, mine, sp = 0u;
    for (;;) {
        sum = 0u; cnt = 0u; mine = 0u;
#pragma unroll
        for (unsigned j = 0; j < 16; ++j) { const unsigned c = xb_ld(&bar[XB_XCNT(j)]); sum += c; cnt += (c > 0u) ? 1u : 0u; mine = (j == x) ? c : mine; }
        if (sum == G) break;
        __builtin_amdgcn_s_sleep(1);
        if ((++sp & 255u) == 0u) { if (xb_ld(&bar[XB_TMO])) break; if (sp > XB_SPIN_CAP) { atomicAdd(&bar[XB_TMO], 1u); break; } }
    }
    nloc = mine > 0u ? mine : 1u; nx = cnt > 0u ? cnt : 1u;
}
DI void xcd_barrier(const XcdBarrier& b) {
    asm volatile("s_waitcnt vmcnt(0)" ::: "memory");
    __syncthreads();
    if (threadIdx.x == 0) {
        unsigned* bar = b.bar;
        __builtin_amdgcn_s_waitcnt(0);
        unsigned nloc = b.st[0], nx = b.st[1];
        if (nloc == 0u) { xcd_barrier_complete(bar, b.x, nloc, nx); b.st[0] = nloc; b.st[1] = nx; }
        const unsigned old = xb_add(&bar[XB_XSUB(b.x)], 1u);
        const unsigned gen = old / nloc;
        if (old + 1u == (gen + 1u) * nloc) {
            __builtin_amdgcn_fence(__ATOMIC_RELEASE, "agent");
            asm volatile("s_waitcnt vmcnt(0)" ::: "memory");
            const unsigned og = xb_add(&bar[XB_TOP], 1u);
            const unsigned tg = og / nx;
            if (og + 1u == (tg + 1u) * nx) xb_add(&bar[XB_TOPGEN], 1u);
            else XB_SPIN(xb_ld(&bar[XB_TOPGEN]) == tg, bar);
            __builtin_amdgcn_fence(__ATOMIC_ACQUIRE, "agent");
            xb_add(&bar[XB_XGEN(b.x)], 1u);
            asm volatile("s_waitcnt vmcnt(0)" ::: "memory");
        } else {
            XB_SPIN(xb_ld(&bar[XB_XGEN(b.x)]) == gen, bar);
            __builtin_amdgcn_fence(__ATOMIC_ACQUIRE, "agent");
            asm volatile("s_waitcnt vmcnt(0)" ::: "memory");
        }
    }
    __syncthreads();
}

template <int WGN, int INS, int IMS, bool DB, class LdW, class LdX>
DI void gemm_core(f32x16 (&acc)[INS][IMS], const int KT, LdW ldw, LdX ldx, char* lds, const int tid) {
  constexpr int WGM = 4 / WGN;
  constexpr int WROWS = WGN * 32 * INS, XROWS = WGM * 32 * IMS, NROWS = WROWS + XROWS, NCH = NROWS / 32, NCHW = WROWS / 32, BUFB = NROWS * 144;
  const int lane = tid & 63, wid = tid >> 6, l31 = lane & 31, hi = lane >> 5;
  const int wn = (WGN == 2) ? (wid >> 1) : wid, wm = (WGN == 2) ? (wid & 1) : 0;
  const int offa = (wn * 32 * INS + l31) * 144 + hi * 16;
  const int offb = (WROWS + wm * 32 * IMS + l31) * 144 + hi * 16;
#pragma unroll
  for (int a = 0; a < INS; ++a)
#pragma unroll
    for (int b = 0; b < IMS; ++b)
#pragma unroll
      for (int r = 0; r < 16; ++r) acc[a][b][r] = 0.f;
#define GLOAD(dst, kt_) _Pragma("unroll") for (int i = 0; i < NCH; ++i) { dst[i] = (i < NCHW) ? ldw(i, tid >> 3, (kt_) * 64 + (tid & 7) * 8) : ldx(i - NCHW, tid >> 3, (kt_) * 64 + (tid & 7) * 8); }
#define LSTORE(src, base) _Pragma("unroll") for (int i = 0; i < NCH; ++i) { const int c = tid + 256 * i; *(u32x4*)((base) + (c >> 3) * 144 + (c & 7) * 16) = src[i]; }
#define COMPUTE_PIPE(buf) { const char* pa = (buf) + offa; const char* pb = (buf) + offb; \
    bf16x8 fa[2][INS], fb[2][IMS]; \
    _Pragma("unroll") for (int in = 0; in < INS; ++in) fa[0][in] = *(const bf16x8*)(pa + in * 32 * 144); \
    _Pragma("unroll") for (int im = 0; im < IMS; ++im) fb[0][im] = *(const bf16x8*)(pb + im * 32 * 144); \
    _Pragma("unroll") for (int s = 0; s < 4; ++s) { \
      if (s < 3) { _Pragma("unroll") for (int in = 0; in < INS; ++in) fa[(s + 1) & 1][in] = *(const bf16x8*)(pa + in * 32 * 144 + (s + 1) * 32); \
        _Pragma("unroll") for (int im = 0; im < IMS; ++im) fb[(s + 1) & 1][im] = *(const bf16x8*)(pb + im * 32 * 144 + (s + 1) * 32); } \
      _Pragma("unroll") for (int im = 0; im < IMS; ++im) _Pragma("unroll") for (int in = 0; in < INS; ++in) \
        acc[in][im] = MFMA(fa[s & 1][in], fb[s & 1][im], acc[in][im]); } }
#define COMPUTE_FLAT(buf) { const char* pa = (buf) + offa; const char* pb = (buf) + offb; \
    _Pragma("unroll") for (int s = 0; s < 4; ++s) { \
      bf16x8 fa[INS], fb[IMS]; \
      _Pragma("unroll") for (int in = 0; in < INS; ++in) fa[in] = *(const bf16x8*)(pa + in * 32 * 144 + s * 32); \
      _Pragma("unroll") for (int im = 0; im < IMS; ++im) fb[im] = *(const bf16x8*)(pb + im * 32 * 144 + s * 32); \
      _Pragma("unroll") for (int im = 0; im < IMS; ++im) _Pragma("unroll") for (int in = 0; in < INS; ++in) \
        acc[in][im] = MFMA(fa[in], fb[im], acc[in][im]); } }
  if (DB) {
    u32x4 preA[NCH], preB[NCH];
    GLOAD(preA, 0)
    GLOAD(preB, 1)
    __syncthreads();
    LSTORE(preA, lds)
    __syncthreads();
    for (int kt = 0; kt < KT; kt += 2) {
      if (kt + 2 < KT) { GLOAD(preA, kt + 2) }
      COMPUTE_PIPE(lds)
      LSTORE(preB, lds + BUFB)
      __syncthreads();
      if (kt + 3 < KT) { GLOAD(preB, kt + 3) }
      COMPUTE_PIPE(lds + BUFB)
      if (kt + 2 < KT) { LSTORE(preA, lds) }
      __syncthreads();
    }
  } else {
    u32x4 pre[NCH];
    GLOAD(pre, 0)
    for (int kt = 0; kt < KT; ++kt) {
      __syncthreads();
      LSTORE(pre, lds)
      __syncthreads();
      if (kt + 1 < KT) { GLOAD(pre, kt + 1) }
      if (INS >= 4) COMPUTE_FLAT(lds) else COMPUTE_PIPE(lds)
    }
  }
#undef GLOAD
#undef LSTORE
#undef COMPUTE_PIPE
#undef COMPUTE_FLAT
}

constexpr float M_INIT = -1e29f;
template <class MaskF>
DI void attn_tile(const int tid, const char* ldsK, const char* ldsV, const bf16x8 (&qr)[4], f32x16 (&o)[2], float& m, float& l, const bool MASKED, MaskF mask) {
  const int lane = tid & 63, l31 = lane & 31, hi = lane >> 5;
  f32x16 p0, p1;
#pragma unroll
  for (int r = 0; r < 16; ++r) { p0[r] = 0.f; p1[r] = 0.f; }
  const char* kp = ldsK + l31 * 144 + hi * 16;
#pragma unroll
  for (int s = 0; s < 4; ++s) {
    const bf16x8 k0 = *(const bf16x8*)(kp + s * 32), k1 = *(const bf16x8*)(kp + 32 * 144 + s * 32);
    p0 = MFMA(k0, qr[s], p0); p1 = MFMA(k1, qr[s], p1);
  }
  if (MASKED) {
#pragma unroll
    for (int r = 0; r < 16; ++r) {
      const int kr = crow(r, hi);
      p0[r] = mask(kr) ? p0[r] : NEGB; p1[r] = mask(kr + 32) ? p1[r] : NEGB;
    }
  }
  const char* vb = ldsV + (4 * hi + ((lane & 15) >> 2)) * 144 + ((lane >> 4) & 1) * 32 + (lane & 3) * 8;
  s16x4 vlo[8], vhi[8];
#pragma unroll
  for (int s4 = 0; s4 < 4; ++s4)
#pragma unroll
    for (int db = 0; db < 2; ++db) { vlo[s4 * 2 + db] = trread(vb + (16 * s4) * 144 + db * 64); vhi[s4 * 2 + db] = trread(vb + (16 * s4 + 8) * 144 + db * 64); }
  __builtin_amdgcn_sched_barrier(0);
  float mx = fmaxf(p0[0], p1[0]);
#pragma unroll
  for (int r = 1; r < 16; ++r) mx = fmaxf(fmaxf(mx, p0[r]), p1[r]);
  { auto rr = __builtin_amdgcn_permlane32_swap(__float_as_uint(mx), __float_as_uint(mx), false, false); mx = fmaxf(__uint_as_float(rr[0]), __uint_as_float(rr[1])); }
  const float mxs = mx * C2;
  if (__any(mxs > m + 8.f)) {
    const float mn = fmaxf(m, mxs), alpha = ex2(m - mn);
    m = mn; l *= alpha;
#pragma unroll
    for (int r = 0; r < 16; ++r) { o[0][r] *= alpha; o[1][r] *= alpha; }
  }
  const float nm = -m;
  float rs = 0.f;
#pragma unroll
  for (int r = 0; r < 16; ++r) { p0[r] = ex2(__builtin_fmaf(p0[r], C2, nm)); p1[r] = ex2(__builtin_fmaf(p1[r], C2, nm)); rs += p0[r] + p1[r]; }
  l += rs;
  bf16x8 pw[4];
  pw[0] = pack8(p0, 0); pw[1] = pack8(p0, 1); pw[2] = pack8(p1, 0); pw[3] = pack8(p1, 1);
#pragma unroll
  for (int s4 = 0; s4 < 4; ++s4) {
#pragma unroll
    for (int db = 0; db < 2; ++db) {
      const s16x4 lo = vlo[s4 * 2 + db], hh = vhi[s4 * 2 + db];
      const bf16x8 vf = {lo[0], lo[1], lo[2], lo[3], hh[0], hh[1], hh[2], hh[3]};
      o[db] = MFMA(vf, pw[s4], o[db]);
    }
  }
}

template <class RowF>
DI void kv_load(const int tid, u32x4 (&pre)[4], RowF rowtok, const u16* proj, int kcol, int vcol) {
#pragma unroll
  for (int i = 0; i < 2; ++i) {
    const int c = tid + 256 * i, row = c >> 3, ch = c & 7;
    const u16* p = proj + (size_t)rowtok(row) * NP + ch * 8;
    pre[i] = *(const u32x4*)(p + kcol); pre[2 + i] = *(const u32x4*)(p + vcol);
  }
}
DI void kv_store(const int tid, const u32x4 (&pre)[4], char* ldsK, char* ldsV) {
#pragma unroll
  for (int i = 0; i < 2; ++i) {
    const int c = tid + 256 * i, row = c >> 3, ch = c & 7;
    *(u32x4*)(ldsK + row * 144 + ch * 16) = pre[i]; *(u32x4*)(ldsV + row * 144 + ch * 16) = pre[2 + i];
  }
}

template <class RowF, class FullF, class MaskF>
DI void attn_stream(const int tid, const u16* proj, const int kcol, const int vcol, const int nt, RowF rowtok, FullF full, MaskF mask,
                    const bf16x8 (&qr)[4], f32x16 (&o)[2], float& m, float& l, char* lds) {
  u32x4 preA[4], preB[4];
  if (nt > 0) kv_load(tid, preA, [&](int row) { return rowtok(0, row); }, proj, kcol, vcol);
  if (nt > 1) kv_load(tid, preB, [&](int row) { return rowtok(1, row); }, proj, kcol, vcol);
  for (int ti = 0; ti < nt; ti += 2) {
    kv_store(tid, preA, lds, lds + 9216);
    __syncthreads();
    if (ti + 2 < nt) kv_load(tid, preA, [&](int row) { return rowtok(ti + 2, row); }, proj, kcol, vcol);
    attn_tile(tid, lds, lds + 9216, qr, o, m, l, !full(ti), [&](int kr) { return mask(ti, kr); });
    if (ti + 1 < nt) {
      kv_store(tid, preB, lds + 18432, lds + 27648);
      __syncthreads();
      if (ti + 3 < nt) kv_load(tid, preB, [&](int row) { return rowtok(ti + 3, row); }, proj, kcol, vcol);
      attn_tile(tid, lds + 18432, lds + 27648, qr, o, m, l, !full(ti + 1), [&](int kr) { return mask(ti + 1, kr); });
    }
  }
}

DI int mapcol(int n, int mode) {
  if (mode == 0) return n;
  if (n < 640) return n;
  if (n < 3200) return n + 12;
  if (n < 3212) return n - 3200 + 640;
  return -1;
}
DI void tr_tile(const float* src, int ldsrc, u16* dst, int ldd, int k0, int n0, const float* g, int mode, char* lds) {
  float* t = (float*)lds;
  const int tid = threadIdx.x;
  float v[16];
#pragma unroll
  for (int i = 0; i < 16; ++i) {
    const int e = tid + 256 * i, kk = e >> 6, nn = e & 63;
    const int sc = mapcol(n0 + nn, mode);
    v[i] = sc >= 0 ? src[(size_t)(k0 + kk) * ldsrc + sc] : 0.f;
  }
  if (g) {
#pragma unroll
    for (int i = 0; i < 16; ++i) v[i] *= g[k0 + ((tid + 256 * i) >> 6)];
  }
#pragma unroll
  for (int i = 0; i < 16; ++i) { const int e = tid + 256 * i, kk = e >> 6, nn = e & 63; t[kk * 65 + nn] = v[i]; }
  __syncthreads();
#pragma unroll
  for (int i = 0; i < 2; ++i) {
    const int e = tid + 256 * i, nn = e >> 3, k8 = (e & 7) * 8;
    u32x4 o;
    o[0] = pk2(t[(k8 + 0) * 65 + nn], t[(k8 + 1) * 65 + nn]); o[1] = pk2(t[(k8 + 2) * 65 + nn], t[(k8 + 3) * 65 + nn]);
    o[2] = pk2(t[(k8 + 4) * 65 + nn], t[(k8 + 5) * 65 + nn]); o[3] = pk2(t[(k8 + 6) * 65 + nn], t[(k8 + 7) * 65 + nn]);
    *(u32x4*)(dst + (size_t)(n0 + nn) * ldd + k0 + k8) = o;
  }
  __syncthreads();
}

template <int NR>
DI void rows_convert(const float* x0, u16* xb0, float* rn0) {
  const int lane = tidx() & 63;
  f32x4 v[NR][4];
#pragma unroll
  for (int r = 0; r < NR; ++r)
#pragma unroll
    for (int i = 0; i < 4; ++i) v[r][i] = *(const f32x4*)(x0 + (size_t)r * 1024 + i * 256 + lane * 4);
#pragma unroll
  for (int r = 0; r < NR; ++r) {
    float ss = 0.f;
#pragma unroll
    for (int i = 0; i < 4; ++i) {
      ss += v[r][i][0] * v[r][i][0] + v[r][i][1] * v[r][i][1] + v[r][i][2] * v[r][i][2] + v[r][i][3] * v[r][i][3];
      u32x2 o; o[0] = pk2(v[r][i][0], v[r][i][1]); o[1] = pk2(v[r][i][2], v[r][i][3]);
      *(u32x2*)(xb0 + (size_t)r * 1024 + i * 256 + lane * 4) = o;
    }
    ss = wave_sum(ss);
    if (lane == 0) rn0[r] = rsqrtf(ss * (1.f / 1024.f) + 1e-6f);
  }
}

template <int NTW>
DI void inproj_tile(const Params& p, int l, int mt, int ntile, char* lds) {
  char* const ws_ = opq(p.ws);
  const u16* W = (const u16*)(ws_ + OFF_WIN) + ((size_t)l * NP + ntile * 64 * NTW) * 1024;
  const u16* X = (const u16*)(ws_ + OFF_XB) + (size_t)mt * 128 * 1024;
  f32x16 acc[NTW][2];
  const int tid = tidx();
  gemm_core<2, NTW, 2, (NTW == 2)>(acc, 16, [&](int i, int r0, int k) -> u32x4 { return *(const u32x4*)((W + i * 32768) + (unsigned)(r0 * 1024 + k)); },
               [&](int i, int r0, int k) -> u32x4 { return *(const u32x4*)((X + i * 32768) + (unsigned)(r0 * 1024 + k)); }, lds, tid);
  const int lane = tid & 63, wid = tid >> 6, l31 = lane & 31, hi = lane >> 5, wn = wid >> 1, wm = wid & 1;
  const float* rn = (const float*)(ws_ + OFF_RN);
  u16* proj = (u16*)(ws_ + OFF_PROJ);
  constexpr int NCOLS = 64 * NTW, RS = NCOLS * 2 + 16;
  __syncthreads();
#pragma unroll
  for (int im = 0; im < 2; ++im) {
    const int tl = wm * 64 + im * 32 + l31;
    const float r = rn[(size_t)mt * 128 + tl];
#pragma unroll
    for (int in = 0; in < NTW; ++in)
#pragma unroll
      for (int g = 0; g < 4; ++g) {
        const int n = wn * 32 * NTW + in * 32 + 8 * g + 4 * hi;
        u32x2 o; o[0] = pk2(acc[in][im][4 * g] * r, acc[in][im][4 * g + 1] * r); o[1] = pk2(acc[in][im][4 * g + 2] * r, acc[in][im][4 * g + 3] * r);
        *(u32x2*)(lds + tl * RS + n * 2) = o;
      }
  }
  __syncthreads();
#pragma unroll 4
  for (int i = 0; i < NCOLS / 16; ++i) {
    const int c = tid + 256 * i, tl = c / (NCOLS / 8), ch = c % (NCOLS / 8);
    const u32x4 v = *(const u32x4*)(lds + tl * RS + ch * 16);
    *(u32x4*)(proj + ((size_t)mt * 128 + tl) * NP + ntile * NCOLS + ch * 8) = v;
  }
}

DI void outproj_item(const Params& p, int l, int it, char* lds) {
  char* const ws_ = opq(p.ws);
  const int mt = (it & 7) * 16 + ((it >> 3) & 15), nt = it >> 7;
  const u16* W = (const u16*)(ws_ + OFF_WOUT) + ((size_t)l * 1024 + nt * 256) * 1024;
  const u16* Y = (const u16*)(ws_ + OFF_XB) + (size_t)mt * 128 * 1024;
  f32x16 acc[4][2];
  const int tid = tidx();
  gemm_core<2, 4, 2, false>(acc, 16, [&](int i, int r0, int k) -> u32x4 { return *(const u32x4*)((W + i * 32768) + (unsigned)(r0 * 1024 + k)); },
               [&](int i, int r0, int k) -> u32x4 { return *(const u32x4*)((Y + i * 32768) + (unsigned)(r0 * 1024 + k)); }, lds, tid);
  const int lane = tid & 63, wid = tid >> 6, l31 = lane & 31, hi = lane >> 5, wn = wid >> 1, wm = wid & 1;
  u16* outb = (u16*)(ws_ + OFF_OUTB);
  float* ssq = (float*)(ws_ + OFF_SSQ);
  constexpr int RS = 256 * 2 + 16;
  __syncthreads();
#pragma unroll
  for (int im = 0; im < 2; ++im) {
    const int tl = wm * 64 + im * 32 + l31;
    float ss = 0.f;
#pragma unroll
    for (int in = 0; in < 4; ++in)
#pragma unroll
      for (int g = 0; g < 4; ++g) {
        const int n = wn * 128 + in * 32 + 8 * g + 4 * hi;
        const float o0 = acc[in][im][4 * g], o1 = acc[in][im][4 * g + 1], o2 = acc[in][im][4 * g + 2], o3 = acc[in][im][4 * g + 3];
        ss += o0 * o0 + o1 * o1 + o2 * o2 + o3 * o3;
        u32x2 v; v[0] = pk2(o0, o1); v[1] = pk2(o2, o3);
        *(u32x2*)(lds + tl * RS + n * 2) = v;
      }
    ss += __shfl_xor(ss, 32, 64);
    if (hi == 0) ssq[((size_t)mt * 128 + tl) * 16 + nt * 2 + wn] = ss;
  }
  __syncthreads();
#pragma unroll 4
  for (int i = 0; i < 16; ++i) {
    const int c = tid + 256 * i, tl = c >> 5, ch = c & 31;
    const u32x4 v = *(const u32x4*)(lds + tl * RS + ch * 16);
    *(u32x4*)(outb + ((size_t)mt * 128 + tl) * 1024 + nt * 256 + ch * 8) = v;
  }
}

template <int NR>
DI void resid_rows(const Params& p, int l, int row0, const float* xin) {
  char* const ws_ = opq(p.ws);
  const int lane = tidx() & 63;
  const u16* outb = (const u16*)(ws_ + OFF_OUTB);
  const float* ssq = (const float*)(ws_ + OFF_SSQ);
  u32x2 ob[NR][4]; f32x4 xv[NR][4]; f32x4 sq[NR][2];
#pragma unroll
  for (int r = 0; r < NR; ++r) {
    const size_t row = (size_t)(row0 + r);
    sq[r][0] = *(const f32x4*)(ssq + row * 16); sq[r][1] = *(const f32x4*)(ssq + row * 16 + 4);
#pragma unroll
    for (int i = 0; i < 4; ++i) { const int idx = i * 256 + lane * 4; ob[r][i] = *(const u32x2*)(outb + row * 1024 + idx); xv[r][i] = *(const f32x4*)(xin + row * 1024 + idx); }
  }
  f32x4 gq[4];
#pragma unroll
  for (int i = 0; i < 4; ++i) gq[i] = *(const f32x4*)(p.g_post + l * 1024 + i * 256 + lane * 4);
  u16* xb = (u16*)(ws_ + OFF_XB);
#pragma unroll
  for (int r = 0; r < NR; ++r) {
    const size_t row = (size_t)(row0 + r);
    const float ss = ((sq[r][0][0] + sq[r][0][1]) + (sq[r][0][2] + sq[r][0][3])) + ((sq[r][1][0] + sq[r][1][1]) + (sq[r][1][2] + sq[r][1][3]));
    const float r2 = rsqrtf(ss * (1.f / 1024.f) + 1e-6f);
    float s2 = 0.f;
#pragma unroll
    for (int i = 0; i < 4; ++i) {
      const int idx = i * 256 + lane * 4;
      const f32x4 o = {lo16(ob[r][i][0]), hi16(ob[r][i][0]), lo16(ob[r][i][1]), hi16(ob[r][i][1])};
      f32x4 xn;
#pragma unroll
      for (int e = 0; e < 4; ++e) { xn[e] = xv[r][i][e] + o[e] * r2 * gq[i][e]; s2 += xn[e] * xn[e]; }
      *(f32x4*)(p.out + row * 1024 + idx) = xn;
      if (l < 3) { u32x2 o2; o2[0] = pk2(xn[0], xn[1]); o2[1] = pk2(xn[2], xn[3]); *(u32x2*)(xb + row * 1024 + idx) = o2; }
    }
    s2 = wave_sum(s2);
    if (lane == 0) ((float*)(ws_ + OFF_RN))[row] = rsqrtf(s2 * (1.f / 1024.f) + 1e-6f);
  }
}

DI void cmp_item(const Params& p, int l, int it, char* lds) {
  char* const ws_ = opq(p.ws);
  const int j = it >> 5, mt = it & 31;
  const u16* proj = (const u16*)(ws_ + OFF_PROJ);
  const u16* W1 = (const u16*)(ws_ + OFF_W1) + (size_t)(l * 2 + j) * 256 * 2048;
  const u16* W2 = (const u16*)(ws_ + OFF_W2) + (size_t)(l * 2 + j) * 64 * 256;
  const float* pe = p.pe_cmp + (size_t)(l * 2 + j) * 32 * 64;
  const int kvcol = C_KCMP + 64 * j;
  f32x16 acc[2][1];
  const int tid = tidx();
  gemm_core<4, 2, 1, false>(acc, 32, [&](int i, int r0, int k) -> u32x4 { return *(const u32x4*)((W1 + i * 65536) + (unsigned)(r0 * 2048 + k)); },
   [&](int i, int row, int k) -> u32x4 {
    const int rr = mt * 32 + row, b = rr >> 7; int n = rr & 127; if (n > 126) n = 126;
    const int l32 = k >> 6, d = k & 63;
    const u32x4 raw = *(const u32x4*)(proj + ((size_t)b * S_ + 16 * n + l32) * NP + kvcol + d);
    const f32x4 e0 = *(const f32x4*)(pe + l32 * 64 + d), e1 = *(const f32x4*)(pe + l32 * 64 + d + 4);
    u32x4 o;
    o[0] = pk2(lo16(raw[0]) + e0[0], hi16(raw[0]) + e0[1]); o[1] = pk2(lo16(raw[1]) + e0[2], hi16(raw[1]) + e0[3]);
    o[2] = pk2(lo16(raw[2]) + e1[0], hi16(raw[2]) + e1[1]); o[3] = pk2(lo16(raw[3]) + e1[2], hi16(raw[3]) + e1[3]);
    return o; }, lds, tid);
  const int lane = tid & 63, wid = tid >> 6, l31 = lane & 31, hi = lane >> 5;
#pragma unroll
  for (int a = 0; a < 2; ++a)
#pragma unroll
    for (int r = 0; r < 16; ++r) {
      const float x = acc[a][0][r]; const float u = 0.7978845608028654f * (x + 0.044715f * x * x * x);
      acc[a][0][r] = x / (1.f + __expf(-2.f * u));
    }
  f32x16 c2[2];
#pragma unroll
  for (int r = 0; r < 16; ++r) { c2[0][r] = 0.f; c2[1][r] = 0.f; }
#pragma unroll
  for (int in = 0; in < 2; ++in)
#pragma unroll
    for (int s2 = 0; s2 < 2; ++s2) {
      const bf16x8 h0 = pack8(acc[in][0], s2);
#pragma unroll
      for (int dt = 0; dt < 2; ++dt) {
        const u16* wp = W2 + (size_t)(dt * 32 + l31) * 256 + wid * 64 + in * 32 + 16 * s2 + 4 * hi;
        const s16x4 lo = *(const s16x4*)wp, hh = *(const s16x4*)(wp + 8);
        const bf16x8 wf = {lo[0], lo[1], lo[2], lo[3], hh[0], hh[1], hh[2], hh[3]};
        c2[dt] = MFMA(wf, h0, c2[dt]);
      }
    }
  float* red = (float*)lds;
  __syncthreads();
  for (int w = 0; w < 4; ++w) {
    if (wid == w) {
#pragma unroll
      for (int dt = 0; dt < 2; ++dt)
#pragma unroll
        for (int r = 0; r < 16; ++r) {
          float* q = red + (dt * 32 + crow(r, hi)) * 32 + l31;
          if (w == 0) *q = c2[dt][r]; else *q += c2[dt][r];
        }
    }
    __syncthreads();
  }
  u16* kc = (u16*)(ws_ + OFF_KC); u16* vct = (u16*)(ws_ + OFF_VCT);
#pragma unroll 4
  for (int i = 0; i < 8; ++i) {
    const int e = tid + 256 * i;
    if (j == 0) { const int tok = e >> 6, d = e & 63; const int rr = mt * 32 + tok; kc[(size_t)rr * 64 + d] = f2bf(red[d * 32 + tok]); }
    else { const int d = e >> 5, tok = e & 31; const int rr = mt * 32 + tok, b = rr >> 7, n = rr & 127; vct[((size_t)b * 64 + d) * 128 + n] = f2bf(red[d * 32 + tok]); }
  }
  __syncthreads();
}

DI void win_item(const Params& p, int it, char* lds) {
  char* const ws_ = opq(p.ws);
  const int b = it & 7, qt = it >> 3, q0 = qt * 32;
  const int tid = tidx(), lane = tid & 63, h = tid >> 6, l31 = lane & 31, hi = lane >> 5;
  const u16* proj = (const u16*)(ws_ + OFF_PROJ);
  const int t = q0 + l31; const size_t tok = (size_t)b * S_ + t;
  bf16x8 qr[4];
#pragma unroll
  for (int s = 0; s < 4; ++s) qr[s] = *(const bf16x8*)(proj + tok * NP + C_AQ + h * 64 + 16 * s + 8 * hi);
  char* ldsK = lds; char* ldsV = lds + 9216;
  f32x16 o[2];
#pragma unroll
  for (int r = 0; r < 16; ++r) { o[0][r] = 0.f; o[1][r] = 0.f; }
  float m = M_INIT, lsum = 0.f;
  const int klo = (q0 - 511 > 0 ? q0 - 511 : 0) >> 6, khi = (q0 + 31) >> 6;
  __syncthreads();
  attn_stream(tid, proj, C_KWIN, C_VWIN, khi - klo + 1,
              [&](int ti, int row) { return b * S_ + (klo + ti) * 64 + row; },
              [&](int ti) { const int k0 = (klo + ti) * 64; return (k0 + 63 <= q0) && (k0 >= q0 + 31 - 511); },
              [&](int ti, int kr) { return (unsigned)(t - ((klo + ti) * 64 + kr)) <= 511u; },
              qr, o, m, lsum, lds);
  lsum += __shfl_xor(lsum, 32, 64);
  const float il = 1.f / lsum;
  u16* ow = (u16*)(ws_ + OFF_OWIN);
#pragma unroll
  for (int db = 0; db < 2; ++db)
#pragma unroll
    for (int g = 0; g < 4; ++g) {
      const int d0 = 32 * db + 8 * g + 4 * hi;
      u32x2 v; v[0] = pk2(o[db][4 * g] * il, o[db][4 * g + 1] * il); v[1] = pk2(o[db][4 * g + 2] * il, o[db][4 * g + 3] * il);
      *(u32x2*)(ow + tok * 256 + h * 64 + d0) = v;
    }
}

DI void dil_item(const Params& p, int it, char* lds) {
  char* const ws_ = opq(p.ws);
  const int di = it >> 9, rem = it & 511, b = rem & 7, h = (rem >> 3) & 3, c = rem >> 5;
  const int sh = 2 * di, dil = 1 << sh;
  const int tpr = 16 >> sh;
  const int r = c / tpr, mt = c % tpr, m0 = mt * 128;
  const int tid = tidx(), lane = tid & 63, wid = tid >> 6, l31 = lane & 31, hi = lane >> 5;
  const u16* proj = (const u16*)(ws_ + OFF_PROJ);
  const int mq = m0 + 32 * wid + l31;
  const size_t tok = (size_t)b * S_ + mq * dil + r;
  bf16x8 qr[4];
#pragma unroll
  for (int s = 0; s < 4; ++s) qr[s] = *(const bf16x8*)(proj + tok * NP + C_BQ + h * 64 + 16 * s + 8 * hi);
  const int tt0 = (m0 == 0) ? 2 : 0;
  {
    u32x4 pre[4][4];
#pragma unroll
    for (int tt = 0; tt < 4; ++tt)
      if (tt >= tt0) kv_load(tid, pre[tt], [&](int row) { return b * S_ + (m0 - 128 + 64 * tt + row) * dil + r; }, proj, C_BK + h * 64, C_BV + h * 64);
    __syncthreads();
#pragma unroll
    for (int tt = 0; tt < 4; ++tt)
      if (tt >= tt0) kv_store(tid, pre[tt], lds + tt * 18432, lds + tt * 18432 + 9216);
    __syncthreads();
  }
  f32x16 o[2];
#pragma unroll
  for (int rr = 0; rr < 16; ++rr) { o[0][rr] = 0.f; o[1][rr] = 0.f; }
  float m = M_INIT, lsum = 0.f;
  const int widu = __builtin_amdgcn_readfirstlane(wid);
  const int wlo = m0 + 32 * widu - 128, whi = m0 + 32 * widu + 31;
  for (int tt = tt0; tt < 4; ++tt) {
    const int tk0 = m0 - 128 + 64 * tt;
    if (tk0 + 63 >= wlo && tk0 <= whi) {
      attn_tile(tid, lds + tt * 18432, lds + tt * 18432 + 9216, qr, o, m, lsum, !(tk0 + 63 <= wlo + 128 && tk0 >= whi - 128), [&](int kr) { return (unsigned)(mq - (tk0 + kr)) <= 128u; });
    }
  }
  lsum += __shfl_xor(lsum, 32, 64);
  const float il = 1.f / lsum;
  u16* od = (u16*)(ws_ + OFF_ODIL) + (size_t)di * T_ * 256;
#pragma unroll
  for (int db = 0; db < 2; ++db)
#pragma unroll
    for (int g = 0; g < 4; ++g) {
      const int d0 = 32 * db + 8 * g + 4 * hi;
      u32x2 v; v[0] = pk2(o[db][4 * g] * il, o[db][4 * g + 1] * il); v[1] = pk2(o[db][4 * g + 2] * il, o[db][4 * g + 3] * il);
      *(u32x2*)(od + tok * 256 + h * 64 + d0) = v;
    }
  if (hi == 0) ((float*)(ws_ + OFF_LSE))[((size_t)di * T_ + tok) * 4 + h] = m * 0.6931471805599453f + __logf(lsum);
}

DI void pool_item(const Params& p, int l, int it, char* lds) {
  char* const ws_ = opq(p.ws);
  const int b = it & 7, qt = it >> 3, q0 = qt * 32;
  const int tid = tidx(), lane = tid & 63, g = tid >> 6, l31 = lane & 31, hi = lane >> 5;
  const u16* proj = (const u16*)(ws_ + OFF_PROJ);
  u16* cin = (u16*)lds;
  char* pl = lds + 48 * 512;
  u32x4 cv[6];
#pragma unroll
  for (int i = 0; i < 6; ++i) {
    const int c = tid + 256 * i, row = c >> 5, ch = c & 31; const int t = q0 - 16 + row;
    cv[i] = u32x4{0u, 0u, 0u, 0u};
    if (t >= 0) cv[i] = *(const u32x4*)(proj + ((size_t)b * S_ + t) * NP + C_CIN + ch * 8);
  }
  const u16* wpt = (const u16*)(ws_ + OFF_WPT) + (size_t)(l * 4 + g) * 4096;
  bf16x8 af[8];
#pragma unroll
  for (int q = 0; q < 8; ++q) af[q] = *(const bf16x8*)(wpt + ((q & 1) * 32 + l31) * 64 + 16 * (q >> 1) + 8 * hi);
  const size_t tok = (size_t)b * S_ + q0 + l31;
  f32x4 psv[8]; u32x2 zv[8];
#pragma unroll
  for (int q = 0; q < 8; ++q) {
    const int col = g * 64 + (q >> 2) * 32 + 8 * (q & 3) + 4 * hi;
    psv[q] = *(const f32x4*)(p.pool_scale + l * 256 + col); zv[q] = *(const u32x2*)(proj + tok * NP + C_CZ + col);
  }
  __syncthreads();
#pragma unroll
  for (int i = 0; i < 6; ++i) { const int c = tid + 256 * i, row = c >> 5, ch = c & 31; *(u32x4*)(cin + row * 256 + ch * 8) = cv[i]; }
  __syncthreads();
  {
    const int ch = tid, w = 2 << g;
    float s = 0.f;
    for (int r = 17 - w; r <= 16; ++r) s += bf2f(cin[r * 256 + ch]);
#pragma unroll 4
    for (int i = 0; i < 32; ++i) {
      const int t = q0 + i; const int cnt = (t + 1 < w) ? t + 1 : w;
      const float self = bf2f(cin[(i + 16) * 256 + ch]);
      *(u16*)(pl + i * 528 + ch * 2) = f2bf(s / (float)cnt - self);
      s += bf2f(cin[(i + 17) * 256 + ch]) - bf2f(cin[(i + 17 - w) * 256 + ch]);
    }
  }
  __syncthreads();
  f32x16 acc[2];
#pragma unroll
  for (int r = 0; r < 16; ++r) { acc[0][r] = 0.f; acc[1][r] = 0.f; }
#pragma unroll
  for (int s4 = 0; s4 < 4; ++s4) {
    const bf16x8 bf = *(const bf16x8*)(pl + l31 * 528 + (g * 64 + 16 * s4 + 8 * hi) * 2);
#pragma unroll
    for (int dt = 0; dt < 2; ++dt) acc[dt] = MFMA(af[s4 * 2 + dt], bf, acc[dt]);
  }
  u16* y = (u16*)(ws_ + OFF_XB);
#pragma unroll
  for (int dt = 0; dt < 2; ++dt)
#pragma unroll
    for (int g4 = 0; g4 < 4; ++g4) {
      const int col = g * 64 + dt * 32 + 8 * g4 + 4 * hi;
      const f32x4 ps = psv[dt * 4 + g4];
      const u32x2 z = zv[dt * 4 + g4];
      u32x2 v;
      v[0] = pk2(acc[dt][4 * g4] * ps[0] * siluf_(lo16(z[0])), acc[dt][4 * g4 + 1] * ps[1] * siluf_(hi16(z[0])));
      v[1] = pk2(acc[dt][4 * g4 + 2] * ps[2] * siluf_(lo16(z[1])), acc[dt][4 * g4 + 3] * ps[3] * siluf_(hi16(z[1])));
      *(u32x2*)(y + tok * 1024 + 512 + col) = v;
    }
}

DI void sgu_item(const Params& p, int l, int it, char* lds) {
  char* const ws_ = opq(p.ws);
  const int b = it & 7, c = (it >> 5) & 15, g = (it >> 3) & 3, t0 = c * 128;
  const int tid = tidx(), lane = tid & 63, l31 = lane & 31, hi = lane >> 5;
  const int wid = __builtin_amdgcn_readfirstlane(tid >> 6);
  const u16* proj = (const u16*)(ws_ + OFF_PROJ);
  char* vn = lds;
  __syncthreads();
  {
    const int j = tid >> 1, half = tid & 1;
    const u16* vp = proj + ((size_t)b * S_ + t0 + j) * NP + C_DV + half * 128;
    u32x4 raw[16];
#pragma unroll
    for (int i = 0; i < 16; ++i) raw[i] = *(const u32x4*)(vp + i * 8);
    float s1 = 0.f;
#pragma unroll
    for (int i = 0; i < 16; ++i)
#pragma unroll
      for (int e = 0; e < 4; ++e) s1 += lo16(raw[i][e]) + hi16(raw[i][e]);
    s1 += __shfl_xor(s1, 1, 64);
    const float mu = s1 * (1.f / 256.f);
    float s2 = 0.f;
#pragma unroll
    for (int i = 0; i < 16; ++i)
#pragma unroll
      for (int e = 0; e < 4; ++e) { const float a = lo16(raw[i][e]) - mu, bb = hi16(raw[i][e]) - mu; s2 += a * a + bb * bb; }
    s2 += __shfl_xor(s2, 1, 64);
    const float rstd = rsqrtf(s2 * (1.f / 256.f) + 1e-5f);
    if (half == (g >> 1)) {
      const float* lg = p.sg_ln_g + l * 256 + g * 64; const float* lb = p.sg_ln_b + l * 256 + g * 64;
      auto emit = [&](const u32x4& r, int i) {
        const f32x4 g0 = *(const f32x4*)(lg + i * 8), g1 = *(const f32x4*)(lg + i * 8 + 4), b0 = *(const f32x4*)(lb + i * 8), b1 = *(const f32x4*)(lb + i * 8 + 4);
        u32x4 o;
        o[0] = pk2((lo16(r[0]) - mu) * rstd * g0[0] + b0[0], (hi16(r[0]) - mu) * rstd * g0[1] + b0[1]);
        o[1] = pk2((lo16(r[1]) - mu) * rstd * g0[2] + b0[2], (hi16(r[1]) - mu) * rstd * g0[3] + b0[3]);
        o[2] = pk2((lo16(r[2]) - mu) * rstd * g1[0] + b1[0], (hi16(r[2]) - mu) * rstd * g1[1] + b1[1]);
        o[3] = pk2((lo16(r[3]) - mu) * rstd * g1[2] + b1[2], (hi16(r[3]) - mu) * rstd * g1[3] + b1[3]);
        *(u32x4*)(vn + j * 144 + i * 16) = o;
      };
      if (g & 1) {
#pragma unroll
        for (int i = 0; i < 8; ++i) emit(raw[8 + i], i);
      } else {
#pragma unroll
        for (int i = 0; i < 8; ++i) emit(raw[i], i);
      }
    }
  }
  __syncthreads();
  const int i = wid * 32 + l31;
  const u16* wsp = (const u16*)(ws_ + OFF_WSP) + ((size_t)(l * 4 + g) * 128 + i) * 128;
  f32x16 acc[2];
#pragma unroll
  for (int r = 0; r < 16; ++r) { acc[0][r] = 0.f; acc[1][r] = 0.f; }
  const int nks = 2 * (wid + 1);
  bf16x8 wfr[8];
#pragma unroll
  for (int s = 0; s < 8; ++s) { if (s < nks) wfr[s] = *(const bf16x8*)(wsp + 16 * s + 8 * hi); else wfr[s] = bf16x8{0, 0, 0, 0, 0, 0, 0, 0}; }
  const char* vb = vn + (8 * hi + ((lane & 15) >> 2)) * 144 + ((lane >> 4) & 1) * 32 + (lane & 3) * 8;
#pragma unroll
  for (int s = 0; s < 8; ++s) {
    if (s < nks) {
#pragma unroll
      for (int ct = 0; ct < 2; ++ct) {
        const s16x4 lo = trread(vb + (16 * s) * 144 + ct * 64), hh = trread(vb + (16 * s + 4) * 144 + ct * 64);
        const bf16x8 af = {lo[0], lo[1], lo[2], lo[3], hh[0], hh[1], hh[2], hh[3]};
        acc[ct] = MFMA(af, wfr[s], acc[ct]);
      }
    }
  }
  const size_t tok = (size_t)b * S_ + t0 + i;
  const float bs = p.b_sp[(l * 4 + g) * 128 + i];
  u16* y = (u16*)(ws_ + OFF_XB);
#pragma unroll
  for (int ct = 0; ct < 2; ++ct)
#pragma unroll
    for (int g4 = 0; g4 < 4; ++g4) {
      const int col = g * 64 + ct * 32 + 8 * g4 + 4 * hi;
      const u32x2 u = *(const u32x2*)(proj + tok * NP + C_DU + col), z = *(const u32x2*)(proj + tok * NP + C_DZ + col);
      u32x2 v;
      v[0] = pk2(lo16(u[0]) * (acc[ct][4 * g4] + bs) * siluf_(lo16(z[0])), hi16(u[0]) * (acc[ct][4 * g4 + 1] + bs) * siluf_(hi16(z[0])));
      v[1] = pk2(lo16(u[1]) * (acc[ct][4 * g4 + 2] + bs) * siluf_(lo16(z[1])), hi16(u[1]) * (acc[ct][4 * g4 + 3] + bs) * siluf_(hi16(z[1])));
      *(u32x2*)(y + tok * 1024 + 768 + col) = v;
    }
}

DI void nsa_item(const Params& p, int it, char* lds) {
  char* const ws_ = opq(p.ws);
  const int b = it & 7, qt = 63 - (it >> 3), q0 = qt * 32;
  const int tid = tidx(), lane = tid & 63, h = tid >> 6, l31 = lane & 31, hi = lane >> 5;
  const u16* proj = (const u16*)(ws_ + OFF_PROJ);
  const int t = q0 + l31; const size_t tok = (size_t)b * S_ + t;
  bf16x8 qr[4];
#pragma unroll
  for (int s = 0; s < 4; ++s) qr[s] = *(const bf16x8*)(proj + tok * NP + C_AQ + h * 64 + 16 * s + 8 * hi);
  char* ldsK = lds; char* ldsV = lds + 9216;
  float* impS = (float*)(lds + 36864);
  float* vals = (float*)(lds + 36864 + 16384);
  unsigned* selm = (unsigned*)(lds + 73728 - 256);
  int* jlist = (int*)(lds + 73728 - 128);
  float* yst = (float*)(lds + 36864);
  __syncthreads();
  if (tid < 32) selm[tid] = 0u;
  const float g0 = sigmoidf_(bf2f(proj[tok * NP + C_AG + 0 + h])), g1 = sigmoidf_(bf2f(proj[tok * NP + C_AG + 4 + h])), g2 = sigmoidf_(bf2f(proj[tok * NP + C_AG + 8 + h]));
  f32x16 ya[2];
  {
    const u16* kc = (const u16*)(ws_ + OFF_KC); const u16* vct = (const u16*)(ws_ + OFF_VCT);
    f32x16 sc[4];
    const int nkb = (((q0 + 31 - 31) >> 4) >> 5) + 1;
#pragma unroll
    for (int kb = 0; kb < 4; ++kb) {
#pragma unroll
      for (int r = 0; r < 16; ++r) sc[kb][r] = 0.f;
      if (kb < nkb) {
#pragma unroll
        for (int s = 0; s < 4; ++s) {
          const bf16x8 kf = *(const bf16x8*)(kc + ((size_t)(b * 128 + kb * 32 + l31)) * 64 + 16 * s + 8 * hi);
          sc[kb] = MFMA(kf, qr[s], sc[kb]);
        }
      }
    }
    s16x4 vcl[16], vch[16];
#pragma unroll
    for (int q = 0; q < 16; ++q) {
      const int kb = q >> 2, s2 = (q >> 1) & 1, db = q & 1;
      const u16* vp = vct + ((size_t)(b * 64 + 32 * db + l31)) * 128 + 32 * kb + 16 * s2 + 4 * hi;
      vcl[q] = s16x4{0, 0, 0, 0}; vch[q] = s16x4{0, 0, 0, 0};
      if (kb < nkb) { vcl[q] = *(const s16x4*)vp; vch[q] = *(const s16x4*)(vp + 8); }
    }
    const int nv = (t >= 31) ? ((t - 31) >> 4) : -1;
    float mx = NEGB;
#pragma unroll
    for (int kb = 0; kb < 4; ++kb)
#pragma unroll
      for (int r = 0; r < 16; ++r) { const int n = 32 * kb + crow(r, hi); const float v = (n <= nv) ? sc[kb][r] * C2 : NEGB; sc[kb][r] = v; mx = fmaxf(mx, v); }
    mx = fmaxf(mx, __shfl_xor(mx, 32, 64));
    float sum = 0.f;
#pragma unroll
    for (int kb = 0; kb < 4; ++kb)
#pragma unroll
      for (int r = 0; r < 16; ++r) { const int n = 32 * kb + crow(r, hi); const float e = (n <= nv) ? ex2(sc[kb][r] - mx) : 0.f; sc[kb][r] = e; sum += e; }
    sum += __shfl_xor(sum, 32, 64);
    const float inv = sum > 0.f ? 1.f / sum : 0.f;
#pragma unroll
    for (int kb = 0; kb < 4; ++kb)
#pragma unroll
      for (int r = 0; r < 16; ++r) sc[kb][r] *= inv;
    float* myimp = impS + (h * 32 + l31) * 32;
#pragma unroll
    for (int kb = 0; kb < 4; ++kb)
#pragma unroll
      for (int g = 0; g < 4; ++g) myimp[8 * kb + 2 * g + hi] = ((sc[kb][4 * g] + sc[kb][4 * g + 1]) + sc[kb][4 * g + 2]) + sc[kb][4 * g + 3];
    __syncthreads();
#pragma unroll
    for (int kb = 0; kb < 4; ++kb)
#pragma unroll
      for (int g = 0; g < 4; ++g) { const int j1 = 8 * kb + 2 * g + hi + 1; if (j1 < 32) myimp[j1] += sc[kb][4 * g + 3]; }
    f32x16 oc[2];
#pragma unroll
    for (int r = 0; r < 16; ++r) { oc[0][r] = 0.f; oc[1][r] = 0.f; }
#pragma unroll
    for (int kb = 0; kb < 4; ++kb)
#pragma unroll
      for (int s2 = 0; s2 < 2; ++s2) {
        if (kb >= nkb) continue;
        const bf16x8 pf = pack8(sc[kb], s2);
#pragma unroll
        for (int db = 0; db < 2; ++db) {
          const s16x4 lo = vcl[(kb * 2 + s2) * 2 + db], hh = vch[(kb * 2 + s2) * 2 + db];
          const bf16x8 vf = {lo[0], lo[1], lo[2], lo[3], hh[0], hh[1], hh[2], hh[3]};
          oc[db] = MFMA(vf, pf, oc[db]);
        }
      }
#pragma unroll
    for (int r = 0; r < 16; ++r) { ya[0][r] = oc[0][r] * g0; ya[1][r] = oc[1][r] * g0; }
  }
  __syncthreads();
  const int cur = q0 >> 6;
  {
    const int q = tid >> 3, sub = tid & 7;
#pragma unroll
    for (int jj = 0; jj < 4; ++jj) {
      const int j = sub * 4 + jj;
      float v = ((impS[(0 * 32 + q) * 32 + j] + impS[(1 * 32 + q) * 32 + j]) + impS[(2 * 32 + q) * 32 + j]) + impS[(3 * 32 + q) * 32 + j];
      const bool forced = (j == 0) || (j == cur) || (j == cur - 1);
      v = forced ? 1e4f : ((j <= cur) ? v : -1e4f);
      vals[q * 32 + j] = v;
    }
    __syncthreads();
    f32x4 vv[8];
#pragma unroll
    for (int i = 0; i < 8; ++i) vv[i] = *(const f32x4*)(vals + q * 32 + i * 4);
    unsigned bits = 0u;
#pragma unroll
    for (int jj = 0; jj < 4; ++jj) {
      const int j = sub * 4 + jj; const float v = vals[q * 32 + j];
      int cnt = 0;
#pragma unroll
      for (int j2 = 0; j2 < 32; ++j2) { const float w = vv[j2 >> 2][j2 & 3]; cnt += ((w > v) || (w == v && j2 < j)) ? 1 : 0; }
      if (cnt < 16 && j <= cur) bits |= 1u << j;
    }
    if (bits) atomicOr(&selm[q], bits);
  }
  __syncthreads();
  const unsigned mymask = selm[l31];
  unsigned anym = mymask, allm = mymask;
#pragma unroll
  for (int o = 16; o >= 1; o >>= 1) { anym |= (unsigned)__shfl_xor((int)anym, o, 64); allm &= (unsigned)__shfl_xor((int)allm, o, 64); }
  anym = __builtin_amdgcn_readfirstlane(anym);
  allm = __builtin_amdgcn_readfirstlane(allm);
  if (tid < 32) { if ((anym >> tid) & 1u) jlist[__builtin_popcount(anym & ((1u << tid) - 1u))] = tid; }
  f32x16 o[2];
#pragma unroll
  for (int r = 0; r < 16; ++r) { o[0][r] = 0.f; o[1][r] = 0.f; }
  float m = M_INIT, lsum = 0.f;
#pragma unroll
  for (int r = 0; r < 16; ++r) { yst[r * 256 + tid] = ya[0][r]; yst[(16 + r) * 256 + tid] = ya[1][r]; }
  __syncthreads();
  attn_stream(tid, proj, C_KSLC, C_VSLC, __builtin_popcount(anym),
              [&](int ti, int row) { return b * S_ + jlist[ti] * 64 + row; },
              [&](int ti) { const int jb = jlist[ti]; return (jb < cur) && ((allm >> jb) & 1u); },
              [&](int ti, int kr) { const int jb = jlist[ti]; return ((mymask >> jb) & 1u) && (jb * 64 + kr <= t); },
              qr, o, m, lsum, lds);
#pragma unroll
  for (int r = 0; r < 16; ++r) { ya[0][r] = yst[r * 256 + tid]; ya[1][r] = yst[(16 + r) * 256 + tid]; }
  lsum += __shfl_xor(lsum, 32, 64);
  const float il = g1 / lsum;
  const u16* ow = (const u16*)(ws_ + OFF_OWIN);
  u16* y = (u16*)(ws_ + OFF_XB);
#pragma unroll
  for (int db = 0; db < 2; ++db)
#pragma unroll
    for (int g = 0; g < 4; ++g) {
      const int col = h * 64 + 32 * db + 8 * g + 4 * hi;
      const u32x2 w = *(const u32x2*)(ow + tok * 256 + col), az = *(const u32x2*)(proj + tok * NP + C_AZ + col);
      const float v0 = (ya[db][4 * g] + o[db][4 * g] * il + g2 * lo16(w[0])) * siluf_(lo16(az[0]));
      const float v1 = (ya[db][4 * g + 1] + o[db][4 * g + 1] * il + g2 * hi16(w[0])) * siluf_(hi16(az[0]));
      const float v2 = (ya[db][4 * g + 2] + o[db][4 * g + 2] * il + g2 * lo16(w[1])) * siluf_(lo16(az[1]));
      const float v3 = (ya[db][4 * g + 3] + o[db][4 * g + 3] * il + g2 * hi16(w[1])) * siluf_(hi16(az[1]));
      u32x2 v; v[0] = pk2(v0, v1); v[1] = pk2(v2, v3);
      *(u32x2*)(y + tok * 1024 + col) = v;
    }
}

DI void dilcomb_item(const Params& p, int it) {
  char* const ws_ = opq(p.ws);
  const u16* proj = (const u16*)(ws_ + OFF_PROJ);
  const u16* od = (const u16*)(ws_ + OFF_ODIL);
  const float* lse = (const float*)(ws_ + OFF_LSE);
  u16* y = (u16*)(ws_ + OFF_XB);
#pragma unroll
  for (int i = 0; i < 4; ++i) {
    const int idx = it * 1024 + i * 256 + threadIdx.x;
    const size_t tok = idx >> 5; const int c8 = idx & 31, h = c8 >> 3;
    const float l0 = lse[((size_t)0 * T_ + tok) * 4 + h], l1 = lse[((size_t)1 * T_ + tok) * 4 + h], l2 = lse[((size_t)2 * T_ + tok) * 4 + h];
    const float mx = fmaxf(l0, fmaxf(l1, l2));
    float w0 = __expf(l0 - mx), w1 = __expf(l1 - mx), w2 = __expf(l2 - mx);
    const float iw = 1.f / (w0 + w1 + w2); w0 *= iw; w1 *= iw; w2 *= iw;
    const u32x4 a = *(const u32x4*)(od + ((size_t)0 * T_ + tok) * 256 + c8 * 8), bq = *(const u32x4*)(od + ((size_t)1 * T_ + tok) * 256 + c8 * 8), cq = *(const u32x4*)(od + ((size_t)2 * T_ + tok) * 256 + c8 * 8);
    const u32x4 z = *(const u32x4*)(proj + tok * NP + C_BZ + c8 * 8);
    u32x4 r;
#pragma unroll
    for (int e = 0; e < 4; ++e) {
      const float v0 = (w0 * lo16(a[e]) + w1 * lo16(bq[e]) + w2 * lo16(cq[e])) * siluf_(lo16(z[e]));
      const float v1 = (w0 * hi16(a[e]) + w1 * hi16(bq[e]) + w2 * hi16(cq[e])) * siluf_(hi16(z[e]));
      r[e] = pk2(v0, v1);
    }
    *(u32x4*)(y + tok * 1024 + 256 + c8 * 8) = r;
  }
}

__global__ void __launch_bounds__(256, 2) hybrid_megakernel(Params p) {
  __shared__ __attribute__((aligned(16))) char lds[73728];
  __shared__ uint4 xb_words;
  cg::grid_group grid = cg::this_grid();
  char* const ws_ = p.ws;
  if (p.ws == nullptr) grid.sync();
  if (threadIdx.x == 0) xb_words = make_uint4(0u, 0u, 0u, 0u);
  __syncthreads();
  const XcdBarrier xb = xcd_barrier_post((unsigned*)(ws_ + OFF_BAR), (volatile LAS unsigned*)&xb_words);
  const int nb = gridDim.x, bid = blockIdx.x;
  const int wid = threadIdx.x >> 6;
  for (int it = bid; it < 3328 + 1024 + 1024 + 32 + 16 + 64; it += nb) {
    if (it < 3328) { const int l = it / 832, r = it % 832, ntile = r >> 4, ktile = r & 15;
      tr_tile(p.w_in + (size_t)l * 1024 * 3212, 3212, (u16*)(ws_ + OFF_WIN) + (size_t)l * NP * 1024, 1024, ktile * 64, ntile * 64, p.g_pre + l * 1024, 1, lds); }
    else if (it < 4352) { const int i2 = it - 3328, l = i2 >> 8, r = i2 & 255, ntile = r >> 4, ktile = r & 15;
      tr_tile(p.w_out + (size_t)l * 1024 * 1024, 1024, (u16*)(ws_ + OFF_WOUT) + (size_t)l * 1024 * 1024, 1024, ktile * 64, ntile * 64, nullptr, 0, lds); }
    else if (it < 5376) { const int i2 = it - 4352, mtx = i2 >> 7, r = i2 & 127, ntile = r >> 5, ktile = r & 31;
      tr_tile(p.w_cmp1 + (size_t)mtx * 2048 * 256, 256, (u16*)(ws_ + OFF_W1) + (size_t)mtx * 256 * 2048, 2048, ktile * 64, ntile * 64, nullptr, 0, lds); }
    else if (it < 5408) { const int i2 = it - 5376, mtx = i2 >> 2, ktile = i2 & 3;
      tr_tile(p.w_cmp2 + (size_t)mtx * 256 * 64, 64, (u16*)(ws_ + OFF_W2) + (size_t)mtx * 64 * 256, 256, ktile * 64, 0, nullptr, 0, lds); }
    else if (it < 5424) { const int mtx = it - 5408;
      tr_tile(p.w_pool + (size_t)mtx * 4096, 64, (u16*)(ws_ + OFF_WPT) + (size_t)mtx * 4096, 64, 0, 0, nullptr, 0, lds); }
    else { const int i2 = it - 5424, mtx = i2 >> 2, qd = i2 & 3;
      const float* src = p.w_sp + (size_t)mtx * 16384 + qd * 4096; u16* dst = (u16*)(ws_ + OFF_WSP) + (size_t)mtx * 16384 + qd * 4096;
      f32x4 v[4];
#pragma unroll
      for (int k = 0; k < 4; ++k) v[k] = *(const f32x4*)(src + (threadIdx.x + 256 * k) * 4);
#pragma unroll
      for (int k = 0; k < 4; ++k) {
        const int e = qd * 4096 + (threadIdx.x + 256 * k) * 4, i = e >> 7, j = e & 127;
        u32x2 o; o[0] = pk2(j <= i ? v[k][0] : 0.f, j + 1 <= i ? v[k][1] : 0.f); o[1] = pk2(j + 2 <= i ? v[k][2] : 0.f, j + 3 <= i ? v[k][3] : 0.f);
        *(u32x2*)(dst + (threadIdx.x + 256 * k) * 4) = o;
      } }
  }
  for (int it = bid; it < T_ / 32; it += nb) {
    const int row = it * 32 + wid * 8;
    rows_convert<8>(p.x + (size_t)row * 1024, (u16*)(ws_ + OFF_XB) + (size_t)row * 1024, (float*)(ws_ + OFF_RN) + row);
  }
  xcd_barrier(xb);
  for (int l = 0; l < 4; ++l) {
    for (int it = bid; it < 1536 + 256; it += nb) {
      if (it < 1536) { const int q = it >> 3; inproj_tile<4>(p, l, (it & 7) * 16 + (q & 15), q >> 4, lds); }
      else { const int i2 = it - 1536, q = i2 >> 3; inproj_tile<2>(p, l, (i2 & 7) * 16 + (q & 15), 24 + (q >> 4), lds); }
    }
    xcd_barrier(xb);
    for (int vb = bid; vb < 512; vb += nb) {
      if (vb < 64) cmp_item(p, l, vb, lds);
      else {
        const int j = vb - 64;
        win_item(p, j, lds);
        if (j + 448 < 512) win_item(p, j + 448, lds);
        for (int it = j; it < 1536; it += 448) dil_item(p, it, lds);
      }
    }
    xcd_barrier(xb);
    for (int vb = bid; vb < 512; vb += nb) {
      nsa_item(p, vb, lds);
      const int gi = vb >> 4;
      int start = 0, mine = 0;
      for (int g2 = 0; g2 <= gi; ++g2) {
        const int n = 32 - g2;
        const int d = (n <= 10) ? 2 : (n <= 22) ? 1 : 0;
        if (g2 < gi) start += 16 * d; else mine = d;
      }
      start += (vb & 15) * mine;
      for (int k = 0; k < mine; ++k) { sgu_item(p, l, start + k, lds); pool_item(p, l, start + k, lds); dilcomb_item(p, start + k); }
    }
    xcd_barrier(xb);
    for (int it = bid; it < 512; it += nb) outproj_item(p, l, it, lds);
    xcd_barrier(xb);
    const float* xin = (l == 0) ? p.x : p.out;
    for (int it = bid; it < T_ / 16; it += nb) resid_rows<4>(p, l, it * 16 + wid * 4, xin);
    if (l < 3) xcd_barrier(xb);
  }
}

extern "C" void kernel_launch(void* const* d_in, const int* in_sizes, int n_in, void* d_out, int out_size, void* d_ws, size_t ws_size, hipStream_t stream) {
  static int grid_blocks = 0;
  if (!grid_blocks) {
    int dev = 0, cus = 0, per_cu = 0;
    hipGetDevice(&dev);
    hipDeviceGetAttribute(&cus, hipDeviceAttributeMultiprocessorCount, dev);
    hipOccupancyMaxActiveBlocksPerMultiprocessor(&per_cu, hybrid_megakernel, 256, 0);
    if (per_cu > 2) per_cu = 2;
    if (per_cu < 1) per_cu = 1;
    grid_blocks = cus * per_cu;
  }
  if (ws_size < WS_TOTAL) { fprintf(stderr, "workspace too small: %zu < %zu\n", ws_size, (size_t)WS_TOTAL); return; }
  Params p{};
  p.x = (const float*)d_in[0]; p.g_pre = (const float*)d_in[1]; p.w_in = (const float*)d_in[2]; p.pe_cmp = (const float*)d_in[3];
  p.w_cmp1 = (const float*)d_in[4]; p.w_cmp2 = (const float*)d_in[5]; p.w_pool = (const float*)d_in[6]; p.pool_scale = (const float*)d_in[7];
  p.sg_ln_g = (const float*)d_in[8]; p.sg_ln_b = (const float*)d_in[9]; p.w_sp = (const float*)d_in[10]; p.b_sp = (const float*)d_in[11];
  p.w_out = (const float*)d_in[12]; p.g_post = (const float*)d_in[13];
  p.out = (float*)d_out; p.ws = (char*)d_ws;
  hipMemsetAsync((char*)d_ws + OFF_BAR, 0, 16384, stream);
  void* args[] = {&p};
  hipError_t e = hipLaunchCooperativeKernel((void*)hybrid_megakernel, dim3(grid_blocks), dim3(256), args, 0, stream);
  if (e != hipSuccess) fprintf(stderr, "cooperative launch failed: %s (grid %d)\n", hipGetErrorString(e), grid_blocks);
}
```

```cpp
#include <hip/hip_runtime.h>
#include <hip/hip_cooperative_groups.h>
#include <cstdio>
namespace cg = cooperative_groups;

typedef unsigned short u16;
using bf16x8 = __attribute__((ext_vector_type(8))) short;
using s16x4 = __attribute__((ext_vector_type(4))) short;
using f32x16 = __attribute__((ext_vector_type(16))) float;
using f32x4 = __attribute__((ext_vector_type(4))) float;
using u32x4 = __attribute__((ext_vector_type(4))) unsigned;
using u32x2 = __attribute__((ext_vector_type(2))) unsigned;
typedef short v4i16_t __attribute__((ext_vector_type(4)));
#define DI __device__ __forceinline__
#define MFMA(a, b, c) __builtin_amdgcn_mfma_f32_32x32x16_bf16((a), (b), (c), 0, 0, 0)

constexpr int T_ = 16384, S_ = 2048, NP = 3328;
constexpr float C2 = 0.125f * 1.4426950408889634f;
constexpr float NEGB = -1e30f;

constexpr int C_AQ = 0, C_KCMP = 256, C_KSLC = 384, C_VSLC = 448, C_KWIN = 512, C_VWIN = 576, C_AZ = 640;
constexpr int C_BQ = 896, C_BK = 1152, C_BV = 1408, C_BZ = 1664, C_CIN = 1920, C_CZ = 2176, C_DU = 2432, C_DV = 2688, C_DZ = 2944, C_AG = 3200;

constexpr size_t al(size_t x) { return (x + 255) & ~(size_t)255; }
constexpr size_t OFF_WIN = 0;
constexpr size_t OFF_WOUT = OFF_WIN + al((size_t)4 * NP * 1024 * 2);
constexpr size_t OFF_W1 = OFF_WOUT + al((size_t)4 * 1024 * 1024 * 2);
constexpr size_t OFF_W2 = OFF_W1 + al((size_t)4 * 2 * 256 * 2048 * 2);
constexpr size_t OFF_XB = OFF_W2 + al((size_t)4 * 2 * 64 * 256 * 2);
constexpr size_t OFF_RN = OFF_XB + al((size_t)T_ * 1024 * 2);
constexpr size_t OFF_PROJ = OFF_RN + al((size_t)T_ * 4);
constexpr size_t OFF_SSQ = OFF_PROJ + al((size_t)T_ * NP * 2);
constexpr size_t OFF_KC = OFF_SSQ + al((size_t)T_ * 16 * 4);
constexpr size_t OFF_VCT = OFF_KC + al((size_t)8 * 128 * 64 * 2);
constexpr size_t OFF_OWIN = OFF_VCT + al((size_t)8 * 128 * 64 * 2);
constexpr size_t OFF_ODIL = OFF_OWIN + al((size_t)T_ * 256 * 2);
constexpr size_t OFF_LSE = OFF_ODIL + al((size_t)3 * T_ * 256 * 2);
constexpr size_t OFF_WPT = OFF_LSE + al((size_t)3 * T_ * 4 * 4);
constexpr size_t OFF_WSP = OFF_WPT + al((size_t)16 * 64 * 64 * 2);
constexpr size_t OFF_OUTB = OFF_WSP + al((size_t)16 * 128 * 128 * 2);
constexpr size_t OFF_BAR = OFF_OUTB + al((size_t)T_ * 1024 * 2);
constexpr size_t WS_TOTAL = OFF_BAR + 9 * 16384;
static_assert(WS_TOTAL <= (size_t)256 * 1024 * 1024, "workspace layout exceeds the guaranteed 256 MiB");

struct Params {
  const float *x, *g_pre, *w_in, *pe_cmp, *w_cmp1, *w_cmp2, *w_pool, *pool_scale, *sg_ln_g, *sg_ln_b, *w_sp, *b_sp, *w_out, *g_post;
  float* out;
  char* ws;
};

DI char* opq(char* q) { size_t z = 0; asm volatile("" : "+s"(z)); return q + z; }
DI int tidx() { int t = threadIdx.x; asm volatile("" : "+v"(t)); return t; }
DI float bf2f(u16 v) { return __uint_as_float((unsigned)v << 16); }
DI unsigned pk2(float a, float b) {
  typedef __bf16 bf2 __attribute__((ext_vector_type(2)));
  typedef float f2 __attribute__((ext_vector_type(2)));
  f2 v = {a, b};
  bf2 r = __builtin_convertvector(v, bf2);
  return __builtin_bit_cast(unsigned, r);
}
DI u16 f2bf(float x) { return (u16)(pk2(x, 0.f) & 0xffffu); }
DI float lo16(unsigned w) { return __uint_as_float(w << 16); }
DI float hi16(unsigned w) { return __uint_as_float(w & 0xffff0000u); }
DI int crow(int r, int hi) { return (r & 3) + 8 * (r >> 2) + 4 * hi; }
DI float ex2(float x) { return __builtin_amdgcn_exp2f(x); }
DI float sigmoidf_(float x) { return 1.f / (1.f + __expf(-x)); }
DI float siluf_(float x) { return x / (1.f + __expf(-x)); }
DI float wave_sum(float v) {
#pragma unroll
  for (int o = 32; o >= 1; o >>= 1) v += __shfl_xor(v, o, 64);
  return v;
}
DI bf16x8 pack8(const f32x16& x, int s8) {
  u32x4 p;
  p[0] = pk2(x[8 * s8 + 0], x[8 * s8 + 1]); p[1] = pk2(x[8 * s8 + 2], x[8 * s8 + 3]);
  p[2] = pk2(x[8 * s8 + 4], x[8 * s8 + 5]); p[3] = pk2(x[8 * s8 + 6], x[8 * s8 + 7]);
  return __builtin_bit_cast(bf16x8, p);
}
DI s16x4 trread(const char* p) {
  return __builtin_bit_cast(s16x4, __builtin_amdgcn_ds_read_tr16_b64_v4i16((__attribute__((address_space(3))) v4i16_t*)p));
}


#define XB_TMO      128
#define XB_XCNT(j)  (256  + 64 * (j))
#define XB_XSUB(j)  (1280 + 64 * (j))
#define XB_XGEN(j)  (2304 + 64 * (j))
#define XB_TOP      3328
#define XB_TOPGEN   3392
#define XCD_BAR_WORDS 3456
#define XB_SPIN_CAP (1u << 22)
#define LAS __attribute__((address_space(3)))
DI unsigned xb_ld(unsigned* p)              { return __hip_atomic_load(p, __ATOMIC_RELAXED, __HIP_MEMORY_SCOPE_AGENT); }
DI unsigned xb_add(unsigned* p, unsigned v) { return __hip_atomic_fetch_add(p, v, __ATOMIC_RELAXED, __HIP_MEMORY_SCOPE_AGENT); }
DI unsigned xb_xcc_id() { return (unsigned)__builtin_amdgcn_s_getreg((3 << 11) | 20) & 0xFu; }
#define XB_SPIN(cond, bar) do { unsigned _sp = 0; while (cond) { __builtin_amdgcn_s_sleep(1); \
    if ((++_sp & 255u) == 0u) { if (xb_ld(&(bar)[XB_TMO])) break; if (_sp > XB_SPIN_CAP) { atomicAdd(&(bar)[XB_TMO], 1u); break; } } } } while (0)
struct XcdBarrier { unsigned* bar; unsigned x; volatile LAS unsigned* st; unsigned G; };
DI XcdBarrier xcd_barrier_post(unsigned* bar, volatile LAS unsigned* st, unsigned G) {
    XcdBarrier b; b.bar = bar; b.x = xb_xcc_id(); b.st = st; b.G = G;
    if (threadIdx.x == 0) (void)xb_add(&bar[XB_XCNT(b.x)], 1u);
    return b;
}
DI void xcd_barrier_complete(unsigned* bar, unsigned x, unsigned G, unsigned& nloc, unsigned& nx) {
    unsigned sum, cnt, mine, sp = 0u;
    for (;;) {
        sum = 0u; cnt = 0u; mine = 0u;
#pragma unroll
        for (unsigned j = 0; j < 16; ++j) { const unsigned c = xb_ld(&bar[XB_XCNT(j)]); sum += c; cnt += (c > 0u) ? 1u : 0u; mine = (j == x) ? c : mine; }
        if (sum == G) break;
        __builtin_amdgcn_s_sleep(1);
        if ((++sp & 255u) == 0u) { if (xb_ld(&bar[XB_TMO])) break; if (sp > XB_SPIN_CAP) { atomicAdd(&bar[XB_TMO], 1u); break; } }
    }
    nloc = mine > 0u ? mine : 1u; nx = cnt > 0u ? cnt : 1u;
}
DI void xcd_barrier(const XcdBarrier& b) {
    asm volatile("s_waitcnt vmcnt(0)" ::: "memory");
    __syncthreads();
    if (threadIdx.x == 0) {
        unsigned* bar = b.bar;
        __builtin_amdgcn_s_waitcnt(0);
        unsigned nloc = b.st[0], nx = b.st[1];
        if (nloc == 0u) { xcd_barrier_complete(bar, b.x, b.G, nloc, nx); b.st[0] = nloc; b.st[1] = nx; }
        const unsigned old = xb_add(&bar[XB_XSUB(b.x)], 1u);
        const unsigned gen = old / nloc;
        if (old + 1u == (gen + 1u) * nloc) {
            __builtin_amdgcn_fence(__ATOMIC_RELEASE, "agent");
            asm volatile("s_waitcnt vmcnt(0)" ::: "memory");
            const unsigned og = xb_add(&bar[XB_TOP], 1u);
            const unsigned tg = og / nx;
            if (og + 1u == (tg + 1u) * nx) xb_add(&bar[XB_TOPGEN], 1u);
            else XB_SPIN(xb_ld(&bar[XB_TOPGEN]) == tg, bar);
            __builtin_amdgcn_fence(__ATOMIC_ACQUIRE, "agent");
            xb_add(&bar[XB_XGEN(b.x)], 1u);
            asm volatile("s_waitcnt vmcnt(0)" ::: "memory");
        } else {
            XB_SPIN(xb_ld(&bar[XB_XGEN(b.x)]) == gen, bar);
            __builtin_amdgcn_fence(__ATOMIC_ACQUIRE, "agent");
            asm volatile("s_waitcnt vmcnt(0)" ::: "memory");
        }
    }
    __syncthreads();
}

template <int WGN, int INS, int IMS, bool DB, class LdW, class LdX>
DI void gemm_core(f32x16 (&acc)[INS][IMS], const int KT, LdW ldw, LdX ldx, char* lds, const int tid) {
  constexpr int WGM = 4 / WGN;
  constexpr int WROWS = WGN * 32 * INS, XROWS = WGM * 32 * IMS, NROWS = WROWS + XROWS, NCH = NROWS / 32, NCHW = WROWS / 32, BUFB = NROWS * 144;
  const int lane = tid & 63, wid = tid >> 6, l31 = lane & 31, hi = lane >> 5;
  const int wn = (WGN == 2) ? (wid >> 1) : wid, wm = (WGN == 2) ? (wid & 1) : 0;
  const int offa = (wn * 32 * INS + l31) * 144 + hi * 16;
  const int offb = (WROWS + wm * 32 * IMS + l31) * 144 + hi * 16;
#pragma unroll
  for (int a = 0; a < INS; ++a)
#pragma unroll
    for (int b = 0; b < IMS; ++b)
#pragma unroll
      for (int r = 0; r < 16; ++r) acc[a][b][r] = 0.f;
#define GLOAD(dst, kt_) _Pragma("unroll") for (int i = 0; i < NCH; ++i) { dst[i] = (i < NCHW) ? ldw(i, tid >> 3, (kt_) * 64 + (tid & 7) * 8) : ldx(i - NCHW, tid >> 3, (kt_) * 64 + (tid & 7) * 8); }
#define LSTORE(src, base) _Pragma("unroll") for (int i = 0; i < NCH; ++i) { const int c = tid + 256 * i; *(u32x4*)((base) + (c >> 3) * 144 + (c & 7) * 16) = src[i]; }
#define COMPUTE_PIPE(buf) { const char* pa = (buf) + offa; const char* pb = (buf) + offb; \
    bf16x8 fa[2][INS], fb[2][IMS]; \
    _Pragma("unroll") for (int in = 0; in < INS; ++in) fa[0][in] = *(const bf16x8*)(pa + in * 32 * 144); \
    _Pragma("unroll") for (int im = 0; im < IMS; ++im) fb[0][im] = *(const bf16x8*)(pb + im * 32 * 144); \
    _Pragma("unroll") for (int s = 0; s < 4; ++s) { \
      if (s < 3) { _Pragma("unroll") for (int in = 0; in < INS; ++in) fa[(s + 1) & 1][in] = *(const bf16x8*)(pa + in * 32 * 144 + (s + 1) * 32); \
        _Pragma("unroll") for (int im = 0; im < IMS; ++im) fb[(s + 1) & 1][im] = *(const bf16x8*)(pb + im * 32 * 144 + (s + 1) * 32); } \
      _Pragma("unroll") for (int im = 0; im < IMS; ++im) _Pragma("unroll") for (int in = 0; in < INS; ++in) \
        acc[in][im] = MFMA(fa[s & 1][in], fb[s & 1][im], acc[in][im]); } }
#define COMPUTE_FLAT(buf) { const char* pa = (buf) + offa; const char* pb = (buf) + offb; \
    _Pragma("unroll") for (int s = 0; s < 4; ++s) { \
      bf16x8 fa[INS], fb[IMS]; \
      _Pragma("unroll") for (int in = 0; in < INS; ++in) fa[in] = *(const bf16x8*)(pa + in * 32 * 144 + s * 32); \
      _Pragma("unroll") for (int im = 0; im < IMS; ++im) fb[im] = *(const bf16x8*)(pb + im * 32 * 144 + s * 32); \
      _Pragma("unroll") for (int im = 0; im < IMS; ++im) _Pragma("unroll") for (int in = 0; in < INS; ++in) \
        acc[in][im] = MFMA(fa[in], fb[im], acc[in][im]); } }
  if (DB) {
    u32x4 preA[NCH], preB[NCH];
    GLOAD(preA, 0)
    GLOAD(preB, 1)
    __syncthreads();
    LSTORE(preA, lds)
    __syncthreads();
    for (int kt = 0; kt < KT; kt += 2) {
      if (kt + 2 < KT) { GLOAD(preA, kt + 2) }
      COMPUTE_PIPE(lds)
      LSTORE(preB, lds + BUFB)
      __syncthreads();
      if (kt + 3 < KT) { GLOAD(preB, kt + 3) }
      COMPUTE_PIPE(lds + BUFB)
      if (kt + 2 < KT) { LSTORE(preA, lds) }
      __syncthreads();
    }
  } else {
    u32x4 pre[NCH];
    GLOAD(pre, 0)
    for (int kt = 0; kt < KT; ++kt) {
      __syncthreads();
      LSTORE(pre, lds)
      __syncthreads();
      if (kt + 1 < KT) { GLOAD(pre, kt + 1) }
      if (INS >= 4) COMPUTE_FLAT(lds) else COMPUTE_PIPE(lds)
    }
  }
#undef GLOAD
#undef LSTORE
#undef COMPUTE_PIPE
#undef COMPUTE_FLAT
}

constexpr float M_INIT = -1e29f;
template <class MaskF>
DI void attn_tile(const int tid, const char* ldsK, const char* ldsV, const bf16x8 (&qr)[4], f32x16 (&o)[2], float& m, float& l, const bool MASKED, MaskF mask) {
  const int lane = tid & 63, l31 = lane & 31, hi = lane >> 5;
  f32x16 p0, p1;
#pragma unroll
  for (int r = 0; r < 16; ++r) { p0[r] = 0.f; p1[r] = 0.f; }
  const char* kp = ldsK + l31 * 144 + hi * 16;
#pragma unroll
  for (int s = 0; s < 4; ++s) {
    const bf16x8 k0 = *(const bf16x8*)(kp + s * 32), k1 = *(const bf16x8*)(kp + 32 * 144 + s * 32);
    p0 = MFMA(k0, qr[s], p0); p1 = MFMA(k1, qr[s], p1);
  }
  if (MASKED) {
#pragma unroll
    for (int r = 0; r < 16; ++r) {
      const int kr = crow(r, hi);
      p0[r] = mask(kr) ? p0[r] : NEGB; p1[r] = mask(kr + 32) ? p1[r] : NEGB;
    }
  }
  const char* vb = ldsV + (4 * hi + ((lane & 15) >> 2)) * 144 + ((lane >> 4) & 1) * 32 + (lane & 3) * 8;
  s16x4 vlo[8], vhi[8];
#pragma unroll
  for (int s4 = 0; s4 < 4; ++s4)
#pragma unroll
    for (int db = 0; db < 2; ++db) { vlo[s4 * 2 + db] = trread(vb + (16 * s4) * 144 + db * 64); vhi[s4 * 2 + db] = trread(vb + (16 * s4 + 8) * 144 + db * 64); }
  __builtin_amdgcn_sched_barrier(0);
  float mx = fmaxf(p0[0], p1[0]);
#pragma unroll
  for (int r = 1; r < 16; ++r) mx = fmaxf(fmaxf(mx, p0[r]), p1[r]);
  { auto rr = __builtin_amdgcn_permlane32_swap(__float_as_uint(mx), __float_as_uint(mx), false, false); mx = fmaxf(__uint_as_float(rr[0]), __uint_as_float(rr[1])); }
  const float mxs = mx * C2;
  if (__any(mxs > m + 8.f)) {
    const float mn = fmaxf(m, mxs), alpha = ex2(m - mn);
    m = mn; l *= alpha;
#pragma unroll
    for (int r = 0; r < 16; ++r) { o[0][r] *= alpha; o[1][r] *= alpha; }
  }
  const float nm = -m;
  float rs = 0.f;
#pragma unroll
  for (int r = 0; r < 16; ++r) { p0[r] = ex2(__builtin_fmaf(p0[r], C2, nm)); p1[r] = ex2(__builtin_fmaf(p1[r], C2, nm)); rs += p0[r] + p1[r]; }
  l += rs;
  bf16x8 pw[4];
  pw[0] = pack8(p0, 0); pw[1] = pack8(p0, 1); pw[2] = pack8(p1, 0); pw[3] = pack8(p1, 1);
#pragma unroll
  for (int s4 = 0; s4 < 4; ++s4) {
#pragma unroll
    for (int db = 0; db < 2; ++db) {
      const s16x4 lo = vlo[s4 * 2 + db], hh = vhi[s4 * 2 + db];
      const bf16x8 vf = {lo[0], lo[1], lo[2], lo[3], hh[0], hh[1], hh[2], hh[3]};
      o[db] = MFMA(vf, pw[s4], o[db]);
    }
  }
}

template <class RowF>
DI void kv_load(const int tid, u32x4 (&pre)[4], RowF rowtok, const u16* proj, int kcol, int vcol) {
#pragma unroll
  for (int i = 0; i < 2; ++i) {
    const int c = tid + 256 * i, row = c >> 3, ch = c & 7;
    const u16* p = proj + (size_t)rowtok(row) * NP + ch * 8;
    pre[i] = *(const u32x4*)(p + kcol); pre[2 + i] = *(const u32x4*)(p + vcol);
  }
}
DI void kv_store(const int tid, const u32x4 (&pre)[4], char* ldsK, char* ldsV) {
#pragma unroll
  for (int i = 0; i < 2; ++i) {
    const int c = tid + 256 * i, row = c >> 3, ch = c & 7;
    *(u32x4*)(ldsK + row * 144 + ch * 16) = pre[i]; *(u32x4*)(ldsV + row * 144 + ch * 16) = pre[2 + i];
  }
}

template <class RowF, class FullF, class MaskF>
DI void attn_stream(const int tid, const u16* proj, const int kcol, const int vcol, const int nt, RowF rowtok, FullF full, MaskF mask,
                    const bf16x8 (&qr)[4], f32x16 (&o)[2], float& m, float& l, char* lds) {
  u32x4 preA[4], preB[4];
  if (nt > 0) kv_load(tid, preA, [&](int row) { return rowtok(0, row); }, proj, kcol, vcol);
  if (nt > 1) kv_load(tid, preB, [&](int row) { return rowtok(1, row); }, proj, kcol, vcol);
  for (int ti = 0; ti < nt; ti += 2) {
    kv_store(tid, preA, lds, lds + 9216);
    __syncthreads();
    if (ti + 2 < nt) kv_load(tid, preA, [&](int row) { return rowtok(ti + 2, row); }, proj, kcol, vcol);
    attn_tile(tid, lds, lds + 9216, qr, o, m, l, !full(ti), [&](int kr) { return mask(ti, kr); });
    if (ti + 1 < nt) {
      kv_store(tid, preB, lds + 18432, lds + 27648);
      __syncthreads();
      if (ti + 3 < nt) kv_load(tid, preB, [&](int row) { return rowtok(ti + 3, row); }, proj, kcol, vcol);
      attn_tile(tid, lds + 18432, lds + 27648, qr, o, m, l, !full(ti + 1), [&](int kr) { return mask(ti + 1, kr); });
    }
  }
}

DI int mapcol(int n, int mode) {
  if (mode == 0) return n;
  if (n < 640) return n;
  if (n < 3200) return n + 12;
  if (n < 3212) return n - 3200 + 640;
  return -1;
}
DI void tr_tile(const float* src, int ldsrc, u16* dst, int ldd, int k0, int n0, const float* g, int mode, char* lds) {
  float* t = (float*)lds;
  const int tid = threadIdx.x;
  float v[16];
#pragma unroll
  for (int i = 0; i < 16; ++i) {
    const int e = tid + 256 * i, kk = e >> 6, nn = e & 63;
    const int sc = mapcol(n0 + nn, mode);
    v[i] = sc >= 0 ? src[(size_t)(k0 + kk) * ldsrc + sc] : 0.f;
  }
  if (g) {
#pragma unroll
    for (int i = 0; i < 16; ++i) v[i] *= g[k0 + ((tid + 256 * i) >> 6)];
  }
#pragma unroll
  for (int i = 0; i < 16; ++i) { const int e = tid + 256 * i, kk = e >> 6, nn = e & 63; t[kk * 65 + nn] = v[i]; }
  __syncthreads();
#pragma unroll
  for (int i = 0; i < 2; ++i) {
    const int e = tid + 256 * i, nn = e >> 3, k8 = (e & 7) * 8;
    u32x4 o;
    o[0] = pk2(t[(k8 + 0) * 65 + nn], t[(k8 + 1) * 65 + nn]); o[1] = pk2(t[(k8 + 2) * 65 + nn], t[(k8 + 3) * 65 + nn]);
    o[2] = pk2(t[(k8 + 4) * 65 + nn], t[(k8 + 5) * 65 + nn]); o[3] = pk2(t[(k8 + 6) * 65 + nn], t[(k8 + 7) * 65 + nn]);
    *(u32x4*)(dst + (size_t)(n0 + nn) * ldd + k0 + k8) = o;
  }
  __syncthreads();
}

template <int NR>
DI void rows_convert(const float* x0, u16* xb0, float* rn0) {
  const int lane = tidx() & 63;
  f32x4 v[NR][4];
#pragma unroll
  for (int r = 0; r < NR; ++r)
#pragma unroll
    for (int i = 0; i < 4; ++i) v[r][i] = *(const f32x4*)(x0 + (size_t)r * 1024 + i * 256 + lane * 4);
#pragma unroll
  for (int r = 0; r < NR; ++r) {
    float ss = 0.f;
#pragma unroll
    for (int i = 0; i < 4; ++i) {
      ss += v[r][i][0] * v[r][i][0] + v[r][i][1] * v[r][i][1] + v[r][i][2] * v[r][i][2] + v[r][i][3] * v[r][i][3];
      u32x2 o; o[0] = pk2(v[r][i][0], v[r][i][1]); o[1] = pk2(v[r][i][2], v[r][i][3]);
      *(u32x2*)(xb0 + (size_t)r * 1024 + i * 256 + lane * 4) = o;
    }
    ss = wave_sum(ss);
    if (lane == 0) rn0[r] = rsqrtf(ss * (1.f / 1024.f) + 1e-6f);
  }
}

template <int NTW>
DI void inproj_tile(const Params& p, int l, int mt, int ntile, char* lds) {
  char* const ws_ = opq(p.ws);
  const u16* W = (const u16*)(ws_ + OFF_WIN) + ((size_t)l * NP + ntile * 64 * NTW) * 1024;
  const u16* X = (const u16*)(ws_ + OFF_XB) + (size_t)mt * 128 * 1024;
  f32x16 acc[NTW][2];
  const int tid = tidx();
  gemm_core<2, NTW, 2, (NTW == 2)>(acc, 16, [&](int i, int r0, int k) -> u32x4 { return *(const u32x4*)((W + i * 32768) + (unsigned)(r0 * 1024 + k)); },
               [&](int i, int r0, int k) -> u32x4 { return *(const u32x4*)((X + i * 32768) + (unsigned)(r0 * 1024 + k)); }, lds, tid);
  const int lane = tid & 63, wid = tid >> 6, l31 = lane & 31, hi = lane >> 5, wn = wid >> 1, wm = wid & 1;
  const float* rn = (const float*)(ws_ + OFF_RN);
  u16* proj = (u16*)(ws_ + OFF_PROJ);
  constexpr int NCOLS = 64 * NTW, RS = NCOLS * 2 + 16;
  __syncthreads();
#pragma unroll
  for (int im = 0; im < 2; ++im) {
    const int tl = wm * 64 + im * 32 + l31;
    const float r = rn[(size_t)mt * 128 + tl];
#pragma unroll
    for (int in = 0; in < NTW; ++in)
#pragma unroll
      for (int g = 0; g < 4; ++g) {
        const int n = wn * 32 * NTW + in * 32 + 8 * g + 4 * hi;
        u32x2 o; o[0] = pk2(acc[in][im][4 * g] * r, acc[in][im][4 * g + 1] * r); o[1] = pk2(acc[in][im][4 * g + 2] * r, acc[in][im][4 * g + 3] * r);
        *(u32x2*)(lds + tl * RS + n * 2) = o;
      }
  }
  __syncthreads();
#pragma unroll 4
  for (int i = 0; i < NCOLS / 16; ++i) {
    const int c = tid + 256 * i, tl = c / (NCOLS / 8), ch = c % (NCOLS / 8);
    const u32x4 v = *(const u32x4*)(lds + tl * RS + ch * 16);
    *(u32x4*)(proj + ((size_t)mt * 128 + tl) * NP + ntile * NCOLS + ch * 8) = v;
  }
}

DI void outproj_item(const Params& p, int l, int it, char* lds) {
  char* const ws_ = opq(p.ws);
  const int mt = (it & 7) * 16 + ((it >> 3) & 15), nt = it >> 7;
  const u16* W = (const u16*)(ws_ + OFF_WOUT) + ((size_t)l * 1024 + nt * 256) * 1024;
  const u16* Y = (const u16*)(ws_ + OFF_XB) + (size_t)mt * 128 * 1024;
  f32x16 acc[4][2];
  const int tid = tidx();
  gemm_core<2, 4, 2, false>(acc, 16, [&](int i, int r0, int k) -> u32x4 { return *(const u32x4*)((W + i * 32768) + (unsigned)(r0 * 1024 + k)); },
               [&](int i, int r0, int k) -> u32x4 { return *(const u32x4*)((Y + i * 32768) + (unsigned)(r0 * 1024 + k)); }, lds, tid);
  const int lane = tid & 63, wid = tid >> 6, l31 = lane & 31, hi = lane >> 5, wn = wid >> 1, wm = wid & 1;
  u16* outb = (u16*)(ws_ + OFF_OUTB);
  float* ssq = (float*)(ws_ + OFF_SSQ);
  constexpr int RS = 256 * 2 + 16;
  __syncthreads();
#pragma unroll
  for (int im = 0; im < 2; ++im) {
    const int tl = wm * 64 + im * 32 + l31;
    float ss = 0.f;
#pragma unroll
    for (int in = 0; in < 4; ++in)
#pragma unroll
      for (int g = 0; g < 4; ++g) {
        const int n = wn * 128 + in * 32 + 8 * g + 4 * hi;
        const float o0 = acc[in][im][4 * g], o1 = acc[in][im][4 * g + 1], o2 = acc[in][im][4 * g + 2], o3 = acc[in][im][4 * g + 3];
        ss += o0 * o0 + o1 * o1 + o2 * o2 + o3 * o3;
        u32x2 v; v[0] = pk2(o0, o1); v[1] = pk2(o2, o3);
        *(u32x2*)(lds + tl * RS + n * 2) = v;
      }
    ss += __shfl_xor(ss, 32, 64);
    if (hi == 0) ssq[((size_t)mt * 128 + tl) * 16 + nt * 2 + wn] = ss;
  }
  __syncthreads();
#pragma unroll 4
  for (int i = 0; i < 16; ++i) {
    const int c = tid + 256 * i, tl = c >> 5, ch = c & 31;
    const u32x4 v = *(const u32x4*)(lds + tl * RS + ch * 16);
    *(u32x4*)(outb + ((size_t)mt * 128 + tl) * 1024 + nt * 256 + ch * 8) = v;
  }
}

template <int NR>
DI void resid_rows(const Params& p, int l, int row0, const float* xin) {
  char* const ws_ = opq(p.ws);
  const int lane = tidx() & 63;
  const u16* outb = (const u16*)(ws_ + OFF_OUTB);
  const float* ssq = (const float*)(ws_ + OFF_SSQ);
  u32x2 ob[NR][4]; f32x4 xv[NR][4]; f32x4 sq[NR][2];
#pragma unroll
  for (int r = 0; r < NR; ++r) {
    const size_t row = (size_t)(row0 + r);
    sq[r][0] = *(const f32x4*)(ssq + row * 16); sq[r][1] = *(const f32x4*)(ssq + row * 16 + 4);
#pragma unroll
    for (int i = 0; i < 4; ++i) { const int idx = i * 256 + lane * 4; ob[r][i] = *(const u32x2*)(outb + row * 1024 + idx); xv[r][i] = *(const f32x4*)(xin + row * 1024 + idx); }
  }
  f32x4 gq[4];
#pragma unroll
  for (int i = 0; i < 4; ++i) gq[i] = *(const f32x4*)(p.g_post + l * 1024 + i * 256 + lane * 4);
  u16* xb = (u16*)(ws_ + OFF_XB);
#pragma unroll
  for (int r = 0; r < NR; ++r) {
    const size_t row = (size_t)(row0 + r);
    const float ss = ((sq[r][0][0] + sq[r][0][1]) + (sq[r][0][2] + sq[r][0][3])) + ((sq[r][1][0] + sq[r][1][1]) + (sq[r][1][2] + sq[r][1][3]));
    const float r2 = rsqrtf(ss * (1.f / 1024.f) + 1e-6f);
    float s2 = 0.f;
#pragma unroll
    for (int i = 0; i < 4; ++i) {
      const int idx = i * 256 + lane * 4;
      const f32x4 o = {lo16(ob[r][i][0]), hi16(ob[r][i][0]), lo16(ob[r][i][1]), hi16(ob[r][i][1])};
      f32x4 xn;
#pragma unroll
      for (int e = 0; e < 4; ++e) { xn[e] = xv[r][i][e] + o[e] * r2 * gq[i][e]; s2 += xn[e] * xn[e]; }
      *(f32x4*)(p.out + row * 1024 + idx) = xn;
      if (l < 3) { u32x2 o2; o2[0] = pk2(xn[0], xn[1]); o2[1] = pk2(xn[2], xn[3]); *(u32x2*)(xb + row * 1024 + idx) = o2; }
    }
    s2 = wave_sum(s2);
    if (lane == 0) ((float*)(ws_ + OFF_RN))[row] = rsqrtf(s2 * (1.f / 1024.f) + 1e-6f);
  }
}

DI void cmp_item(const Params& p, int l, int it, char* lds) {
  char* const ws_ = opq(p.ws);
  const int j = it >> 5, mt = (it & 7) * 4 + ((it >> 3) & 3);
  const u16* proj = (const u16*)(ws_ + OFF_PROJ);
  const u16* W1 = (const u16*)(ws_ + OFF_W1) + (size_t)(l * 2 + j) * 256 * 2048;
  const u16* W2 = (const u16*)(ws_ + OFF_W2) + (size_t)(l * 2 + j) * 64 * 256;
  const float* pe = p.pe_cmp + (size_t)(l * 2 + j) * 32 * 64;
  const int kvcol = C_KCMP + 64 * j;
  f32x16 acc[2][1];
  const int tid = tidx();
  gemm_core<4, 2, 1, false>(acc, 32, [&](int i, int r0, int k) -> u32x4 { return *(const u32x4*)((W1 + i * 65536) + (unsigned)(r0 * 2048 + k)); },
   [&](int i, int row, int k) -> u32x4 {
    const int rr = mt * 32 + row, b = rr >> 7; int n = rr & 127; if (n > 126) n = 126;
    const int l32 = k >> 6, d = k & 63;
    const u32x4 raw = *(const u32x4*)(proj + ((size_t)b * S_ + 16 * n + l32) * NP + kvcol + d);
    const f32x4 e0 = *(const f32x4*)(pe + l32 * 64 + d), e1 = *(const f32x4*)(pe + l32 * 64 + d + 4);
    u32x4 o;
    o[0] = pk2(lo16(raw[0]) + e0[0], hi16(raw[0]) + e0[1]); o[1] = pk2(lo16(raw[1]) + e0[2], hi16(raw[1]) + e0[3]);
    o[2] = pk2(lo16(raw[2]) + e1[0], hi16(raw[2]) + e1[1]); o[3] = pk2(lo16(raw[3]) + e1[2], hi16(raw[3]) + e1[3]);
    return o; }, lds, tid);
  const int lane = tid & 63, wid = tid >> 6, l31 = lane & 31, hi = lane >> 5;
#pragma unroll
  for (int a = 0; a < 2; ++a)
#pragma unroll
    for (int r = 0; r < 16; ++r) {
      const float x = acc[a][0][r]; const float u = 0.7978845608028654f * (x + 0.044715f * x * x * x);
      acc[a][0][r] = x / (1.f + __expf(-2.f * u));
    }
  f32x16 c2[2];
#pragma unroll
  for (int r = 0; r < 16; ++r) { c2[0][r] = 0.f; c2[1][r] = 0.f; }
#pragma unroll
  for (int in = 0; in < 2; ++in)
#pragma unroll
    for (int s2 = 0; s2 < 2; ++s2) {
      const bf16x8 h0 = pack8(acc[in][0], s2);
#pragma unroll
      for (int dt = 0; dt < 2; ++dt) {
        const u16* wp = W2 + (size_t)(dt * 32 + l31) * 256 + wid * 64 + in * 32 + 16 * s2 + 4 * hi;
        const s16x4 lo = *(const s16x4*)wp, hh = *(const s16x4*)(wp + 8);
        const bf16x8 wf = {lo[0], lo[1], lo[2], lo[3], hh[0], hh[1], hh[2], hh[3]};
        c2[dt] = MFMA(wf, h0, c2[dt]);
      }
    }
  float* red = (float*)lds;
  __syncthreads();
  for (int w = 0; w < 4; ++w) {
    if (wid == w) {
#pragma unroll
      for (int dt = 0; dt < 2; ++dt)
#pragma unroll
        for (int r = 0; r < 16; ++r) {
          float* q = red + (dt * 32 + crow(r, hi)) * 32 + l31;
          if (w == 0) *q = c2[dt][r]; else *q += c2[dt][r];
        }
    }
    __syncthreads();
  }
  u16* kc = (u16*)(ws_ + OFF_KC); u16* vct = (u16*)(ws_ + OFF_VCT);
#pragma unroll 4
  for (int i = 0; i < 8; ++i) {
    const int e = tid + 256 * i;
    if (j == 0) { const int tok = e >> 6, d = e & 63; const int rr = mt * 32 + tok; kc[(size_t)rr * 64 + d] = f2bf(red[d * 32 + tok]); }
    else { const int d = e >> 5, tok = e & 31; const int rr = mt * 32 + tok, b = rr >> 7, n = rr & 127; vct[((size_t)b * 64 + d) * 128 + n] = f2bf(red[d * 32 + tok]); }
  }
  __syncthreads();
}

DI void win_item(const Params& p, int it, char* lds) {
  char* const ws_ = opq(p.ws);
  const int b = it & 7, qt = it >> 3, q0 = qt * 32;
  const int tid = tidx(), lane = tid & 63, h = tid >> 6, l31 = lane & 31, hi = lane >> 5;
  const u16* proj = (const u16*)(ws_ + OFF_PROJ);
  const int t = q0 + l31; const size_t tok = (size_t)b * S_ + t;
  bf16x8 qr[4];
#pragma unroll
  for (int s = 0; s < 4; ++s) qr[s] = *(const bf16x8*)(proj + tok * NP + C_AQ + h * 64 + 16 * s + 8 * hi);
  char* ldsK = lds; char* ldsV = lds + 9216;
  f32x16 o[2];
#pragma unroll
  for (int r = 0; r < 16; ++r) { o[0][r] = 0.f; o[1][r] = 0.f; }
  float m = M_INIT, lsum = 0.f;
  const int klo = (q0 - 511 > 0 ? q0 - 511 : 0) >> 6, khi = (q0 + 31) >> 6;
  __syncthreads();
  attn_stream(tid, proj, C_KWIN, C_VWIN, khi - klo + 1,
              [&](int ti, int row) { return b * S_ + (klo + ti) * 64 + row; },
              [&](int ti) { const int k0 = (klo + ti) * 64; return (k0 + 63 <= q0) && (k0 >= q0 + 31 - 511); },
              [&](int ti, int kr) { return (unsigned)(t - ((klo + ti) * 64 + kr)) <= 511u; },
              qr, o, m, lsum, lds);
  lsum += __shfl_xor(lsum, 32, 64);
  const float il = 1.f / lsum;
  u16* ow = (u16*)(ws_ + OFF_OWIN);
#pragma unroll
  for (int db = 0; db < 2; ++db)
#pragma unroll
    for (int g = 0; g < 4; ++g) {
      const int d0 = 32 * db + 8 * g + 4 * hi;
      u32x2 v; v[0] = pk2(o[db][4 * g] * il, o[db][4 * g + 1] * il); v[1] = pk2(o[db][4 * g + 2] * il, o[db][4 * g + 3] * il);
      *(u32x2*)(ow + tok * 256 + h * 64 + d0) = v;
    }
}

DI void dil_item(const Params& p, int it, char* lds) {
  char* const ws_ = opq(p.ws);
  const int di = it >> 9, rem = it & 511, b = rem & 7, h = (rem >> 3) & 3, c = rem >> 5;
  const int sh = 2 * di, dil = 1 << sh;
  const int tpr = 16 >> sh;
  const int r = c / tpr, mt = c % tpr, m0 = mt * 128;
  const int tid = tidx(), lane = tid & 63, wid = tid >> 6, l31 = lane & 31, hi = lane >> 5;
  const u16* proj = (const u16*)(ws_ + OFF_PROJ);
  const int mq = m0 + 32 * wid + l31;
  const size_t tok = (size_t)b * S_ + mq * dil + r;
  bf16x8 qr[4];
#pragma unroll
  for (int s = 0; s < 4; ++s) qr[s] = *(const bf16x8*)(proj + tok * NP + C_BQ + h * 64 + 16 * s + 8 * hi);
  const int tt0 = (m0 == 0) ? 2 : 0;
  {
    u32x4 pre[4][4];
#pragma unroll
    for (int tt = 0; tt < 4; ++tt)
      if (tt >= tt0) kv_load(tid, pre[tt], [&](int row) { return b * S_ + (m0 - 128 + 64 * tt + row) * dil + r; }, proj, C_BK + h * 64, C_BV + h * 64);
    __syncthreads();
#pragma unroll
    for (int tt = 0; tt < 4; ++tt)
      if (tt >= tt0) kv_store(tid, pre[tt], lds + tt * 18432, lds + tt * 18432 + 9216);
    __syncthreads();
  }
  f32x16 o[2];
#pragma unroll
  for (int rr = 0; rr < 16; ++rr) { o[0][rr] = 0.f; o[1][rr] = 0.f; }
  float m = M_INIT, lsum = 0.f;
  const int widu = __builtin_amdgcn_readfirstlane(wid);
  const int wlo = m0 + 32 * widu - 128, whi = m0 + 32 * widu + 31;
  for (int tt = tt0; tt < 4; ++tt) {
    const int tk0 = m0 - 128 + 64 * tt;
    if (tk0 + 63 >= wlo && tk0 <= whi) {
      attn_tile(tid, lds + tt * 18432, lds + tt * 18432 + 9216, qr, o, m, lsum, !(tk0 + 63 <= wlo + 128 && tk0 >= whi - 128), [&](int kr) { return (unsigned)(mq - (tk0 + kr)) <= 128u; });
    }
  }
  lsum += __shfl_xor(lsum, 32, 64);
  const float il = 1.f / lsum;
  u16* od = (u16*)(ws_ + OFF_ODIL) + (size_t)di * T_ * 256;
#pragma unroll
  for (int db = 0; db < 2; ++db)
#pragma unroll
    for (int g = 0; g < 4; ++g) {
      const int d0 = 32 * db + 8 * g + 4 * hi;
      u32x2 v; v[0] = pk2(o[db][4 * g] * il, o[db][4 * g + 1] * il); v[1] = pk2(o[db][4 * g + 2] * il, o[db][4 * g + 3] * il);
      *(u32x2*)(od + tok * 256 + h * 64 + d0) = v;
    }
  if (hi == 0) ((float*)(ws_ + OFF_LSE))[((size_t)di * T_ + tok) * 4 + h] = m * 0.6931471805599453f + __logf(lsum);
}

DI void pool_item(const Params& p, int l, int it, char* lds) {
  char* const ws_ = opq(p.ws);
  const int b = it & 7, qt = it >> 3, q0 = qt * 32;
  const int tid = tidx(), lane = tid & 63, g = tid >> 6, l31 = lane & 31, hi = lane >> 5;
  const u16* proj = (const u16*)(ws_ + OFF_PROJ);
  u16* cin = (u16*)lds;
  char* pl = lds + 48 * 512;
  u32x4 cv[6];
#pragma unroll
  for (int i = 0; i < 6; ++i) {
    const int c = tid + 256 * i, row = c >> 5, ch = c & 31; const int t = q0 - 16 + row;
    cv[i] = u32x4{0u, 0u, 0u, 0u};
    if (t >= 0) cv[i] = *(const u32x4*)(proj + ((size_t)b * S_ + t) * NP + C_CIN + ch * 8);
  }
  const u16* wpt = (const u16*)(ws_ + OFF_WPT) + (size_t)(l * 4 + g) * 4096;
  bf16x8 af[8];
#pragma unroll
  for (int q = 0; q < 8; ++q) af[q] = *(const bf16x8*)(wpt + ((q & 1) * 32 + l31) * 64 + 16 * (q >> 1) + 8 * hi);
  const size_t tok = (size_t)b * S_ + q0 + l31;
  f32x4 psv[8]; u32x2 zv[8];
#pragma unroll
  for (int q = 0; q < 8; ++q) {
    const int col = g * 64 + (q >> 2) * 32 + 8 * (q & 3) + 4 * hi;
    psv[q] = *(const f32x4*)(p.pool_scale + l * 256 + col); zv[q] = *(const u32x2*)(proj + tok * NP + C_CZ + col);
  }
  __syncthreads();
#pragma unroll
  for (int i = 0; i < 6; ++i) { const int c = tid + 256 * i, row = c >> 5, ch = c & 31; *(u32x4*)(cin + row * 256 + ch * 8) = cv[i]; }
  __syncthreads();
  {
    const int ch = tid, w = 2 << g;
    float s = 0.f;
    for (int r = 17 - w; r <= 16; ++r) s += bf2f(cin[r * 256 + ch]);
#pragma unroll 4
    for (int i = 0; i < 32; ++i) {
      const int t = q0 + i; const int cnt = (t + 1 < w) ? t + 1 : w;
      const float self = bf2f(cin[(i + 16) * 256 + ch]);
      *(u16*)(pl + i * 528 + ch * 2) = f2bf(s / (float)cnt - self);
      s += bf2f(cin[(i + 17) * 256 + ch]) - bf2f(cin[(i + 17 - w) * 256 + ch]);
    }
  }
  __syncthreads();
  f32x16 acc[2];
#pragma unroll
  for (int r = 0; r < 16; ++r) { acc[0][r] = 0.f; acc[1][r] = 0.f; }
#pragma unroll
  for (int s4 = 0; s4 < 4; ++s4) {
    const bf16x8 bf = *(const bf16x8*)(pl + l31 * 528 + (g * 64 + 16 * s4 + 8 * hi) * 2);
#pragma unroll
    for (int dt = 0; dt < 2; ++dt) acc[dt] = MFMA(af[s4 * 2 + dt], bf, acc[dt]);
  }
  u16* y = (u16*)(ws_ + OFF_XB);
#pragma unroll
  for (int dt = 0; dt < 2; ++dt)
#pragma unroll
    for (int g4 = 0; g4 < 4; ++g4) {
      const int col = g * 64 + dt * 32 + 8 * g4 + 4 * hi;
      const f32x4 ps = psv[dt * 4 + g4];
      const u32x2 z = zv[dt * 4 + g4];
      u32x2 v;
      v[0] = pk2(acc[dt][4 * g4] * ps[0] * siluf_(lo16(z[0])), acc[dt][4 * g4 + 1] * ps[1] * siluf_(hi16(z[0])));
      v[1] = pk2(acc[dt][4 * g4 + 2] * ps[2] * siluf_(lo16(z[1])), acc[dt][4 * g4 + 3] * ps[3] * siluf_(hi16(z[1])));
      *(u32x2*)(y + tok * 1024 + 512 + col) = v;
    }
}

DI void sgu_item(const Params& p, int l, int it, char* lds) {
  char* const ws_ = opq(p.ws);
  const int b = it & 7, c = (it >> 5) & 15, g = (it >> 3) & 3, t0 = c * 128;
  const int tid = tidx(), lane = tid & 63, l31 = lane & 31, hi = lane >> 5;
  const int wid = __builtin_amdgcn_readfirstlane(tid >> 6);
  const u16* proj = (const u16*)(ws_ + OFF_PROJ);
  char* vn = lds;
  __syncthreads();
  {
    const int j = tid >> 1, half = tid & 1;
    const u16* vp = proj + ((size_t)b * S_ + t0 + j) * NP + C_DV + half * 128;
    u32x4 raw[16];
#pragma unroll
    for (int i = 0; i < 16; ++i) raw[i] = *(const u32x4*)(vp + i * 8);
    float s1 = 0.f;
#pragma unroll
    for (int i = 0; i < 16; ++i)
#pragma unroll
      for (int e = 0; e < 4; ++e) s1 += lo16(raw[i][e]) + hi16(raw[i][e]);
    s1 += __shfl_xor(s1, 1, 64);
    const float mu = s1 * (1.f / 256.f);
    float s2 = 0.f;
#pragma unroll
    for (int i = 0; i < 16; ++i)
#pragma unroll
      for (int e = 0; e < 4; ++e) { const float a = lo16(raw[i][e]) - mu, bb = hi16(raw[i][e]) - mu; s2 += a * a + bb * bb; }
    s2 += __shfl_xor(s2, 1, 64);
    const float rstd = rsqrtf(s2 * (1.f / 256.f) + 1e-5f);
    if (half == (g >> 1)) {
      const float* lg = p.sg_ln_g + l * 256 + g * 64; const float* lb = p.sg_ln_b + l * 256 + g * 64;
      auto emit = [&](const u32x4& r, int i) {
        const f32x4 g0 = *(const f32x4*)(lg + i * 8), g1 = *(const f32x4*)(lg + i * 8 + 4), b0 = *(const f32x4*)(lb + i * 8), b1 = *(const f32x4*)(lb + i * 8 + 4);
        u32x4 o;
        o[0] = pk2((lo16(r[0]) - mu) * rstd * g0[0] + b0[0], (hi16(r[0]) - mu) * rstd * g0[1] + b0[1]);
        o[1] = pk2((lo16(r[1]) - mu) * rstd * g0[2] + b0[2], (hi16(r[1]) - mu) * rstd * g0[3] + b0[3]);
        o[2] = pk2((lo16(r[2]) - mu) * rstd * g1[0] + b1[0], (hi16(r[2]) - mu) * rstd * g1[1] + b1[1]);
        o[3] = pk2((lo16(r[3]) - mu) * rstd * g1[2] + b1[2], (hi16(r[3]) - mu) * rstd * g1[3] + b1[3]);
        *(u32x4*)(vn + j * 144 + i * 16) = o;
      };
      if (g & 1) {
#pragma unroll
        for (int i = 0; i < 8; ++i) emit(raw[8 + i], i);
      } else {
#pragma unroll
        for (int i = 0; i < 8; ++i) emit(raw[i], i);
      }
    }
  }
  __syncthreads();
  const int i = wid * 32 + l31;
  const u16* wsp = (const u16*)(ws_ + OFF_WSP) + ((size_t)(l * 4 + g) * 128 + i) * 128;
  f32x16 acc[2];
#pragma unroll
  for (int r = 0; r < 16; ++r) { acc[0][r] = 0.f; acc[1][r] = 0.f; }
  const int nks = 2 * (wid + 1);
  bf16x8 wfr[8];
#pragma unroll
  for (int s = 0; s < 8; ++s) { if (s < nks) wfr[s] = *(const bf16x8*)(wsp + 16 * s + 8 * hi); else wfr[s] = bf16x8{0, 0, 0, 0, 0, 0, 0, 0}; }
  const char* vb = vn + (8 * hi + ((lane & 15) >> 2)) * 144 + ((lane >> 4) & 1) * 32 + (lane & 3) * 8;
#pragma unroll
  for (int s = 0; s < 8; ++s) {
    if (s < nks) {
#pragma unroll
      for (int ct = 0; ct < 2; ++ct) {
        const s16x4 lo = trread(vb + (16 * s) * 144 + ct * 64), hh = trread(vb + (16 * s + 4) * 144 + ct * 64);
        const bf16x8 af = {lo[0], lo[1], lo[2], lo[3], hh[0], hh[1], hh[2], hh[3]};
        acc[ct] = MFMA(af, wfr[s], acc[ct]);
      }
    }
  }
  const size_t tok = (size_t)b * S_ + t0 + i;
  const float bs = p.b_sp[(l * 4 + g) * 128 + i];
  u16* y = (u16*)(ws_ + OFF_XB);
#pragma unroll
  for (int ct = 0; ct < 2; ++ct)
#pragma unroll
    for (int g4 = 0; g4 < 4; ++g4) {
      const int col = g * 64 + ct * 32 + 8 * g4 + 4 * hi;
      const u32x2 u = *(const u32x2*)(proj + tok * NP + C_DU + col), z = *(const u32x2*)(proj + tok * NP + C_DZ + col);
      u32x2 v;
      v[0] = pk2(lo16(u[0]) * (acc[ct][4 * g4] + bs) * siluf_(lo16(z[0])), hi16(u[0]) * (acc[ct][4 * g4 + 1] + bs) * siluf_(hi16(z[0])));
      v[1] = pk2(lo16(u[1]) * (acc[ct][4 * g4 + 2] + bs) * siluf_(lo16(z[1])), hi16(u[1]) * (acc[ct][4 * g4 + 3] + bs) * siluf_(hi16(z[1])));
      *(u32x2*)(y + tok * 1024 + 768 + col) = v;
    }
}

DI void nsa_item(const Params& p, int it, char* lds) {
  char* const ws_ = opq(p.ws);
  const int b = it & 7, qt = 63 - (it >> 3), q0 = qt * 32;
  const int tid = tidx(), lane = tid & 63, h = tid >> 6, l31 = lane & 31, hi = lane >> 5;
  const u16* proj = (const u16*)(ws_ + OFF_PROJ);
  const int t = q0 + l31; const size_t tok = (size_t)b * S_ + t;
  bf16x8 qr[4];
#pragma unroll
  for (int s = 0; s < 4; ++s) qr[s] = *(const bf16x8*)(proj + tok * NP + C_AQ + h * 64 + 16 * s + 8 * hi);
  char* ldsK = lds; char* ldsV = lds + 9216;
  float* impS = (float*)(lds + 36864);
  float* vals = (float*)(lds + 36864 + 16384);
  unsigned* selm = (unsigned*)(lds + 73728 - 256);
  int* jlist = (int*)(lds + 73728 - 128);
  float* yst = (float*)(lds + 36864);
  __syncthreads();
  if (tid < 32) selm[tid] = 0u;
  const float g0 = sigmoidf_(bf2f(proj[tok * NP + C_AG + 0 + h])), g1 = sigmoidf_(bf2f(proj[tok * NP + C_AG + 4 + h])), g2 = sigmoidf_(bf2f(proj[tok * NP + C_AG + 8 + h]));
  f32x16 ya[2];
  {
    const u16* kc = (const u16*)(ws_ + OFF_KC); const u16* vct = (const u16*)(ws_ + OFF_VCT);
    f32x16 sc[4];
    const int nkb = (((q0 + 31 - 31) >> 4) >> 5) + 1;
#pragma unroll
    for (int kb = 0; kb < 4; ++kb) {
#pragma unroll
      for (int r = 0; r < 16; ++r) sc[kb][r] = 0.f;
      if (kb < nkb) {
#pragma unroll
        for (int s = 0; s < 4; ++s) {
          const bf16x8 kf = *(const bf16x8*)(kc + ((size_t)(b * 128 + kb * 32 + l31)) * 64 + 16 * s + 8 * hi);
          sc[kb] = MFMA(kf, qr[s], sc[kb]);
        }
      }
    }
    s16x4 vcl[16], vch[16];
#pragma unroll
    for (int q = 0; q < 16; ++q) {
      const int kb = q >> 2, s2 = (q >> 1) & 1, db = q & 1;
      const u16* vp = vct + ((size_t)(b * 64 + 32 * db + l31)) * 128 + 32 * kb + 16 * s2 + 4 * hi;
      vcl[q] = s16x4{0, 0, 0, 0}; vch[q] = s16x4{0, 0, 0, 0};
      if (kb < nkb) { vcl[q] = *(const s16x4*)vp; vch[q] = *(const s16x4*)(vp + 8); }
    }
    const int nv = (t >= 31) ? ((t - 31) >> 4) : -1;
    float mx = NEGB;
#pragma unroll
    for (int kb = 0; kb < 4; ++kb)
#pragma unroll
      for (int r = 0; r < 16; ++r) { const int n = 32 * kb + crow(r, hi); const float v = (n <= nv) ? sc[kb][r] * C2 : NEGB; sc[kb][r] = v; mx = fmaxf(mx, v); }
    mx = fmaxf(mx, __shfl_xor(mx, 32, 64));
    float sum = 0.f;
#pragma unroll
    for (int kb = 0; kb < 4; ++kb)
#pragma unroll
      for (int r = 0; r < 16; ++r) { const int n = 32 * kb + crow(r, hi); const float e = (n <= nv) ? ex2(sc[kb][r] - mx) : 0.f; sc[kb][r] = e; sum += e; }
    sum += __shfl_xor(sum, 32, 64);
    const float inv = sum > 0.f ? 1.f / sum : 0.f;
#pragma unroll
    for (int kb = 0; kb < 4; ++kb)
#pragma unroll
      for (int r = 0; r < 16; ++r) sc[kb][r] *= inv;
    float* myimp = impS + (h * 32 + l31) * 32;
#pragma unroll
    for (int kb = 0; kb < 4; ++kb)
#pragma unroll
      for (int g = 0; g < 4; ++g) myimp[8 * kb + 2 * g + hi] = ((sc[kb][4 * g] + sc[kb][4 * g + 1]) + sc[kb][4 * g + 2]) + sc[kb][4 * g + 3];
    __syncthreads();
#pragma unroll
    for (int kb = 0; kb < 4; ++kb)
#pragma unroll
      for (int g = 0; g < 4; ++g) { const int j1 = 8 * kb + 2 * g + hi + 1; if (j1 < 32) myimp[j1] += sc[kb][4 * g + 3]; }
    f32x16 oc[2];
#pragma unroll
    for (int r = 0; r < 16; ++r) { oc[0][r] = 0.f; oc[1][r] = 0.f; }
#pragma unroll
    for (int kb = 0; kb < 4; ++kb)
#pragma unroll
      for (int s2 = 0; s2 < 2; ++s2) {
        if (kb >= nkb) continue;
        const bf16x8 pf = pack8(sc[kb], s2);
#pragma unroll
        for (int db = 0; db < 2; ++db) {
          const s16x4 lo = vcl[(kb * 2 + s2) * 2 + db], hh = vch[(kb * 2 + s2) * 2 + db];
          const bf16x8 vf = {lo[0], lo[1], lo[2], lo[3], hh[0], hh[1], hh[2], hh[3]};
          oc[db] = MFMA(vf, pf, oc[db]);
        }
      }
#pragma unroll
    for (int r = 0; r < 16; ++r) { ya[0][r] = oc[0][r] * g0; ya[1][r] = oc[1][r] * g0; }
  }
  __syncthreads();
  const int cur = q0 >> 6;
  {
    const int q = tid >> 3, sub = tid & 7;
#pragma unroll
    for (int jj = 0; jj < 4; ++jj) {
      const int j = sub * 4 + jj;
      float v = ((impS[(0 * 32 + q) * 32 + j] + impS[(1 * 32 + q) * 32 + j]) + impS[(2 * 32 + q) * 32 + j]) + impS[(3 * 32 + q) * 32 + j];
      const bool forced = (j == 0) || (j == cur) || (j == cur - 1);
      v = forced ? 1e4f : ((j <= cur) ? v : -1e4f);
      vals[q * 32 + j] = v;
    }
    __syncthreads();
    f32x4 vv[8];
#pragma unroll
    for (int i = 0; i < 8; ++i) vv[i] = *(const f32x4*)(vals + q * 32 + i * 4);
    unsigned bits = 0u;
#pragma unroll
    for (int jj = 0; jj < 4; ++jj) {
      const int j = sub * 4 + jj; const float v = vals[q * 32 + j];
      int cnt = 0;
#pragma unroll
      for (int j2 = 0; j2 < 32; ++j2) { const float w = vv[j2 >> 2][j2 & 3]; cnt += ((w > v) || (w == v && j2 < j)) ? 1 : 0; }
      if (cnt < 16 && j <= cur) bits |= 1u << j;
    }
    if (bits) atomicOr(&selm[q], bits);
  }
  __syncthreads();
  const unsigned mymask = selm[l31];
  unsigned anym = mymask, allm = mymask;
#pragma unroll
  for (int o = 16; o >= 1; o >>= 1) { anym |= (unsigned)__shfl_xor((int)anym, o, 64); allm &= (unsigned)__shfl_xor((int)allm, o, 64); }
  anym = __builtin_amdgcn_readfirstlane(anym);
  allm = __builtin_amdgcn_readfirstlane(allm);
  if (tid < 32) { if ((anym >> tid) & 1u) jlist[__builtin_popcount(anym & ((1u << tid) - 1u))] = tid; }
  f32x16 o[2];
#pragma unroll
  for (int r = 0; r < 16; ++r) { o[0][r] = 0.f; o[1][r] = 0.f; }
  float m = M_INIT, lsum = 0.f;
#pragma unroll
  for (int r = 0; r < 16; ++r) { yst[r * 256 + tid] = ya[0][r]; yst[(16 + r) * 256 + tid] = ya[1][r]; }
  __syncthreads();
  attn_stream(tid, proj, C_KSLC, C_VSLC, __builtin_popcount(anym),
              [&](int ti, int row) { return b * S_ + jlist[ti] * 64 + row; },
              [&](int ti) { const int jb = jlist[ti]; return (jb < cur) && ((allm >> jb) & 1u); },
              [&](int ti, int kr) { const int jb = jlist[ti]; return ((mymask >> jb) & 1u) && (jb * 64 + kr <= t); },
              qr, o, m, lsum, lds);
#pragma unroll
  for (int r = 0; r < 16; ++r) { ya[0][r] = yst[r * 256 + tid]; ya[1][r] = yst[(16 + r) * 256 + tid]; }
  lsum += __shfl_xor(lsum, 32, 64);
  const float il = g1 / lsum;
  const u16* ow = (const u16*)(ws_ + OFF_OWIN);
  u16* y = (u16*)(ws_ + OFF_XB);
#pragma unroll
  for (int db = 0; db < 2; ++db)
#pragma unroll
    for (int g = 0; g < 4; ++g) {
      const int col = h * 64 + 32 * db + 8 * g + 4 * hi;
      const u32x2 w = *(const u32x2*)(ow + tok * 256 + col), az = *(const u32x2*)(proj + tok * NP + C_AZ + col);
      const float v0 = (ya[db][4 * g] + o[db][4 * g] * il + g2 * lo16(w[0])) * siluf_(lo16(az[0]));
      const float v1 = (ya[db][4 * g + 1] + o[db][4 * g + 1] * il + g2 * hi16(w[0])) * siluf_(hi16(az[0]));
      const float v2 = (ya[db][4 * g + 2] + o[db][4 * g + 2] * il + g2 * lo16(w[1])) * siluf_(lo16(az[1]));
      const float v3 = (ya[db][4 * g + 3] + o[db][4 * g + 3] * il + g2 * hi16(w[1])) * siluf_(hi16(az[1]));
      u32x2 v; v[0] = pk2(v0, v1); v[1] = pk2(v2, v3);
      *(u32x2*)(y + tok * 1024 + col) = v;
    }
}

DI void dilcomb_item(const Params& p, int it) {
  char* const ws_ = opq(p.ws);
  const u16* proj = (const u16*)(ws_ + OFF_PROJ);
  const u16* od = (const u16*)(ws_ + OFF_ODIL);
  const float* lse = (const float*)(ws_ + OFF_LSE);
  u16* y = (u16*)(ws_ + OFF_XB);
#pragma unroll
  for (int i = 0; i < 4; ++i) {
    const int idx = it * 1024 + i * 256 + threadIdx.x;
    const size_t tok = idx >> 5; const int c8 = idx & 31, h = c8 >> 3;
    const float l0 = lse[((size_t)0 * T_ + tok) * 4 + h], l1 = lse[((size_t)1 * T_ + tok) * 4 + h], l2 = lse[((size_t)2 * T_ + tok) * 4 + h];
    const float mx = fmaxf(l0, fmaxf(l1, l2));
    float w0 = __expf(l0 - mx), w1 = __expf(l1 - mx), w2 = __expf(l2 - mx);
    const float iw = 1.f / (w0 + w1 + w2); w0 *= iw; w1 *= iw; w2 *= iw;
    const u32x4 a = *(const u32x4*)(od + ((size_t)0 * T_ + tok) * 256 + c8 * 8), bq = *(const u32x4*)(od + ((size_t)1 * T_ + tok) * 256 + c8 * 8), cq = *(const u32x4*)(od + ((size_t)2 * T_ + tok) * 256 + c8 * 8);
    const u32x4 z = *(const u32x4*)(proj + tok * NP + C_BZ + c8 * 8);
    u32x4 r;
#pragma unroll
    for (int e = 0; e < 4; ++e) {
      const float v0 = (w0 * lo16(a[e]) + w1 * lo16(bq[e]) + w2 * lo16(cq[e])) * siluf_(lo16(z[e]));
      const float v1 = (w0 * hi16(a[e]) + w1 * hi16(bq[e]) + w2 * hi16(cq[e])) * siluf_(hi16(z[e]));
      r[e] = pk2(v0, v1);
    }
    *(u32x4*)(y + tok * 1024 + 256 + c8 * 8) = r;
  }
}

__global__ void __launch_bounds__(256, 2) hybrid_megakernel(Params p) {
  __shared__ __attribute__((aligned(16))) char lds[73728];
  __shared__ uint4 xb_words;
  __shared__ uint4 xg_words;
  cg::grid_group grid = cg::this_grid();
  char* const ws_ = p.ws;
  if (p.ws == nullptr) grid.sync();
  if (threadIdx.x == 0) { xb_words = make_uint4(0u, 0u, 0u, 0u); xg_words = make_uint4(0u, 0u, 0u, 0u); }
  __syncthreads();
  const XcdBarrier xb = xcd_barrier_post((unsigned*)(ws_ + OFF_BAR), (volatile LAS unsigned*)&xb_words, gridDim.x);
  const bool grp = (gridDim.x % 8u) == 0u;
  const XcdBarrier xg = grp ? xcd_barrier_post((unsigned*)(ws_ + OFF_BAR) + (1 + (blockIdx.x & 7)) * 4096, (volatile LAS unsigned*)&xg_words, gridDim.x / 8u) : xb;
  const int nb = gridDim.x, bid = blockIdx.x;
  const int wid = threadIdx.x >> 6;
  for (int it = bid; it < 3328 + 1024 + 1024 + 32 + 16 + 64; it += nb) {
    if (it < 3328) { const int l = it / 832, r = it % 832, ntile = r >> 4, ktile = r & 15;
      tr_tile(p.w_in + (size_t)l * 1024 * 3212, 3212, (u16*)(ws_ + OFF_WIN) + (size_t)l * NP * 1024, 1024, ktile * 64, ntile * 64, p.g_pre + l * 1024, 1, lds); }
    else if (it < 4352) { const int i2 = it - 3328, l = i2 >> 8, r = i2 & 255, ntile = r >> 4, ktile = r & 15;
      tr_tile(p.w_out + (size_t)l * 1024 * 1024, 1024, (u16*)(ws_ + OFF_WOUT) + (size_t)l * 1024 * 1024, 1024, ktile * 64, ntile * 64, nullptr, 0, lds); }
    else if (it < 5376) { const int i2 = it - 4352, mtx = i2 >> 7, r = i2 & 127, ntile = r >> 5, ktile = r & 31;
      tr_tile(p.w_cmp1 + (size_t)mtx * 2048 * 256, 256, (u16*)(ws_ + OFF_W1) + (size_t)mtx * 256 * 2048, 2048, ktile * 64, ntile * 64, nullptr, 0, lds); }
    else if (it < 5408) { const int i2 = it - 5376, mtx = i2 >> 2, ktile = i2 & 3;
      tr_tile(p.w_cmp2 + (size_t)mtx * 256 * 64, 64, (u16*)(ws_ + OFF_W2) + (size_t)mtx * 64 * 256, 256, ktile * 64, 0, nullptr, 0, lds); }
    else if (it < 5424) { const int mtx = it - 5408;
      tr_tile(p.w_pool + (size_t)mtx * 4096, 64, (u16*)(ws_ + OFF_WPT) + (size_t)mtx * 4096, 64, 0, 0, nullptr, 0, lds); }
    else { const int i2 = it - 5424, mtx = i2 >> 2, qd = i2 & 3;
      const float* src = p.w_sp + (size_t)mtx * 16384 + qd * 4096; u16* dst = (u16*)(ws_ + OFF_WSP) + (size_t)mtx * 16384 + qd * 4096;
      f32x4 v[4];
#pragma unroll
      for (int k = 0; k < 4; ++k) v[k] = *(const f32x4*)(src + (threadIdx.x + 256 * k) * 4);
#pragma unroll
      for (int k = 0; k < 4; ++k) {
        const int e = qd * 4096 + (threadIdx.x + 256 * k) * 4, i = e >> 7, j = e & 127;
        u32x2 o; o[0] = pk2(j <= i ? v[k][0] : 0.f, j + 1 <= i ? v[k][1] : 0.f); o[1] = pk2(j + 2 <= i ? v[k][2] : 0.f, j + 3 <= i ? v[k][3] : 0.f);
        *(u32x2*)(dst + (threadIdx.x + 256 * k) * 4) = o;
      } }
  }
  for (int it = bid; it < T_ / 32; it += nb) {
    const int row = it * 32 + wid * 8;
    rows_convert<8>(p.x + (size_t)row * 1024, (u16*)(ws_ + OFF_XB) + (size_t)row * 1024, (float*)(ws_ + OFF_RN) + row);
  }
  xcd_barrier(xb);
  for (int l = 0; l < 4; ++l) {
    for (int it = bid; it < 1536 + 256; it += nb) {
      if (it < 1536) { const int q = it >> 3; inproj_tile<4>(p, l, (it & 7) * 16 + (q & 15), q >> 4, lds); }
      else { const int i2 = it - 1536, q = i2 >> 3; inproj_tile<2>(p, l, (i2 & 7) * 16 + (q & 15), 24 + (q >> 4), lds); }
    }
    xcd_barrier(xg);
    for (int vb = bid; vb < 512; vb += nb) {
      if (vb < 64) cmp_item(p, l, vb, lds);
      else {
        const int j = vb - 64;
        win_item(p, j, lds);
        if (j + 448 < 512) win_item(p, j + 448, lds);
        for (int it = j; it < 1536; it += 448) dil_item(p, it, lds);
      }
    }
    xcd_barrier(xg);
    for (int vb = bid; vb < 512; vb += nb) {
      nsa_item(p, vb, lds);
      const int gi = vb >> 4;
      int start = 0, mine = 0;
      for (int g2 = 0; g2 <= gi; ++g2) {
        const int n = 32 - g2;
        const int d = (n <= 10) ? 2 : (n <= 22) ? 1 : 0;
        if (g2 < gi) start += 2 * d; else mine = d;
      }
      start += ((vb >> 3) & 1) * mine;
      const int x = vb & 7;
      for (int k = 0; k < mine; ++k) { const int slot = start + k; sgu_item(p, l, slot * 8 + x, lds); pool_item(p, l, slot * 8 + x, lds); dilcomb_item(p, x * 64 + slot); }
    }
    xcd_barrier(xg);
    for (int it = bid; it < 512; it += nb) outproj_item(p, l, it, lds);
    xcd_barrier(xg);
    const float* xin = (l == 0) ? p.x : p.out;
    for (int vb = bid; vb < 512; vb += nb)
      for (int j = vb >> 3; j < 128; j += 64) resid_rows<4>(p, l, (vb & 7) * 2048 + j * 16 + wid * 4, xin);
    if (l < 3) xcd_barrier(xg);
  }
}

extern "C" void kernel_launch(void* const* d_in, const int* in_sizes, int n_in, void* d_out, int out_size, void* d_ws, size_t ws_size, hipStream_t stream) {
  static int grid_blocks = 0;
  if (!grid_blocks) {
    int dev = 0, cus = 0, per_cu = 0;
    hipGetDevice(&dev);
    hipDeviceGetAttribute(&cus, hipDeviceAttributeMultiprocessorCount, dev);
    hipOccupancyMaxActiveBlocksPerMultiprocessor(&per_cu, hybrid_megakernel, 256, 0);
    if (per_cu > 2) per_cu = 2;
    if (per_cu < 1) per_cu = 1;
    grid_blocks = cus * per_cu;
  }
  if (ws_size < WS_TOTAL) { fprintf(stderr, "workspace too small: %zu < %zu\n", ws_size, (size_t)WS_TOTAL); return; }
  Params p{};
  p.x = (const float*)d_in[0]; p.g_pre = (const float*)d_in[1]; p.w_in = (const float*)d_in[2]; p.pe_cmp = (const float*)d_in[3];
  p.w_cmp1 = (const float*)d_in[4]; p.w_cmp2 = (const float*)d_in[5]; p.w_pool = (const float*)d_in[6]; p.pool_scale = (const float*)d_in[7];
  p.sg_ln_g = (const float*)d_in[8]; p.sg_ln_b = (const float*)d_in[9]; p.w_sp = (const float*)d_in[10]; p.b_sp = (const float*)d_in[11];
  p.w_out = (const float*)d_in[12]; p.g_post = (const float*)d_in[13];
  p.out = (float*)d_out; p.ws = (char*)d_ws;
  hipMemsetAsync((char*)d_ws + OFF_BAR, 0, 9 * 16384, stream);
  void* args[] = {&p};
  hipError_t e = hipLaunchCooperativeKernel((void*)hybrid_megakernel, dim3(grid_blocks), dim3(256), args, 0, stream);
  if (e != hipSuccess) fprintf(stderr, "cooperative launch failed: %s (grid %d)\n", hipGetErrorString(e), grid_blocks);
}
```

```cpp
#include <hip/hip_runtime.h>
#include <hip/hip_cooperative_groups.h>
#include <cstdio>
namespace cg = cooperative_groups;

typedef unsigned short u16;
using bf16x8 = __attribute__((ext_vector_type(8))) short;
using s16x4 = __attribute__((ext_vector_type(4))) short;
using f32x16 = __attribute__((ext_vector_type(16))) float;
using f32x4 = __attribute__((ext_vector_type(4))) float;
using u32x4 = __attribute__((ext_vector_type(4))) unsigned;
using u32x2 = __attribute__((ext_vector_type(2))) unsigned;
typedef short v4i16_t __attribute__((ext_vector_type(4)));
#define DI __device__ __forceinline__
#define MFMA(a, b, c) __builtin_amdgcn_mfma_f32_32x32x16_bf16((a), (b), (c), 0, 0, 0)

constexpr int T_ = 16384, S_ = 2048, NP = 3328;
constexpr float C2 = 0.125f * 1.4426950408889634f;
constexpr float NEGB = -1e30f;

constexpr int C_AQ = 0, C_KCMP = 256, C_KSLC = 384, C_VSLC = 448, C_KWIN = 512, C_VWIN = 576, C_AZ = 640;
constexpr int C_BQ = 896, C_BK = 1152, C_BV = 1408, C_BZ = 1664, C_CIN = 1920, C_CZ = 2176, C_DU = 2432, C_DV = 2688, C_DZ = 2944, C_AG = 3200;

constexpr size_t al(size_t x) { return (x + 255) & ~(size_t)255; }
constexpr size_t OFF_WIN = 0;
constexpr size_t OFF_WOUT = OFF_WIN + al((size_t)4 * NP * 1024 * 2);
constexpr size_t OFF_W1 = OFF_WOUT + al((size_t)4 * 1024 * 1024 * 2);
constexpr size_t OFF_W2 = OFF_W1 + al((size_t)4 * 2 * 256 * 2048 * 2);
constexpr size_t OFF_XB = OFF_W2 + al((size_t)4 * 2 * 64 * 256 * 2);
constexpr size_t OFF_RN = OFF_XB + al((size_t)T_ * 1024 * 2);
constexpr size_t OFF_PROJ = OFF_RN + al((size_t)T_ * 4);
constexpr size_t OFF_SSQ = OFF_PROJ + al((size_t)T_ * NP * 2);
constexpr size_t OFF_KC = OFF_SSQ + al((size_t)T_ * 16 * 4);
constexpr size_t OFF_VCT = OFF_KC + al((size_t)8 * 128 * 64 * 2);
constexpr size_t OFF_OWIN = OFF_VCT + al((size_t)8 * 128 * 64 * 2);
constexpr size_t OFF_ODIL = OFF_OWIN + al((size_t)T_ * 256 * 2);
constexpr size_t OFF_LSE = OFF_ODIL + al((size_t)3 * T_ * 256 * 2);
constexpr size_t OFF_WPT = OFF_LSE + al((size_t)3 * T_ * 4 * 4);
constexpr size_t OFF_WSP = OFF_WPT + al((size_t)16 * 64 * 64 * 2);
constexpr size_t OFF_OUTB = OFF_WSP + al((size_t)16 * 128 * 128 * 2);
constexpr size_t OFF_BAR = OFF_OUTB + al((size_t)T_ * 1024 * 2);
constexpr size_t WS_TOTAL = OFF_BAR + 9 * 16384;
static_assert(WS_TOTAL <= (size_t)256 * 1024 * 1024, "workspace layout exceeds the guaranteed 256 MiB");

struct Params {
  const float *x, *g_pre, *w_in, *pe_cmp, *w_cmp1, *w_cmp2, *w_pool, *pool_scale, *sg_ln_g, *sg_ln_b, *w_sp, *b_sp, *w_out, *g_post;
  float* out;
  char* ws;
};

DI char* opq(char* q) { size_t z = 0; asm volatile("" : "+s"(z)); return q + z; }
DI int tidx() { int t = threadIdx.x; asm volatile("" : "+v"(t)); return t; }
DI float bf2f(u16 v) { return __uint_as_float((unsigned)v << 16); }
DI unsigned pk2(float a, float b) {
  typedef __bf16 bf2 __attribute__((ext_vector_type(2)));
  typedef float f2 __attribute__((ext_vector_type(2)));
  f2 v = {a, b};
  bf2 r = __builtin_convertvector(v, bf2);
  return __builtin_bit_cast(unsigned, r);
}
DI u16 f2bf(float x) { return (u16)(pk2(x, 0.f) & 0xffffu); }
DI float lo16(unsigned w) { return __uint_as_float(w << 16); }
DI float hi16(unsigned w) { return __uint_as_float(w & 0xffff0000u); }
DI int crow(int r, int hi) { return (r & 3) + 8 * (r >> 2) + 4 * hi; }
DI float ex2(float x) { return __builtin_amdgcn_exp2f(x); }
DI float sigmoidf_(float x) { return 1.f / (1.f + __expf(-x)); }
DI float siluf_(float x) { return x / (1.f + __expf(-x)); }
DI float wave_sum(float v) {
#pragma unroll
  for (int o = 32; o >= 1; o >>= 1) v += __shfl_xor(v, o, 64);
  return v;
}
DI bf16x8 pack8(const f32x16& x, int s8) {
  u32x4 p;
  p[0] = pk2(x[8 * s8 + 0], x[8 * s8 + 1]); p[1] = pk2(x[8 * s8 + 2], x[8 * s8 + 3]);
  p[2] = pk2(x[8 * s8 + 4], x[8 * s8 + 5]); p[3] = pk2(x[8 * s8 + 6], x[8 * s8 + 7]);
  return __builtin_bit_cast(bf16x8, p);
}
DI s16x4 trread(const char* p) {
  return __builtin_bit_cast(s16x4, __builtin_amdgcn_ds_read_tr16_b64_v4i16((__attribute__((address_space(3))) v4i16_t*)p));
}


#define XB_TMO      128
#define XB_XCNT(j)  (256  + 64 * (j))
#define XB_XSUB(j)  (1280 + 64 * (j))
#define XB_XGEN(j)  (2304 + 64 * (j))
#define XB_TOP      3328
#define XB_TOPGEN   3392
#define XCD_BAR_WORDS 3456
#define XB_SPIN_CAP (1u << 22)
#define LAS __attribute__((address_space(3)))
DI unsigned xb_ld(unsigned* p)              { return __hip_atomic_load(p, __ATOMIC_RELAXED, __HIP_MEMORY_SCOPE_AGENT); }
DI unsigned xb_add(unsigned* p, unsigned v) { return __hip_atomic_fetch_add(p, v, __ATOMIC_RELAXED, __HIP_MEMORY_SCOPE_AGENT); }
DI unsigned xb_xcc_id() { return (unsigned)__builtin_amdgcn_s_getreg((3 << 11) | 20) & 0xFu; }
#define XB_SPIN(cond, bar) do { unsigned _sp = 0; while (cond) { __builtin_amdgcn_s_sleep(1); \
    if ((++_sp & 255u) == 0u) { if (xb_ld(&(bar)[XB_TMO])) break; if (_sp > XB_SPIN_CAP) { atomicAdd(&(bar)[XB_TMO], 1u); break; } } } } while (0)
struct XcdBarrier { unsigned* bar; unsigned x; volatile LAS unsigned* st; unsigned G; };
DI XcdBarrier xcd_barrier_post(unsigned* bar, volatile LAS unsigned* st, unsigned G) {
    XcdBarrier b; b.bar = bar; b.x = xb_xcc_id(); b.st = st; b.G = G;
    if (threadIdx.x == 0) (void)xb_add(&bar[XB_XCNT(b.x)], 1u);
    return b;
}
DI void xcd_barrier_complete(unsigned* bar, unsigned x, unsigned G, unsigned& nloc, unsigned& nx) {
    unsigned sum, cnt, mine, sp = 0u;
    for (;;) {
        sum = 0u; cnt = 0u; mine = 0u;
#pragma unroll
        for (unsigned j = 0; j < 16; ++j) { const unsigned c = xb_ld(&bar[XB_XCNT(j)]); sum += c; cnt += (c > 0u) ? 1u : 0u; mine = (j == x) ? c : mine; }
        if (sum == G) break;
        __builtin_amdgcn_s_sleep(1);
        if ((++sp & 255u) == 0u) { if (xb_ld(&bar[XB_TMO])) break; if (sp > XB_SPIN_CAP) { atomicAdd(&bar[XB_TMO], 1u); break; } }
    }
    nloc = mine > 0u ? mine : 1u; nx = cnt > 0u ? cnt : 1u;
}
DI void xcd_barrier(const XcdBarrier& b) {
    asm volatile("s_waitcnt vmcnt(0)" ::: "memory");
    __syncthreads();
    if (threadIdx.x == 0) {
        unsigned* bar = b.bar;
        __builtin_amdgcn_s_waitcnt(0);
        unsigned nloc = b.st[0], nx = b.st[1];
        if (nloc == 0u) { xcd_barrier_complete(bar, b.x, b.G, nloc, nx); b.st[0] = nloc; b.st[1] = nx; }
        const unsigned old = xb_add(&bar[XB_XSUB(b.x)], 1u);
        const unsigned gen = old / nloc;
        if (old + 1u == (gen + 1u) * nloc) {
            __builtin_amdgcn_fence(__ATOMIC_RELEASE, "agent");
            asm volatile("s_waitcnt vmcnt(0)" ::: "memory");
            const unsigned og = xb_add(&bar[XB_TOP], 1u);
            const unsigned tg = og / nx;
            if (og + 1u == (tg + 1u) * nx) xb_add(&bar[XB_TOPGEN], 1u);
            else XB_SPIN(xb_ld(&bar[XB_TOPGEN]) == tg, bar);
            __builtin_amdgcn_fence(__ATOMIC_ACQUIRE, "agent");
            xb_add(&bar[XB_XGEN(b.x)], 1u);
            asm volatile("s_waitcnt vmcnt(0)" ::: "memory");
        } else {
            XB_SPIN(xb_ld(&bar[XB_XGEN(b.x)]) == gen, bar);
            __builtin_amdgcn_fence(__ATOMIC_ACQUIRE, "agent");
            asm volatile("s_waitcnt vmcnt(0)" ::: "memory");
        }
    }
    __syncthreads();
}

template <int WGN, int INS, int IMS, bool DB, class LdW, class LdX>
DI void gemm_core(f32x16 (&acc)[INS][IMS], const int KT, LdW ldw, LdX ldx, char* lds, const int tid) {
  constexpr int WGM = 4 / WGN;
  constexpr int WROWS = WGN * 32 * INS, XROWS = WGM * 32 * IMS, NROWS = WROWS + XROWS, NCH = NROWS / 32, NCHW = WROWS / 32, BUFB = NROWS * 144;
  const int lane = tid & 63, wid = tid >> 6, l31 = lane & 31, hi = lane >> 5;
  const int wn = (WGN == 2) ? (wid >> 1) : wid, wm = (WGN == 2) ? (wid & 1) : 0;
  const int offa = (wn * 32 * INS + l31) * 144 + hi * 16;
  const int offb = (WROWS + wm * 32 * IMS + l31) * 144 + hi * 16;
#pragma unroll
  for (int a = 0; a < INS; ++a)
#pragma unroll
    for (int b = 0; b < IMS; ++b)
#pragma unroll
      for (int r = 0; r < 16; ++r) acc[a][b][r] = 0.f;
#define GLOAD(dst, kt_) _Pragma("unroll") for (int i = 0; i < NCH; ++i) { dst[i] = (i < NCHW) ? ldw(i, tid >> 3, (kt_) * 64 + (tid & 7) * 8) : ldx(i - NCHW, tid >> 3, (kt_) * 64 + (tid & 7) * 8); }
#define LSTORE(src, base) _Pragma("unroll") for (int i = 0; i < NCH; ++i) { const int c = tid + 256 * i; *(u32x4*)((base) + (c >> 3) * 144 + (c & 7) * 16) = src[i]; }
#define COMPUTE_PIPE(buf) { const char* pa = (buf) + offa; const char* pb = (buf) + offb; \
    bf16x8 fa[2][INS], fb[2][IMS]; \
    _Pragma("unroll") for (int in = 0; in < INS; ++in) fa[0][in] = *(const bf16x8*)(pa + in * 32 * 144); \
    _Pragma("unroll") for (int im = 0; im < IMS; ++im) fb[0][im] = *(const bf16x8*)(pb + im * 32 * 144); \
    _Pragma("unroll") for (int s = 0; s < 4; ++s) { \
      if (s < 3) { _Pragma("unroll") for (int in = 0; in < INS; ++in) fa[(s + 1) & 1][in] = *(const bf16x8*)(pa + in * 32 * 144 + (s + 1) * 32); \
        _Pragma("unroll") for (int im = 0; im < IMS; ++im) fb[(s + 1) & 1][im] = *(const bf16x8*)(pb + im * 32 * 144 + (s + 1) * 32); } \
      _Pragma("unroll") for (int im = 0; im < IMS; ++im) _Pragma("unroll") for (int in = 0; in < INS; ++in) \
        acc[in][im] = MFMA(fa[s & 1][in], fb[s & 1][im], acc[in][im]); } }
#define COMPUTE_FLAT(buf) { const char* pa = (buf) + offa; const char* pb = (buf) + offb; \
    _Pragma("unroll") for (int s = 0; s < 4; ++s) { \
      bf16x8 fa[INS], fb[IMS]; \
      _Pragma("unroll") for (int in = 0; in < INS; ++in) fa[in] = *(const bf16x8*)(pa + in * 32 * 144 + s * 32); \
      _Pragma("unroll") for (int im = 0; im < IMS; ++im) fb[im] = *(const bf16x8*)(pb + im * 32 * 144 + s * 32); \
      _Pragma("unroll") for (int im = 0; im < IMS; ++im) _Pragma("unroll") for (int in = 0; in < INS; ++in) \
        acc[in][im] = MFMA(fa[in], fb[im], acc[in][im]); } }
  if (DB) {
    u32x4 preA[NCH], preB[NCH];
    GLOAD(preA, 0)
    GLOAD(preB, 1)
    __syncthreads();
    LSTORE(preA, lds)
    __syncthreads();
    for (int kt = 0; kt < KT; kt += 2) {
      if (kt + 2 < KT) { GLOAD(preA, kt + 2) }
      COMPUTE_PIPE(lds)
      LSTORE(preB, lds + BUFB)
      __syncthreads();
      if (kt + 3 < KT) { GLOAD(preB, kt + 3) }
      COMPUTE_PIPE(lds + BUFB)
      if (kt + 2 < KT) { LSTORE(preA, lds) }
      __syncthreads();
    }
  } else {
    u32x4 pre[NCH];
    GLOAD(pre, 0)
    for (int kt = 0; kt < KT; ++kt) {
      __syncthreads();
      LSTORE(pre, lds)
      __syncthreads();
      if (kt + 1 < KT) { GLOAD(pre, kt + 1) }
      if (INS >= 4) COMPUTE_FLAT(lds) else COMPUTE_PIPE(lds)
    }
  }
#undef GLOAD
#undef LSTORE
#undef COMPUTE_PIPE
#undef COMPUTE_FLAT
}

constexpr float M_INIT = -1e29f;
template <class MaskF>
DI void attn_tile(const int tid, const char* ldsK, const char* ldsV, const bf16x8 (&qr)[4], f32x16 (&o)[2], float& m, float& l, const bool MASKED, MaskF mask) {
  const int lane = tid & 63, l31 = lane & 31, hi = lane >> 5;
  f32x16 p0, p1;
#pragma unroll
  for (int r = 0; r < 16; ++r) { p0[r] = 0.f; p1[r] = 0.f; }
  const char* kp = ldsK + l31 * 144 + hi * 16;
#pragma unroll
  for (int s = 0; s < 4; ++s) {
    const bf16x8 k0 = *(const bf16x8*)(kp + s * 32), k1 = *(const bf16x8*)(kp + 32 * 144 + s * 32);
    p0 = MFMA(k0, qr[s], p0); p1 = MFMA(k1, qr[s], p1);
  }
  if (MASKED) {
#pragma unroll
    for (int r = 0; r < 16; ++r) {
      const int kr = crow(r, hi);
      p0[r] = mask(kr) ? p0[r] : NEGB; p1[r] = mask(kr + 32) ? p1[r] : NEGB;
    }
  }
  const char* vb = ldsV + (4 * hi + ((lane & 15) >> 2)) * 144 + ((lane >> 4) & 1) * 32 + (lane & 3) * 8;
  s16x4 vlo[8], vhi[8];
#pragma unroll
  for (int s4 = 0; s4 < 4; ++s4)
#pragma unroll
    for (int db = 0; db < 2; ++db) { vlo[s4 * 2 + db] = trread(vb + (16 * s4) * 144 + db * 64); vhi[s4 * 2 + db] = trread(vb + (16 * s4 + 8) * 144 + db * 64); }
  __builtin_amdgcn_sched_barrier(0);
  float mx = fmaxf(p0[0], p1[0]);
#pragma unroll
  for (int r = 1; r < 16; ++r) mx = fmaxf(fmaxf(mx, p0[r]), p1[r]);
  { auto rr = __builtin_amdgcn_permlane32_swap(__float_as_uint(mx), __float_as_uint(mx), false, false); mx = fmaxf(__uint_as_float(rr[0]), __uint_as_float(rr[1])); }
  const float mxs = mx * C2;
  if (__any(mxs > m + 8.f)) {
    const float mn = fmaxf(m, mxs), alpha = ex2(m - mn);
    m = mn; l *= alpha;
#pragma unroll
    for (int r = 0; r < 16; ++r) { o[0][r] *= alpha; o[1][r] *= alpha; }
  }
  const float nm = -m;
  float rs = 0.f;
#pragma unroll
  for (int r = 0; r < 16; ++r) { p0[r] = ex2(__builtin_fmaf(p0[r], C2, nm)); p1[r] = ex2(__builtin_fmaf(p1[r], C2, nm)); rs += p0[r] + p1[r]; }
  l += rs;
  bf16x8 pw[4];
  pw[0] = pack8(p0, 0); pw[1] = pack8(p0, 1); pw[2] = pack8(p1, 0); pw[3] = pack8(p1, 1);
#pragma unroll
  for (int s4 = 0; s4 < 4; ++s4) {
#pragma unroll
    for (int db = 0; db < 2; ++db) {
      const s16x4 lo = vlo[s4 * 2 + db], hh = vhi[s4 * 2 + db];
      const bf16x8 vf = {lo[0], lo[1], lo[2], lo[3], hh[0], hh[1], hh[2], hh[3]};
      o[db] = MFMA(vf, pw[s4], o[db]);
    }
  }
}

template <class RowF>
DI void kv_load(const int tid, u32x4 (&pre)[4], RowF rowtok, const u16* proj, int kcol, int vcol) {
#pragma unroll
  for (int i = 0; i < 2; ++i) {
    const int c = tid + 256 * i, row = c >> 3, ch = c & 7;
    const u16* p = proj + (size_t)rowtok(row) * NP + ch * 8;
    pre[i] = *(const u32x4*)(p + kcol); pre[2 + i] = *(const u32x4*)(p + vcol);
  }
}
DI void kv_store(const int tid, const u32x4 (&pre)[4], char* ldsK, char* ldsV) {
#pragma unroll
  for (int i = 0; i < 2; ++i) {
    const int c = tid + 256 * i, row = c >> 3, ch = c & 7;
    *(u32x4*)(ldsK + row * 144 + ch * 16) = pre[i]; *(u32x4*)(ldsV + row * 144 + ch * 16) = pre[2 + i];
  }
}

template <class RowF, class FullF, class MaskF>
DI void attn_stream(const int tid, const u16* proj, const int kcol, const int vcol, const int nt, RowF rowtok, FullF full, MaskF mask,
                    const bf16x8 (&qr)[4], f32x16 (&o)[2], float& m, float& l, char* lds) {
  u32x4 preA[4], preB[4];
  if (nt > 0) kv_load(tid, preA, [&](int row) { return rowtok(0, row); }, proj, kcol, vcol);
  if (nt > 1) kv_load(tid, preB, [&](int row) { return rowtok(1, row); }, proj, kcol, vcol);
  for (int ti = 0; ti < nt; ti += 2) {
    kv_store(tid, preA, lds, lds + 9216);
    __syncthreads();
    if (ti + 2 < nt) kv_load(tid, preA, [&](int row) { return rowtok(ti + 2, row); }, proj, kcol, vcol);
    attn_tile(tid, lds, lds + 9216, qr, o, m, l, !full(ti), [&](int kr) { return mask(ti, kr); });
    if (ti + 1 < nt) {
      kv_store(tid, preB, lds + 18432, lds + 27648);
      __syncthreads();
      if (ti + 3 < nt) kv_load(tid, preB, [&](int row) { return rowtok(ti + 3, row); }, proj, kcol, vcol);
      attn_tile(tid, lds + 18432, lds + 27648, qr, o, m, l, !full(ti + 1), [&](int kr) { return mask(ti + 1, kr); });
    }
  }
}

DI int mapcol(int n, int mode) {
  if (mode == 0) return n;
  if (n < 640) return n;
  if (n < 3200) return n + 12;
  if (n < 3212) return n - 3200 + 640;
  return -1;
}
DI void tr_tile(const float* src, int ldsrc, u16* dst, int ldd, int k0, int n0, const float* g, int mode, char* lds) {
  float* t = (float*)lds;
  const int tid = threadIdx.x;
  float v[16];
#pragma unroll
  for (int i = 0; i < 16; ++i) {
    const int e = tid + 256 * i, kk = e >> 6, nn = e & 63;
    const int sc = mapcol(n0 + nn, mode);
    v[i] = sc >= 0 ? src[(size_t)(k0 + kk) * ldsrc + sc] : 0.f;
  }
  if (g) {
#pragma unroll
    for (int i = 0; i < 16; ++i) v[i] *= g[k0 + ((tid + 256 * i) >> 6)];
  }
#pragma unroll
  for (int i = 0; i < 16; ++i) { const int e = tid + 256 * i, kk = e >> 6, nn = e & 63; t[kk * 65 + nn] = v[i]; }
  __syncthreads();
#pragma unroll
  for (int i = 0; i < 2; ++i) {
    const int e = tid + 256 * i, nn = e >> 3, k8 = (e & 7) * 8;
    u32x4 o;
    o[0] = pk2(t[(k8 + 0) * 65 + nn], t[(k8 + 1) * 65 + nn]); o[1] = pk2(t[(k8 + 2) * 65 + nn], t[(k8 + 3) * 65 + nn]);
    o[2] = pk2(t[(k8 + 4) * 65 + nn], t[(k8 + 5) * 65 + nn]); o[3] = pk2(t[(k8 + 6) * 65 + nn], t[(k8 + 7) * 65 + nn]);
    *(u32x4*)(dst + (size_t)(n0 + nn) * ldd + k0 + k8) = o;
  }
  __syncthreads();
}

template <int NR>
DI void rows_convert(const float* x0, u16* xb0, float* rn0) {
  const int lane = tidx() & 63;
  f32x4 v[NR][4];
#pragma unroll
  for (int r = 0; r < NR; ++r)
#pragma unroll
    for (int i = 0; i < 4; ++i) v[r][i] = *(const f32x4*)(x0 + (size_t)r * 1024 + i * 256 + lane * 4);
#pragma unroll
  for (int r = 0; r < NR; ++r) {
    float ss = 0.f;
#pragma unroll
    for (int i = 0; i < 4; ++i) {
      ss += v[r][i][0] * v[r][i][0] + v[r][i][1] * v[r][i][1] + v[r][i][2] * v[r][i][2] + v[r][i][3] * v[r][i][3];
      u32x2 o; o[0] = pk2(v[r][i][0], v[r][i][1]); o[1] = pk2(v[r][i][2], v[r][i][3]);
      *(u32x2*)(xb0 + (size_t)r * 1024 + i * 256 + lane * 4) = o;
    }
    ss = wave_sum(ss);
    if (lane == 0) rn0[r] = rsqrtf(ss * (1.f / 1024.f) + 1e-6f);
  }
}

template <int NTW>
DI void inproj_tile(const Params& p, int l, int mt, int ntile, char* lds) {
  char* const ws_ = opq(p.ws);
  const u16* W = (const u16*)(ws_ + OFF_WIN) + ((size_t)l * NP + ntile * 64 * NTW) * 1024;
  const u16* X = (const u16*)(ws_ + OFF_XB) + (size_t)mt * 128 * 1024;
  f32x16 acc[NTW][2];
  const int tid = tidx();
  gemm_core<2, NTW, 2, (NTW == 2)>(acc, 16, [&](int i, int r0, int k) -> u32x4 { return *(const u32x4*)((W + i * 32768) + (unsigned)(r0 * 1024 + k)); },
               [&](int i, int r0, int k) -> u32x4 { return *(const u32x4*)((X + i * 32768) + (unsigned)(r0 * 1024 + k)); }, lds, tid);
  const int lane = tid & 63, wid = tid >> 6, l31 = lane & 31, hi = lane >> 5, wn = wid >> 1, wm = wid & 1;
  const float* rn = (const float*)(ws_ + OFF_RN);
  u16* proj = (u16*)(ws_ + OFF_PROJ);
  constexpr int NCOLS = 64 * NTW, RS = NCOLS * 2 + 16;
  __syncthreads();
#pragma unroll
  for (int im = 0; im < 2; ++im) {
    const int tl = wm * 64 + im * 32 + l31;
    const float r = rn[(size_t)mt * 128 + tl];
#pragma unroll
    for (int in = 0; in < NTW; ++in)
#pragma unroll
      for (int g = 0; g < 4; ++g) {
        const int n = wn * 32 * NTW + in * 32 + 8 * g + 4 * hi;
        u32x2 o; o[0] = pk2(acc[in][im][4 * g] * r, acc[in][im][4 * g + 1] * r); o[1] = pk2(acc[in][im][4 * g + 2] * r, acc[in][im][4 * g + 3] * r);
        *(u32x2*)(lds + tl * RS + n * 2) = o;
      }
  }
  __syncthreads();
#pragma unroll 4
  for (int i = 0; i < NCOLS / 16; ++i) {
    const int c = tid + 256 * i, tl = c / (NCOLS / 8), ch = c % (NCOLS / 8);
    const u32x4 v = *(const u32x4*)(lds + tl * RS + ch * 16);
    *(u32x4*)(proj + ((size_t)mt * 128 + tl) * NP + ntile * NCOLS + ch * 8) = v;
  }
}

DI void outproj_item(const Params& p, int l, int it, char* lds) {
  char* const ws_ = opq(p.ws);
  const int mt = (it & 7) * 16 + ((it >> 3) & 15), nt = it >> 7;
  const u16* W = (const u16*)(ws_ + OFF_WOUT) + ((size_t)l * 1024 + nt * 256) * 1024;
  const u16* Y = (const u16*)(ws_ + OFF_XB) + (size_t)mt * 128 * 1024;
  f32x16 acc[4][2];
  const int tid = tidx();
  gemm_core<2, 4, 2, false>(acc, 16, [&](int i, int r0, int k) -> u32x4 { return *(const u32x4*)((W + i * 32768) + (unsigned)(r0 * 1024 + k)); },
               [&](int i, int r0, int k) -> u32x4 { return *(const u32x4*)((Y + i * 32768) + (unsigned)(r0 * 1024 + k)); }, lds, tid);
  const int lane = tid & 63, wid = tid >> 6, l31 = lane & 31, hi = lane >> 5, wn = wid >> 1, wm = wid & 1;
  u16* outb = (u16*)(ws_ + OFF_OUTB);
  float* ssq = (float*)(ws_ + OFF_SSQ);
  constexpr int RS = 256 * 2 + 16;
  __syncthreads();
#pragma unroll
  for (int im = 0; im < 2; ++im) {
    const int tl = wm * 64 + im * 32 + l31;
    float ss = 0.f;
#pragma unroll
    for (int in = 0; in < 4; ++in)
#pragma unroll
      for (int g = 0; g < 4; ++g) {
        const int n = wn * 128 + in * 32 + 8 * g + 4 * hi;
        const float o0 = acc[in][im][4 * g], o1 = acc[in][im][4 * g + 1], o2 = acc[in][im][4 * g + 2], o3 = acc[in][im][4 * g + 3];
        ss += o0 * o0 + o1 * o1 + o2 * o2 + o3 * o3;
        u32x2 v; v[0] = pk2(o0, o1); v[1] = pk2(o2, o3);
        *(u32x2*)(lds + tl * RS + n * 2) = v;
      }
    ss += __shfl_xor(ss, 32, 64);
    if (hi == 0) ssq[((size_t)mt * 128 + tl) * 16 + nt * 2 + wn] = ss;
  }
  __syncthreads();
#pragma unroll 4
  for (int i = 0; i < 16; ++i) {
    const int c = tid + 256 * i, tl = c >> 5, ch = c & 31;
    const u32x4 v = *(const u32x4*)(lds + tl * RS + ch * 16);
    *(u32x4*)(outb + ((size_t)mt * 128 + tl) * 1024 + nt * 256 + ch * 8) = v;
  }
}

template <int NR>
DI void resid_rows(const Params& p, int l, int row0, const float* xin) {
  char* const ws_ = opq(p.ws);
  const int lane = tidx() & 63;
  const u16* outb = (const u16*)(ws_ + OFF_OUTB);
  const float* ssq = (const float*)(ws_ + OFF_SSQ);
  u32x2 ob[NR][4]; f32x4 xv[NR][4]; f32x4 sq[NR][2];
#pragma unroll
  for (int r = 0; r < NR; ++r) {
    const size_t row = (size_t)(row0 + r);
    sq[r][0] = *(const f32x4*)(ssq + row * 16); sq[r][1] = *(const f32x4*)(ssq + row * 16 + 4);
#pragma unroll
    for (int i = 0; i < 4; ++i) { const int idx = i * 256 + lane * 4; ob[r][i] = *(const u32x2*)(outb + row * 1024 + idx); xv[r][i] = *(const f32x4*)(xin + row * 1024 + idx); }
  }
  f32x4 gq[4];
#pragma unroll
  for (int i = 0; i < 4; ++i) gq[i] = *(const f32x4*)(p.g_post + l * 1024 + i * 256 + lane * 4);
  u16* xb = (u16*)(ws_ + OFF_XB);
#pragma unroll
  for (int r = 0; r < NR; ++r) {
    const size_t row = (size_t)(row0 + r);
    const float ss = ((sq[r][0][0] + sq[r][0][1]) + (sq[r][0][2] + sq[r][0][3])) + ((sq[r][1][0] + sq[r][1][1]) + (sq[r][1][2] + sq[r][1][3]));
    const float r2 = rsqrtf(ss * (1.f / 1024.f) + 1e-6f);
    float s2 = 0.f;
#pragma unroll
    for (int i = 0; i < 4; ++i) {
      const int idx = i * 256 + lane * 4;
      const f32x4 o = {lo16(ob[r][i][0]), hi16(ob[r][i][0]), lo16(ob[r][i][1]), hi16(ob[r][i][1])};
      f32x4 xn;
#pragma unroll
      for (int e = 0; e < 4; ++e) { xn[e] = xv[r][i][e] + o[e] * r2 * gq[i][e]; s2 += xn[e] * xn[e]; }
      *(f32x4*)(p.out + row * 1024 + idx) = xn;
      if (l < 3) { u32x2 o2; o2[0] = pk2(xn[0], xn[1]); o2[1] = pk2(xn[2], xn[3]); *(u32x2*)(xb + row * 1024 + idx) = o2; }
    }
    s2 = wave_sum(s2);
    if (lane == 0) ((float*)(ws_ + OFF_RN))[row] = rsqrtf(s2 * (1.f / 1024.f) + 1e-6f);
  }
}

DI void cmp_item(const Params& p, int l, int it, char* lds) {
  char* const ws_ = opq(p.ws);
  const int j = it >> 5, mt = (it & 7) * 4 + ((it >> 3) & 3);
  const u16* proj = (const u16*)(ws_ + OFF_PROJ);
  const u16* W1 = (const u16*)(ws_ + OFF_W1) + (size_t)(l * 2 + j) * 256 * 2048;
  const u16* W2 = (const u16*)(ws_ + OFF_W2) + (size_t)(l * 2 + j) * 64 * 256;
  const float* pe = p.pe_cmp + (size_t)(l * 2 + j) * 32 * 64;
  const int kvcol = C_KCMP + 64 * j;
  f32x16 acc[2][1];
  const int tid = tidx();
  gemm_core<4, 2, 1, false>(acc, 32, [&](int i, int r0, int k) -> u32x4 { return *(const u32x4*)((W1 + i * 65536) + (unsigned)(r0 * 2048 + k)); },
   [&](int i, int row, int k) -> u32x4 {
    const int rr = mt * 32 + row, b = rr >> 7; int n = rr & 127; if (n > 126) n = 126;
    const int l32 = k >> 6, d = k & 63;
    const u32x4 raw = *(const u32x4*)(proj + ((size_t)b * S_ + 16 * n + l32) * NP + kvcol + d);
    const f32x4 e0 = *(const f32x4*)(pe + l32 * 64 + d), e1 = *(const f32x4*)(pe + l32 * 64 + d + 4);
    u32x4 o;
    o[0] = pk2(lo16(raw[0]) + e0[0], hi16(raw[0]) + e0[1]); o[1] = pk2(lo16(raw[1]) + e0[2], hi16(raw[1]) + e0[3]);
    o[2] = pk2(lo16(raw[2]) + e1[0], hi16(raw[2]) + e1[1]); o[3] = pk2(lo16(raw[3]) + e1[2], hi16(raw[3]) + e1[3]);
    return o; }, lds, tid);
  const int lane = tid & 63, wid = tid >> 6, l31 = lane & 31, hi = lane >> 5;
#pragma unroll
  for (int a = 0; a < 2; ++a)
#pragma unroll
    for (int r = 0; r < 16; ++r) {
      const float x = acc[a][0][r]; const float u = 0.7978845608028654f * (x + 0.044715f * x * x * x);
      acc[a][0][r] = x / (1.f + __expf(-2.f * u));
    }
  f32x16 c2[2];
#pragma unroll
  for (int r = 0; r < 16; ++r) { c2[0][r] = 0.f; c2[1][r] = 0.f; }
#pragma unroll
  for (int in = 0; in < 2; ++in)
#pragma unroll
    for (int s2 = 0; s2 < 2; ++s2) {
      const bf16x8 h0 = pack8(acc[in][0], s2);
#pragma unroll
      for (int dt = 0; dt < 2; ++dt) {
        const u16* wp = W2 + (size_t)(dt * 32 + l31) * 256 + wid * 64 + in * 32 + 16 * s2 + 4 * hi;
        const s16x4 lo = *(const s16x4*)wp, hh = *(const s16x4*)(wp + 8);
        const bf16x8 wf = {lo[0], lo[1], lo[2], lo[3], hh[0], hh[1], hh[2], hh[3]};
        c2[dt] = MFMA(wf, h0, c2[dt]);
      }
    }
  float* red = (float*)lds;
  __syncthreads();
  for (int w = 0; w < 4; ++w) {
    if (wid == w) {
#pragma unroll
      for (int dt = 0; dt < 2; ++dt)
#pragma unroll
        for (int r = 0; r < 16; ++r) {
          float* q = red + (dt * 32 + crow(r, hi)) * 32 + l31;
          if (w == 0) *q = c2[dt][r]; else *q += c2[dt][r];
        }
    }
    __syncthreads();
  }
  u16* kc = (u16*)(ws_ + OFF_KC); u16* vct = (u16*)(ws_ + OFF_VCT);
#pragma unroll 4
  for (int i = 0; i < 8; ++i) {
    const int e = tid + 256 * i;
    if (j == 0) { const int tok = e >> 6, d = e & 63; const int rr = mt * 32 + tok; kc[(size_t)rr * 64 + d] = f2bf(red[d * 32 + tok]); }
    else { const int d = e >> 5, tok = e & 31; const int rr = mt * 32 + tok, b = rr >> 7, n = rr & 127; vct[((size_t)b * 64 + d) * 128 + n] = f2bf(red[d * 32 + tok]); }
  }
  __syncthreads();
}

DI void win_item(const Params& p, int it, char* lds) {
  char* const ws_ = opq(p.ws);
  const int b = it & 7, qt = it >> 3, q0 = qt * 32;
  const int tid = tidx(), lane = tid & 63, h = tid >> 6, l31 = lane & 31, hi = lane >> 5;
  const u16* proj = (const u16*)(ws_ + OFF_PROJ);
  const int t = q0 + l31; const size_t tok = (size_t)b * S_ + t;
  bf16x8 qr[4];
#pragma unroll
  for (int s = 0; s < 4; ++s) qr[s] = *(const bf16x8*)(proj + tok * NP + C_AQ + h * 64 + 16 * s + 8 * hi);
  char* ldsK = lds; char* ldsV = lds + 9216;
  f32x16 o[2];
#pragma unroll
  for (int r = 0; r < 16; ++r) { o[0][r] = 0.f; o[1][r] = 0.f; }
  float m = M_INIT, lsum = 0.f;
  const int klo = (q0 - 511 > 0 ? q0 - 511 : 0) >> 6, khi = (q0 + 31) >> 6;
  __syncthreads();
  attn_stream(tid, proj, C_KWIN, C_VWIN, khi - klo + 1,
              [&](int ti, int row) { return b * S_ + (klo + ti) * 64 + row; },
              [&](int ti) { const int k0 = (klo + ti) * 64; return (k0 + 63 <= q0) && (k0 >= q0 + 31 - 511); },
              [&](int ti, int kr) { return (unsigned)(t - ((klo + ti) * 64 + kr)) <= 511u; },
              qr, o, m, lsum, lds);
  lsum += __shfl_xor(lsum, 32, 64);
  const float il = 1.f / lsum;
  u16* ow = (u16*)(ws_ + OFF_OWIN);
#pragma unroll
  for (int db = 0; db < 2; ++db)
#pragma unroll
    for (int g = 0; g < 4; ++g) {
      const int d0 = 32 * db + 8 * g + 4 * hi;
      u32x2 v; v[0] = pk2(o[db][4 * g] * il, o[db][4 * g + 1] * il); v[1] = pk2(o[db][4 * g + 2] * il, o[db][4 * g + 3] * il);
      *(u32x2*)(ow + tok * 256 + h * 64 + d0) = v;
    }
}

DI void dil_item(const Params& p, int it, char* lds) {
  char* const ws_ = opq(p.ws);
  const int di = it >> 9, rem = it & 511, b = rem & 7, h = (rem >> 3) & 3, c = rem >> 5;
  const int sh = 2 * di, dil = 1 << sh;
  const int tpr = 16 >> sh;
  const int r = c / tpr, mt = c % tpr, m0 = mt * 128;
  const int tid = tidx(), lane = tid & 63, wid = tid >> 6, l31 = lane & 31, hi = lane >> 5;
  const u16* proj = (const u16*)(ws_ + OFF_PROJ);
  const int mq = m0 + 32 * wid + l31;
  const size_t tok = (size_t)b * S_ + mq * dil + r;
  bf16x8 qr[4];
#pragma unroll
  for (int s = 0; s < 4; ++s) qr[s] = *(const bf16x8*)(proj + tok * NP + C_BQ + h * 64 + 16 * s + 8 * hi);
  const int tt0 = (m0 == 0) ? 2 : 0;
  {
    u32x4 pre[4][4];
#pragma unroll
    for (int tt = 0; tt < 4; ++tt)
      if (tt >= tt0) kv_load(tid, pre[tt], [&](int row) { return b * S_ + (m0 - 128 + 64 * tt + row) * dil + r; }, proj, C_BK + h * 64, C_BV + h * 64);
    __syncthreads();
#pragma unroll
    for (int tt = 0; tt < 4; ++tt)
      if (tt >= tt0) kv_store(tid, pre[tt], lds + tt * 18432, lds + tt * 18432 + 9216);
    __syncthreads();
  }
  f32x16 o[2];
#pragma unroll
  for (int rr = 0; rr < 16; ++rr) { o[0][rr] = 0.f; o[1][rr] = 0.f; }
  float m = M_INIT, lsum = 0.f;
  const int widu = __builtin_amdgcn_readfirstlane(wid);
  const int wlo = m0 + 32 * widu - 128, whi = m0 + 32 * widu + 31;
  for (int tt = tt0; tt < 4; ++tt) {
    const int tk0 = m0 - 128 + 64 * tt;
    if (tk0 + 63 >= wlo && tk0 <= whi) {
      attn_tile(tid, lds + tt * 18432, lds + tt * 18432 + 9216, qr, o, m, lsum, !(tk0 + 63 <= wlo + 128 && tk0 >= whi - 128), [&](int kr) { return (unsigned)(mq - (tk0 + kr)) <= 128u; });
    }
  }
  lsum += __shfl_xor(lsum, 32, 64);
  const float il = 1.f / lsum;
  u16* od = (u16*)(ws_ + OFF_ODIL) + (size_t)di * T_ * 256;
#pragma unroll
  for (int db = 0; db < 2; ++db)
#pragma unroll
    for (int g = 0; g < 4; ++g) {
      const int d0 = 32 * db + 8 * g + 4 * hi;
      u32x2 v; v[0] = pk2(o[db][4 * g] * il, o[db][4 * g + 1] * il); v[1] = pk2(o[db][4 * g + 2] * il, o[db][4 * g + 3] * il);
      *(u32x2*)(od + tok * 256 + h * 64 + d0) = v;
    }
  if (hi == 0) ((float*)(ws_ + OFF_LSE))[((size_t)di * T_ + tok) * 4 + h] = m * 0.6931471805599453f + __logf(lsum);
}

DI void pool_item(const Params& p, int l, int it, char* lds) {
  char* const ws_ = opq(p.ws);
  const int b = it & 7, qt = it >> 3, q0 = qt * 32;
  const int tid = tidx(), lane = tid & 63, g = tid >> 6, l31 = lane & 31, hi = lane >> 5;
  const u16* proj = (const u16*)(ws_ + OFF_PROJ);
  u16* cin = (u16*)lds;
  char* pl = lds + 48 * 512;
  u32x4 cv[6];
#pragma unroll
  for (int i = 0; i < 6; ++i) {
    const int c = tid + 256 * i, row = c >> 5, ch = c & 31; const int t = q0 - 16 + row;
    cv[i] = u32x4{0u, 0u, 0u, 0u};
    if (t >= 0) cv[i] = *(const u32x4*)(proj + ((size_t)b * S_ + t) * NP + C_CIN + ch * 8);
  }
  const u16* wpt = (const u16*)(ws_ + OFF_WPT) + (size_t)(l * 4 + g) * 4096;
  bf16x8 af[8];
#pragma unroll
  for (int q = 0; q < 8; ++q) af[q] = *(const bf16x8*)(wpt + ((q & 1) * 32 + l31) * 64 + 16 * (q >> 1) + 8 * hi);
  const size_t tok = (size_t)b * S_ + q0 + l31;
  f32x4 psv[8]; u32x2 zv[8];
#pragma unroll
  for (int q = 0; q < 8; ++q) {
    const int col = g * 64 + (q >> 2) * 32 + 8 * (q & 3) + 4 * hi;
    psv[q] = *(const f32x4*)(p.pool_scale + l * 256 + col); zv[q] = *(const u32x2*)(proj + tok * NP + C_CZ + col);
  }
  __syncthreads();
#pragma unroll
  for (int i = 0; i < 6; ++i) { const int c = tid + 256 * i, row = c >> 5, ch = c & 31; *(u32x4*)(cin + row * 256 + ch * 8) = cv[i]; }
  __syncthreads();
  {
    const int ch = tid, w = 2 << g;
    float s = 0.f;
    for (int r = 17 - w; r <= 16; ++r) s += bf2f(cin[r * 256 + ch]);
#pragma unroll 4
    for (int i = 0; i < 32; ++i) {
      const int t = q0 + i; const int cnt = (t + 1 < w) ? t + 1 : w;
      const float self = bf2f(cin[(i + 16) * 256 + ch]);
      *(u16*)(pl + i * 528 + ch * 2) = f2bf(s / (float)cnt - self);
      s += bf2f(cin[(i + 17) * 256 + ch]) - bf2f(cin[(i + 17 - w) * 256 + ch]);
    }
  }
  __syncthreads();
  f32x16 acc[2];
#pragma unroll
  for (int r = 0; r < 16; ++r) { acc[0][r] = 0.f; acc[1][r] = 0.f; }
#pragma unroll
  for (int s4 = 0; s4 < 4; ++s4) {
    const bf16x8 bf = *(const bf16x8*)(pl + l31 * 528 + (g * 64 + 16 * s4 + 8 * hi) * 2);
#pragma unroll
    for (int dt = 0; dt < 2; ++dt) acc[dt] = MFMA(af[s4 * 2 + dt], bf, acc[dt]);
  }
  u16* y = (u16*)(ws_ + OFF_XB);
#pragma unroll
  for (int dt = 0; dt < 2; ++dt)
#pragma unroll
    for (int g4 = 0; g4 < 4; ++g4) {
      const int col = g * 64 + dt * 32 + 8 * g4 + 4 * hi;
      const f32x4 ps = psv[dt * 4 + g4];
      const u32x2 z = zv[dt * 4 + g4];
      u32x2 v;
      v[0] = pk2(acc[dt][4 * g4] * ps[0] * siluf_(lo16(z[0])), acc[dt][4 * g4 + 1] * ps[1] * siluf_(hi16(z[0])));
      v[1] = pk2(acc[dt][4 * g4 + 2] * ps[2] * siluf_(lo16(z[1])), acc[dt][4 * g4 + 3] * ps[3] * siluf_(hi16(z[1])));
      *(u32x2*)(y + tok * 1024 + 512 + col) = v;
    }
}

DI void sgu_item(const Params& p, int l, int it, char* lds) {
  char* const ws_ = opq(p.ws);
  const int b = it & 7, c = (it >> 5) & 15, g = (it >> 3) & 3, t0 = c * 128;
  const int tid = tidx(), lane = tid & 63, l31 = lane & 31, hi = lane >> 5;
  const int wid = __builtin_amdgcn_readfirstlane(tid >> 6);
  const u16* proj = (const u16*)(ws_ + OFF_PROJ);
  char* vn = lds;
  __syncthreads();
  {
    const int j = tid >> 1, half = tid & 1;
    const u16* vp = proj + ((size_t)b * S_ + t0 + j) * NP + C_DV + half * 128;
    u32x4 raw[16];
#pragma unroll
    for (int i = 0; i < 16; ++i) raw[i] = *(const u32x4*)(vp + i * 8);
    float s1 = 0.f;
#pragma unroll
    for (int i = 0; i < 16; ++i)
#pragma unroll
      for (int e = 0; e < 4; ++e) s1 += lo16(raw[i][e]) + hi16(raw[i][e]);
    s1 += __shfl_xor(s1, 1, 64);
    const float mu = s1 * (1.f / 256.f);
    float s2 = 0.f;
#pragma unroll
    for (int i = 0; i < 16; ++i)
#pragma unroll
      for (int e = 0; e < 4; ++e) { const float a = lo16(raw[i][e]) - mu, bb = hi16(raw[i][e]) - mu; s2 += a * a + bb * bb; }
    s2 += __shfl_xor(s2, 1, 64);
    const float rstd = rsqrtf(s2 * (1.f / 256.f) + 1e-5f);
    if (half == (g >> 1)) {
      const float* lg = p.sg_ln_g + l * 256 + g * 64; const float* lb = p.sg_ln_b + l * 256 + g * 64;
      auto emit = [&](const u32x4& r, int i) {
        const f32x4 g0 = *(const f32x4*)(lg + i * 8), g1 = *(const f32x4*)(lg + i * 8 + 4), b0 = *(const f32x4*)(lb + i * 8), b1 = *(const f32x4*)(lb + i * 8 + 4);
        u32x4 o;
        o[0] = pk2((lo16(r[0]) - mu) * rstd * g0[0] + b0[0], (hi16(r[0]) - mu) * rstd * g0[1] + b0[1]);
        o[1] = pk2((lo16(r[1]) - mu) * rstd * g0[2] + b0[2], (hi16(r[1]) - mu) * rstd * g0[3] + b0[3]);
        o[2] = pk2((lo16(r[2]) - mu) * rstd * g1[0] + b1[0], (hi16(r[2]) - mu) * rstd * g1[1] + b1[1]);
        o[3] = pk2((lo16(r[3]) - mu) * rstd * g1[2] + b1[2], (hi16(r[3]) - mu) * rstd * g1[3] + b1[3]);
        *(u32x4*)(vn + j * 144 + i * 16) = o;
      };
      if (g & 1) {
#pragma unroll
        for (int i = 0; i < 8; ++i) emit(raw[8 + i], i);
      } else {
#pragma unroll
        for (int i = 0; i < 8; ++i) emit(raw[i], i);
      }
    }
  }
  __syncthreads();
  const int i = wid * 32 + l31;
  const u16* wsp = (const u16*)(ws_ + OFF_WSP) + ((size_t)(l * 4 + g) * 128 + i) * 128;
  f32x16 acc[2];
#pragma unroll
  for (int r = 0; r < 16; ++r) { acc[0][r] = 0.f; acc[1][r] = 0.f; }
  const int nks = 2 * (wid + 1);
  bf16x8 wfr[8];
#pragma unroll
  for (int s = 0; s < 8; ++s) { if (s < nks) wfr[s] = *(const bf16x8*)(wsp + 16 * s + 8 * hi); else wfr[s] = bf16x8{0, 0, 0, 0, 0, 0, 0, 0}; }
  const char* vb = vn + (8 * hi + ((lane & 15) >> 2)) * 144 + ((lane >> 4) & 1) * 32 + (lane & 3) * 8;
#pragma unroll
  for (int s = 0; s < 8; ++s) {
    if (s < nks) {
#pragma unroll
      for (int ct = 0; ct < 2; ++ct) {
        const s16x4 lo = trread(vb + (16 * s) * 144 + ct * 64), hh = trread(vb + (16 * s + 4) * 144 + ct * 64);
        const bf16x8 af = {lo[0], lo[1], lo[2], lo[3], hh[0], hh[1], hh[2], hh[3]};
        acc[ct] = MFMA(af, wfr[s], acc[ct]);
      }
    }
  }
  const size_t tok = (size_t)b * S_ + t0 + i;
  const float bs = p.b_sp[(l * 4 + g) * 128 + i];
  u16* y = (u16*)(ws_ + OFF_XB);
#pragma unroll
  for (int ct = 0; ct < 2; ++ct)
#pragma unroll
    for (int g4 = 0; g4 < 4; ++g4) {
      const int col = g * 64 + ct * 32 + 8 * g4 + 4 * hi;
      const u32x2 u = *(const u32x2*)(proj + tok * NP + C_DU + col), z = *(const u32x2*)(proj + tok * NP + C_DZ + col);
      u32x2 v;
      v[0] = pk2(lo16(u[0]) * (acc[ct][4 * g4] + bs) * siluf_(lo16(z[0])), hi16(u[0]) * (acc[ct][4 * g4 + 1] + bs) * siluf_(hi16(z[0])));
      v[1] = pk2(lo16(u[1]) * (acc[ct][4 * g4 + 2] + bs) * siluf_(lo16(z[1])), hi16(u[1]) * (acc[ct][4 * g4 + 3] + bs) * siluf_(hi16(z[1])));
      *(u32x2*)(y + tok * 1024 + 768 + col) = v;
    }
}

DI void nsa_item(const Params& p, int it, char* lds) {
  char* const ws_ = opq(p.ws);
  const int b = it & 7, qt = 63 - (it >> 3), q0 = qt * 32;
  const int tid = tidx(), lane = tid & 63, h = tid >> 6, l31 = lane & 31, hi = lane >> 5;
  const u16* proj = (const u16*)(ws_ + OFF_PROJ);
  const int t = q0 + l31; const size_t tok = (size_t)b * S_ + t;
  bf16x8 qr[4];
#pragma unroll
  for (int s = 0; s < 4; ++s) qr[s] = *(const bf16x8*)(proj + tok * NP + C_AQ + h * 64 + 16 * s + 8 * hi);
  char* ldsK = lds; char* ldsV = lds + 9216;
  float* impS = (float*)(lds + 36864);
  float* vals = (float*)(lds + 36864 + 16384);
  unsigned* selm = (unsigned*)(lds + 73728 - 256);
  int* jlist = (int*)(lds + 73728 - 128);
  float* yst = (float*)(lds + 36864);
  __syncthreads();
  if (tid < 32) selm[tid] = 0u;
  const float g0 = sigmoidf_(bf2f(proj[tok * NP + C_AG + 0 + h])), g1 = sigmoidf_(bf2f(proj[tok * NP + C_AG + 4 + h])), g2 = sigmoidf_(bf2f(proj[tok * NP + C_AG + 8 + h]));
  f32x16 ya[2];
  {
    const u16* kc = (const u16*)(ws_ + OFF_KC); const u16* vct = (const u16*)(ws_ + OFF_VCT);
    f32x16 sc[4];
    const int nkb = (((q0 + 31 - 31) >> 4) >> 5) + 1;
#pragma unroll
    for (int kb = 0; kb < 4; ++kb) {
#pragma unroll
      for (int r = 0; r < 16; ++r) sc[kb][r] = 0.f;
      if (kb < nkb) {
#pragma unroll
        for (int s = 0; s < 4; ++s) {
          const bf16x8 kf = *(const bf16x8*)(kc + ((size_t)(b * 128 + kb * 32 + l31)) * 64 + 16 * s + 8 * hi);
          sc[kb] = MFMA(kf, qr[s], sc[kb]);
        }
      }
    }
    s16x4 vcl[16], vch[16];
#pragma unroll
    for (int q = 0; q < 16; ++q) {
      const int kb = q >> 2, s2 = (q >> 1) & 1, db = q & 1;
      const u16* vp = vct + ((size_t)(b * 64 + 32 * db + l31)) * 128 + 32 * kb + 16 * s2 + 4 * hi;
      vcl[q] = s16x4{0, 0, 0, 0}; vch[q] = s16x4{0, 0, 0, 0};
      if (kb < nkb) { vcl[q] = *(const s16x4*)vp; vch[q] = *(const s16x4*)(vp + 8); }
    }
    const int nv = (t >= 31) ? ((t - 31) >> 4) : -1;
    float mx = NEGB;
#pragma unroll
    for (int kb = 0; kb < 4; ++kb)
#pragma unroll
      for (int r = 0; r < 16; ++r) { const int n = 32 * kb + crow(r, hi); const float v = (n <= nv) ? sc[kb][r] * C2 : NEGB; sc[kb][r] = v; mx = fmaxf(mx, v); }
    mx = fmaxf(mx, __shfl_xor(mx, 32, 64));
    float sum = 0.f;
#pragma unroll
    for (int kb = 0; kb < 4; ++kb)
#pragma unroll
      for (int r = 0; r < 16; ++r) { const int n = 32 * kb + crow(r, hi); const float e = (n <= nv) ? ex2(sc[kb][r] - mx) : 0.f; sc[kb][r] = e; sum += e; }
    sum += __shfl_xor(sum, 32, 64);
    const float inv = sum > 0.f ? 1.f / sum : 0.f;
#pragma unroll
    for (int kb = 0; kb < 4; ++kb)
#pragma unroll
      for (int r = 0; r < 16; ++r) sc[kb][r] *= inv;
    float* myimp = impS + (h * 32 + l31) * 32;
#pragma unroll
    for (int kb = 0; kb < 4; ++kb)
#pragma unroll
      for (int g = 0; g < 4; ++g) myimp[8 * kb + 2 * g + hi] = ((sc[kb][4 * g] + sc[kb][4 * g + 1]) + sc[kb][4 * g + 2]) + sc[kb][4 * g + 3];
    __syncthreads();
#pragma unroll
    for (int kb = 0; kb < 4; ++kb)
#pragma unroll
      for (int g = 0; g < 4; ++g) { const int j1 = 8 * kb + 2 * g + hi + 1; if (j1 < 32) myimp[j1] += sc[kb][4 * g + 3]; }
    f32x16 oc[2];
#pragma unroll
    for (int r = 0; r < 16; ++r) { oc[0][r] = 0.f; oc[1][r] = 0.f; }
#pragma unroll
    for (int kb = 0; kb < 4; ++kb)
#pragma unroll
      for (int s2 = 0; s2 < 2; ++s2) {
        if (kb >= nkb) continue;
        const bf16x8 pf = pack8(sc[kb], s2);
#pragma unroll
        for (int db = 0; db < 2; ++db) {
          const s16x4 lo = vcl[(kb * 2 + s2) * 2 + db], hh = vch[(kb * 2 + s2) * 2 + db];
          const bf16x8 vf = {lo[0], lo[1], lo[2], lo[3], hh[0], hh[1], hh[2], hh[3]};
          oc[db] = MFMA(vf, pf, oc[db]);
        }
      }
#pragma unroll
    for (int r = 0; r < 16; ++r) { ya[0][r] = oc[0][r] * g0; ya[1][r] = oc[1][r] * g0; }
  }
  __syncthreads();
  const int cur = q0 >> 6;
  {
    const int q = tid >> 3, sub = tid & 7;
#pragma unroll
    for (int jj = 0; jj < 4; ++jj) {
      const int j = sub * 4 + jj;
      float v = ((impS[(0 * 32 + q) * 32 + j] + impS[(1 * 32 + q) * 32 + j]) + impS[(2 * 32 + q) * 32 + j]) + impS[(3 * 32 + q) * 32 + j];
      const bool forced = (j == 0) || (j == cur) || (j == cur - 1);
      v = forced ? 1e4f : ((j <= cur) ? v : -1e4f);
      vals[q * 32 + j] = v;
    }
    __syncthreads();
    f32x4 vv[8];
#pragma unroll
    for (int i = 0; i < 8; ++i) vv[i] = *(const f32x4*)(vals + q * 32 + i * 4);
    unsigned bits = 0u;
#pragma unroll
    for (int jj = 0; jj < 4; ++jj) {
      const int j = sub * 4 + jj; const float v = vals[q * 32 + j];
      int cnt = 0;
#pragma unroll
      for (int j2 = 0; j2 < 32; ++j2) { const float w = vv[j2 >> 2][j2 & 3]; cnt += ((w > v) || (w == v && j2 < j)) ? 1 : 0; }
      if (cnt < 16 && j <= cur) bits |= 1u << j;
    }
    if (bits) atomicOr(&selm[q], bits);
  }
  __syncthreads();
  const unsigned mymask = selm[l31];
  unsigned anym = mymask, allm = mymask;
#pragma unroll
  for (int o = 16; o >= 1; o >>= 1) { anym |= (unsigned)__shfl_xor((int)anym, o, 64); allm &= (unsigned)__shfl_xor((int)allm, o, 64); }
  anym = __builtin_amdgcn_readfirstlane(anym);
  allm = __builtin_amdgcn_readfirstlane(allm);
  if (tid < 32) { if ((anym >> tid) & 1u) jlist[__builtin_popcount(anym & ((1u << tid) - 1u))] = tid; }
  f32x16 o[2];
#pragma unroll
  for (int r = 0; r < 16; ++r) { o[0][r] = 0.f; o[1][r] = 0.f; }
  float m = M_INIT, lsum = 0.f;
#pragma unroll
  for (int r = 0; r < 16; ++r) { yst[r * 256 + tid] = ya[0][r]; yst[(16 + r) * 256 + tid] = ya[1][r]; }
  __syncthreads();
  attn_stream(tid, proj, C_KSLC, C_VSLC, __builtin_popcount(anym),
              [&](int ti, int row) { return b * S_ + jlist[ti] * 64 + row; },
              [&](int ti) { const int jb = jlist[ti]; return (jb < cur) && ((allm >> jb) & 1u); },
              [&](int ti, int kr) { const int jb = jlist[ti]; return ((mymask >> jb) & 1u) && (jb * 64 + kr <= t); },
              qr, o, m, lsum, lds);
#pragma unroll
  for (int r = 0; r < 16; ++r) { ya[0][r] = yst[r * 256 + tid]; ya[1][r] = yst[(16 + r) * 256 + tid]; }
  lsum += __shfl_xor(lsum, 32, 64);
  const float il = g1 / lsum;
  const u16* ow = (const u16*)(ws_ + OFF_OWIN);
  u16* y = (u16*)(ws_ + OFF_XB);
#pragma unroll
  for (int db = 0; db < 2; ++db)
#pragma unroll
    for (int g = 0; g < 4; ++g) {
      const int col = h * 64 + 32 * db + 8 * g + 4 * hi;
      const u32x2 w = *(const u32x2*)(ow + tok * 256 + col), az = *(const u32x2*)(proj + tok * NP + C_AZ + col);
      const float v0 = (ya[db][4 * g] + o[db][4 * g] * il + g2 * lo16(w[0])) * siluf_(lo16(az[0]));
      const float v1 = (ya[db][4 * g + 1] + o[db][4 * g + 1] * il + g2 * hi16(w[0])) * siluf_(hi16(az[0]));
      const float v2 = (ya[db][4 * g + 2] + o[db][4 * g + 2] * il + g2 * lo16(w[1])) * siluf_(lo16(az[1]));
      const float v3 = (ya[db][4 * g + 3] + o[db][4 * g + 3] * il + g2 * hi16(w[1])) * siluf_(hi16(az[1]));
      u32x2 v; v[0] = pk2(v0, v1); v[1] = pk2(v2, v3);
      *(u32x2*)(y + tok * 1024 + col) = v;
    }
}

DI void dilcomb_item(const Params& p, int it) {
  char* const ws_ = opq(p.ws);
  const u16* proj = (const u16*)(ws_ + OFF_PROJ);
  const u16* od = (const u16*)(ws_ + OFF_ODIL);
  const float* lse = (const float*)(ws_ + OFF_LSE);
  u16* y = (u16*)(ws_ + OFF_XB);
#pragma unroll
  for (int i = 0; i < 4; ++i) {
    const int idx = it * 1024 + i * 256 + threadIdx.x;
    const size_t tok = idx >> 5; const int c8 = idx & 31, h = c8 >> 3;
    const float l0 = lse[((size_t)0 * T_ + tok) * 4 + h], l1 = lse[((size_t)1 * T_ + tok) * 4 + h], l2 = lse[((size_t)2 * T_ + tok) * 4 + h];
    const float mx = fmaxf(l0, fmaxf(l1, l2));
    float w0 = __expf(l0 - mx), w1 = __expf(l1 - mx), w2 = __expf(l2 - mx);
    const float iw = 1.f / (w0 + w1 + w2); w0 *= iw; w1 *= iw; w2 *= iw;
    const u32x4 a = *(const u32x4*)(od + ((size_t)0 * T_ + tok) * 256 + c8 * 8), bq = *(const u32x4*)(od + ((size_t)1 * T_ + tok) * 256 + c8 * 8), cq = *(const u32x4*)(od + ((size_t)2 * T_ + tok) * 256 + c8 * 8);
    const u32x4 z = *(const u32x4*)(proj + tok * NP + C_BZ + c8 * 8);
    u32x4 r;
#pragma unroll
    for (int e = 0; e < 4; ++e) {
      const float v0 = (w0 * lo16(a[e]) + w1 * lo16(bq[e]) + w2 * lo16(cq[e])) * siluf_(lo16(z[e]));
      const float v1 = (w0 * hi16(a[e]) + w1 * hi16(bq[e]) + w2 * hi16(cq[e])) * siluf_(hi16(z[e]));
      r[e] = pk2(v0, v1);
    }
    *(u32x4*)(y + tok * 1024 + 256 + c8 * 8) = r;
  }
}

__global__ void __launch_bounds__(256, 2) hybrid_megakernel(Params p) {
  __shared__ __attribute__((aligned(16))) char lds[73728];
  __shared__ uint4 xb_words;
  __shared__ uint4 xg_words;
  cg::grid_group grid = cg::this_grid();
  char* const ws_ = p.ws;
  if (p.ws == nullptr) grid.sync();
  if (threadIdx.x == 0) { xb_words = make_uint4(0u, 0u, 0u, 0u); xg_words = make_uint4(0u, 0u, 0u, 0u); }
  __syncthreads();
  const XcdBarrier xb = xcd_barrier_post((unsigned*)(ws_ + OFF_BAR), (volatile LAS unsigned*)&xb_words, gridDim.x);
  const bool grp = (gridDim.x % 8u) == 0u;
  const XcdBarrier xg = grp ? xcd_barrier_post((unsigned*)(ws_ + OFF_BAR) + (1 + (blockIdx.x & 7)) * 4096, (volatile LAS unsigned*)&xg_words, gridDim.x / 8u) : xb;
  const int nb = gridDim.x, bid = blockIdx.x;
  const int wid = threadIdx.x >> 6;
  for (int it = bid; it < 3328 + 1024 + 1024 + 32 + 16 + 64; it += nb) {
    if (it < 3328) { const int l = it / 832, r = it % 832, ntile = r >> 4, ktile = r & 15;
      tr_tile(p.w_in + (size_t)l * 1024 * 3212, 3212, (u16*)(ws_ + OFF_WIN) + (size_t)l * NP * 1024, 1024, ktile * 64, ntile * 64, p.g_pre + l * 1024, 1, lds); }
    else if (it < 4352) { const int i2 = it - 3328, l = i2 >> 8, r = i2 & 255, ntile = r >> 4, ktile = r & 15;
      tr_tile(p.w_out + (size_t)l * 1024 * 1024, 1024, (u16*)(ws_ + OFF_WOUT) + (size_t)l * 1024 * 1024, 1024, ktile * 64, ntile * 64, nullptr, 0, lds); }
    else if (it < 5376) { const int i2 = it - 4352, mtx = i2 >> 7, r = i2 & 127, ntile = r >> 5, ktile = r & 31;
      tr_tile(p.w_cmp1 + (size_t)mtx * 2048 * 256, 256, (u16*)(ws_ + OFF_W1) + (size_t)mtx * 256 * 2048, 2048, ktile * 64, ntile * 64, nullptr, 0, lds); }
    else if (it < 5408) { const int i2 = it - 5376, mtx = i2 >> 2, ktile = i2 & 3;
      tr_tile(p.w_cmp2 + (size_t)mtx * 256 * 64, 64, (u16*)(ws_ + OFF_W2) + (size_t)mtx * 64 * 256, 256, ktile * 64, 0, nullptr, 0, lds); }
    else if (it < 5424) { const int mtx = it - 5408;
      tr_tile(p.w_pool + (size_t)mtx * 4096, 64, (u16*)(ws_ + OFF_WPT) + (size_t)mtx * 4096, 64, 0, 0, nullptr, 0, lds); }
    else { const int i2 = it - 5424, mtx = i2 >> 2, qd = i2 & 3;
      const float* src = p.w_sp + (size_t)mtx * 16384 + qd * 4096; u16* dst = (u16*)(ws_ + OFF_WSP) + (size_t)mtx * 16384 + qd * 4096;
      f32x4 v[4];
#pragma unroll
      for (int k = 0; k < 4; ++k) v[k] = *(const f32x4*)(src + (threadIdx.x + 256 * k) * 4);
#pragma unroll
      for (int k = 0; k < 4; ++k) {
        const int e = qd * 4096 + (threadIdx.x + 256 * k) * 4, i = e >> 7, j = e & 127;
        u32x2 o; o[0] = pk2(j <= i ? v[k][0] : 0.f, j + 1 <= i ? v[k][1] : 0.f); o[1] = pk2(j + 2 <= i ? v[k][2] : 0.f, j + 3 <= i ? v[k][3] : 0.f);
        *(u32x2*)(dst + (threadIdx.x + 256 * k) * 4) = o;
      } }
  }
  for (int it = bid; it < T_ / 32; it += nb) {
    const int row = it * 32 + wid * 8;
    rows_convert<8>(p.x + (size_t)row * 1024, (u16*)(ws_ + OFF_XB) + (size_t)row * 1024, (float*)(ws_ + OFF_RN) + row);
  }
  xcd_barrier(xb);
  for (int l = 0; l < 4; ++l) {
    for (int it = bid; it < 1536; it += nb) { const int q = it >> 3; inproj_tile<4>(p, l, (it & 7) * 16 + (q & 15), q >> 4, lds); }
    xcd_barrier(xg);
    for (int vb = bid; vb < 512; vb += nb) {
      if (vb < 64) cmp_item(p, l, vb, lds);
      else {
        const int j = vb - 64;
        if (vb >= 256) { const int i2 = (vb - 256) >> 3; inproj_tile<2>(p, l, (vb & 7) * 16 + (i2 & 15), 24 + (i2 >> 4), lds); }
        win_item(p, j, lds);
        if (j + 448 < 512) win_item(p, j + 448, lds);
        for (int it = j; it < 1536; it += 448) dil_item(p, it, lds);
      }
    }
    xcd_barrier(xg);
    for (int vb = bid; vb < 512; vb += nb) {
      nsa_item(p, vb, lds);
      const int gi = vb >> 4;
      int start = 0, mine = 0;
      for (int g2 = 0; g2 <= gi; ++g2) {
        const int n = 32 - g2;
        const int d = (n <= 10) ? 2 : (n <= 22) ? 1 : 0;
        if (g2 < gi) start += 2 * d; else mine = d;
      }
      start += ((vb >> 3) & 1) * mine;
      const int x = vb & 7;
      for (int k = 0; k < mine; ++k) { const int slot = start + k; sgu_item(p, l, slot * 8 + x, lds); pool_item(p, l, slot * 8 + x, lds); dilcomb_item(p, x * 64 + slot); }
    }
    xcd_barrier(xg);
    for (int it = bid; it < 512; it += nb) outproj_item(p, l, it, lds);
    xcd_barrier(xg);
    const float* xin = (l == 0) ? p.x : p.out;
    for (int vb = bid; vb < 512; vb += nb)
      for (int j = vb >> 3; j < 128; j += 64) resid_rows<4>(p, l, (vb & 7) * 2048 + j * 16 + wid * 4, xin);
    if (l < 3) xcd_barrier(xg);
  }
}

extern "C" void kernel_launch(void* const* d_in, const int* in_sizes, int n_in, void* d_out, int out_size, void* d_ws, size_t ws_size, hipStream_t stream) {
  static int grid_blocks = 0;
  if (!grid_blocks) {
    int dev = 0, cus = 0, per_cu = 0;
    hipGetDevice(&dev);
    hipDeviceGetAttribute(&cus, hipDeviceAttributeMultiprocessorCount, dev);
    hipOccupancyMaxActiveBlocksPerMultiprocessor(&per_cu, hybrid_megakernel, 256, 0);
    if (per_cu > 2) per_cu = 2;
    if (per_cu < 1) per_cu = 1;
    grid_blocks = cus * per_cu;
  }
  if (ws_size < WS_TOTAL) { fprintf(stderr, "workspace too small: %zu < %zu\n", ws_size, (size_t)WS_TOTAL); return; }
  Params p{};
  p.x = (const float*)d_in[0]; p.g_pre = (const float*)d_in[1]; p.w_in = (const float*)d_in[2]; p.pe_cmp = (const float*)d_in[3];
  p.w_cmp1 = (const float*)d_in[4]; p.w_cmp2 = (const float*)d_in[5]; p.w_pool = (const float*)d_in[6]; p.pool_scale = (const float*)d_in[7];
  p.sg_ln_g = (const float*)d_in[8]; p.sg_ln_b = (const float*)d_in[9]; p.w_sp = (const float*)d_in[10]; p.b_sp = (const float*)d_in[11];
  p.w_out = (const float*)d_in[12]; p.g_post = (const float*)d_in[13];
  p.out = (float*)d_out; p.ws = (char*)d_ws;
  hipMemsetAsync((char*)d_ws + OFF_BAR, 0, 9 * 16384, stream);
  void* args[] = {&p};
  hipError_t e = hipLaunchCooperativeKernel((void*)hybrid_megakernel, dim3(grid_blocks), dim3(256), args, 0, stream);
  if (e != hipSuccess) fprintf(stderr, "cooperative launch failed: %s (grid %d)\n", hipGetErrorString(e), grid_blocks);
}
```

```cpp
#include <hip/hip_runtime.h>
#include <hip/hip_cooperative_groups.h>
#include <cstdio>
namespace cg = cooperative_groups;

typedef unsigned short u16;
using bf16x8 = __attribute__((ext_vector_type(8))) short;
using s16x4 = __attribute__((ext_vector_type(4))) short;
using f32x16 = __attribute__((ext_vector_type(16))) float;
using f32x4 = __attribute__((ext_vector_type(4))) float;
using u32x4 = __attribute__((ext_vector_type(4))) unsigned;
using u32x2 = __attribute__((ext_vector_type(2))) unsigned;
typedef short v4i16_t __attribute__((ext_vector_type(4)));
#define DI __device__ __forceinline__
#define MFMA(a, b, c) __builtin_amdgcn_mfma_f32_32x32x16_bf16((a), (b), (c), 0, 0, 0)

constexpr int T_ = 16384, S_ = 2048, NP = 3328;
constexpr float C2 = 0.125f * 1.4426950408889634f;
constexpr float NEGB = -1e30f;

constexpr int C_AQ = 0, C_KCMP = 256, C_KSLC = 384, C_VSLC = 448, C_KWIN = 512, C_VWIN = 576, C_AZ = 640;
constexpr int C_BQ = 896, C_BK = 1152, C_BV = 1408, C_BZ = 1664, C_CIN = 1920, C_CZ = 2176, C_DU = 2432, C_DV = 2688, C_DZ = 2944, C_AG = 3200;

constexpr size_t al(size_t x) { return (x + 255) & ~(size_t)255; }
constexpr size_t OFF_WIN = 0;
constexpr size_t OFF_WOUT = OFF_WIN + al((size_t)4 * NP * 1024 * 2);
constexpr size_t OFF_W1 = OFF_WOUT + al((size_t)4 * 1024 * 1024 * 2);
constexpr size_t OFF_W2 = OFF_W1 + al((size_t)4 * 2 * 256 * 2048 * 2);
constexpr size_t OFF_XB = OFF_W2 + al((size_t)4 * 2 * 64 * 256 * 2);
constexpr size_t OFF_RN = OFF_XB + al((size_t)T_ * 1024 * 2);
constexpr size_t OFF_PROJ = OFF_RN + al((size_t)T_ * 4);
constexpr size_t OFF_SSQ = OFF_PROJ + al((size_t)T_ * NP * 2);
constexpr size_t OFF_KC = OFF_SSQ + al((size_t)T_ * 16 * 4);
constexpr size_t OFF_VCT = OFF_KC + al((size_t)8 * 128 * 64 * 2);
constexpr size_t OFF_OWIN = OFF_VCT + al((size_t)8 * 128 * 64 * 2);
constexpr size_t OFF_ODIL = OFF_OWIN + al((size_t)T_ * 256 * 2);
constexpr size_t OFF_LSE = OFF_ODIL + al((size_t)3 * T_ * 256 * 2);
constexpr size_t OFF_WPT = OFF_LSE + al((size_t)3 * T_ * 4 * 4);
constexpr size_t OFF_WSP = OFF_WPT + al((size_t)16 * 64 * 64 * 2);
constexpr size_t OFF_OUTB = OFF_WSP + al((size_t)16 * 128 * 128 * 2);
constexpr size_t OFF_BAR = OFF_OUTB + al((size_t)T_ * 1024 * 2);
constexpr size_t WS_TOTAL = OFF_BAR + 9 * 16384;
static_assert(WS_TOTAL <= (size_t)256 * 1024 * 1024, "workspace layout exceeds the guaranteed 256 MiB");

struct Params {
  const float *x, *g_pre, *w_in, *pe_cmp, *w_cmp1, *w_cmp2, *w_pool, *pool_scale, *sg_ln_g, *sg_ln_b, *w_sp, *b_sp, *w_out, *g_post;
  float* out;
  char* ws;
};

DI char* opq(char* q) { size_t z = 0; asm volatile("" : "+s"(z)); return q + z; }
DI int tidx() { int t = threadIdx.x; asm volatile("" : "+v"(t)); return t; }
DI float bf2f(u16 v) { return __uint_as_float((unsigned)v << 16); }
DI unsigned pk2(float a, float b) {
  typedef __bf16 bf2 __attribute__((ext_vector_type(2)));
  typedef float f2 __attribute__((ext_vector_type(2)));
  f2 v = {a, b};
  bf2 r = __builtin_convertvector(v, bf2);
  return __builtin_bit_cast(unsigned, r);
}
DI u16 f2bf(float x) { return (u16)(pk2(x, 0.f) & 0xffffu); }
DI float lo16(unsigned w) { return __uint_as_float(w << 16); }
DI float hi16(unsigned w) { return __uint_as_float(w & 0xffff0000u); }
DI int crow(int r, int hi) { return (r & 3) + 8 * (r >> 2) + 4 * hi; }
DI float ex2(float x) { return __builtin_amdgcn_exp2f(x); }
DI float sigmoidf_(float x) { return 1.f / (1.f + __expf(-x)); }
DI float siluf_(float x) { return x / (1.f + __expf(-x)); }
DI float wave_sum(float v) {
#pragma unroll
  for (int o = 32; o >= 1; o >>= 1) v += __shfl_xor(v, o, 64);
  return v;
}
DI bf16x8 pack8(const f32x16& x, int s8) {
  u32x4 p;
  p[0] = pk2(x[8 * s8 + 0], x[8 * s8 + 1]); p[1] = pk2(x[8 * s8 + 2], x[8 * s8 + 3]);
  p[2] = pk2(x[8 * s8 + 4], x[8 * s8 + 5]); p[3] = pk2(x[8 * s8 + 6], x[8 * s8 + 7]);
  return __builtin_bit_cast(bf16x8, p);
}
DI s16x4 trread(const char* p) {
  return __builtin_bit_cast(s16x4, __builtin_amdgcn_ds_read_tr16_b64_v4i16((__attribute__((address_space(3))) v4i16_t*)p));
}


#define XB_TMO      128
#define XB_XCNT(j)  (256  + 64 * (j))
#define XB_XSUB(j)  (1280 + 64 * (j))
#define XB_XGEN(j)  (2304 + 64 * (j))
#define XB_TOP      3328
#define XB_TOPGEN   3392
#define XCD_BAR_WORDS 3456
#define XB_SPIN_CAP (1u << 22)
#define LAS __attribute__((address_space(3)))
DI unsigned xb_ld(unsigned* p)              { return __hip_atomic_load(p, __ATOMIC_RELAXED, __HIP_MEMORY_SCOPE_AGENT); }
DI unsigned xb_add(unsigned* p, unsigned v) { return __hip_atomic_fetch_add(p, v, __ATOMIC_RELAXED, __HIP_MEMORY_SCOPE_AGENT); }
DI unsigned xb_xcc_id() { return (unsigned)__builtin_amdgcn_s_getreg((3 << 11) | 20) & 0xFu; }
#define XB_SPIN(cond, bar) do { unsigned _sp = 0; while (cond) { __builtin_amdgcn_s_sleep(1); \
    if ((++_sp & 255u) == 0u) { if (xb_ld(&(bar)[XB_TMO])) break; if (_sp > XB_SPIN_CAP) { atomicAdd(&(bar)[XB_TMO], 1u); break; } } } } while (0)
struct XcdBarrier { unsigned* bar; unsigned x; volatile LAS unsigned* st; unsigned G; };
DI XcdBarrier xcd_barrier_post(unsigned* bar, volatile LAS unsigned* st, unsigned G) {
    XcdBarrier b; b.bar = bar; b.x = xb_xcc_id(); b.st = st; b.G = G;
    if (threadIdx.x == 0) (void)xb_add(&bar[XB_XCNT(b.x)], 1u);
    return b;
}
DI void xcd_barrier_complete(unsigned* bar, unsigned x, unsigned G, unsigned& nloc, unsigned& nx) {
    unsigned sum, cnt, mine, sp = 0u;
    for (;;) {
        sum = 0u; cnt = 0u; mine = 0u;
#pragma unroll
        for (unsigned j = 0; j < 16; ++j) { const unsigned c = xb_ld(&bar[XB_XCNT(j)]); sum += c; cnt += (c > 0u) ? 1u : 0u; mine = (j == x) ? c : mine; }
        if (sum == G) break;
        __builtin_amdgcn_s_sleep(1);
        if ((++sp & 255u) == 0u) { if (xb_ld(&bar[XB_TMO])) break; if (sp > XB_SPIN_CAP) { atomicAdd(&bar[XB_TMO], 1u); break; } }
    }
    nloc = mine > 0u ? mine : 1u; nx = cnt > 0u ? cnt : 1u;
}
DI void xcd_barrier(const XcdBarrier& b) {
    asm volatile("s_waitcnt vmcnt(0)" ::: "memory");
    __syncthreads();
    if (threadIdx.x == 0) {
        unsigned* bar = b.bar;
        __builtin_amdgcn_s_waitcnt(0);
        unsigned nloc = b.st[0], nx = b.st[1];
        if (nloc == 0u) { xcd_barrier_complete(bar, b.x, b.G, nloc, nx); b.st[0] = nloc; b.st[1] = nx; }
        const unsigned old = xb_add(&bar[XB_XSUB(b.x)], 1u);
        const unsigned gen = old / nloc;
        if (old + 1u == (gen + 1u) * nloc) {
            __builtin_amdgcn_fence(__ATOMIC_RELEASE, "agent");
            asm volatile("s_waitcnt vmcnt(0)" ::: "memory");
            const unsigned og = xb_add(&bar[XB_TOP], 1u);
            const unsigned tg = og / nx;
            if (og + 1u == (tg + 1u) * nx) xb_add(&bar[XB_TOPGEN], 1u);
            else XB_SPIN(xb_ld(&bar[XB_TOPGEN]) == tg, bar);
            __builtin_amdgcn_fence(__ATOMIC_ACQUIRE, "agent");
            xb_add(&bar[XB_XGEN(b.x)], 1u);
            asm volatile("s_waitcnt vmcnt(0)" ::: "memory");
        } else {
            XB_SPIN(xb_ld(&bar[XB_XGEN(b.x)]) == gen, bar);
            __builtin_amdgcn_fence(__ATOMIC_ACQUIRE, "agent");
            asm volatile("s_waitcnt vmcnt(0)" ::: "memory");
        }
    }
    __syncthreads();
}

template <int WGN, int INS, int IMS, bool DB, class LdW, class LdX>
DI void gemm_core(f32x16 (&acc)[INS][IMS], const int KT, LdW ldw, LdX ldx, char* lds, const int tid) {
  constexpr int WGM = 4 / WGN;
  constexpr int WROWS = WGN * 32 * INS, XROWS = WGM * 32 * IMS, NROWS = WROWS + XROWS, NCH = NROWS / 32, NCHW = WROWS / 32, BUFB = NROWS * 144;
  const int lane = tid & 63, wid = tid >> 6, l31 = lane & 31, hi = lane >> 5;
  const int wn = (WGN == 2) ? (wid >> 1) : wid, wm = (WGN == 2) ? (wid & 1) : 0;
  const int offa = (wn * 32 * INS + l31) * 144 + hi * 16;
  const int offb = (WROWS + wm * 32 * IMS + l31) * 144 + hi * 16;
#pragma unroll
  for (int a = 0; a < INS; ++a)
#pragma unroll
    for (int b = 0; b < IMS; ++b)
#pragma unroll
      for (int r = 0; r < 16; ++r) acc[a][b][r] = 0.f;
#define GLOAD(dst, kt_) _Pragma("unroll") for (int i = 0; i < NCH; ++i) { dst[i] = (i < NCHW) ? ldw(i, tid >> 3, (kt_) * 64 + (tid & 7) * 8) : ldx(i - NCHW, tid >> 3, (kt_) * 64 + (tid & 7) * 8); }
#define LSTORE(src, base) _Pragma("unroll") for (int i = 0; i < NCH; ++i) { const int c = tid + 256 * i; *(u32x4*)((base) + (c >> 3) * 144 + (c & 7) * 16) = src[i]; }
#define COMPUTE_PIPE(buf) { const char* pa = (buf) + offa; const char* pb = (buf) + offb; \
    bf16x8 fa[2][INS], fb[2][IMS]; \
    _Pragma("unroll") for (int in = 0; in < INS; ++in) fa[0][in] = *(const bf16x8*)(pa + in * 32 * 144); \
    _Pragma("unroll") for (int im = 0; im < IMS; ++im) fb[0][im] = *(const bf16x8*)(pb + im * 32 * 144); \
    _Pragma("unroll") for (int s = 0; s < 4; ++s) { \
      if (s < 3) { _Pragma("unroll") for (int in = 0; in < INS; ++in) fa[(s + 1) & 1][in] = *(const bf16x8*)(pa + in * 32 * 144 + (s + 1) * 32); \
        _Pragma("unroll") for (int im = 0; im < IMS; ++im) fb[(s + 1) & 1][im] = *(const bf16x8*)(pb + im * 32 * 144 + (s + 1) * 32); } \
      _Pragma("unroll") for (int im = 0; im < IMS; ++im) _Pragma("unroll") for (int in = 0; in < INS; ++in) \
        acc[in][im] = MFMA(fa[s & 1][in], fb[s & 1][im], acc[in][im]); } }
#define COMPUTE_FLAT(buf) { const char* pa = (buf) + offa; const char* pb = (buf) + offb; \
    _Pragma("unroll") for (int s = 0; s < 4; ++s) { \
      bf16x8 fa[INS], fb[IMS]; \
      _Pragma("unroll") for (int in = 0; in < INS; ++in) fa[in] = *(const bf16x8*)(pa + in * 32 * 144 + s * 32); \
      _Pragma("unroll") for (int im = 0; im < IMS; ++im) fb[im] = *(const bf16x8*)(pb + im * 32 * 144 + s * 32); \
      _Pragma("unroll") for (int im = 0; im < IMS; ++im) _Pragma("unroll") for (int in = 0; in < INS; ++in) \
        acc[in][im] = MFMA(fa[in], fb[im], acc[in][im]); } }
  if (DB) {
    u32x4 preA[NCH], preB[NCH];
    GLOAD(preA, 0)
    GLOAD(preB, 1)
    __syncthreads();
    LSTORE(preA, lds)
    __syncthreads();
    for (int kt = 0; kt < KT; kt += 2) {
      if (kt + 2 < KT) { GLOAD(preA, kt + 2) }
      COMPUTE_PIPE(lds)
      LSTORE(preB, lds + BUFB)
      __syncthreads();
      if (kt + 3 < KT) { GLOAD(preB, kt + 3) }
      COMPUTE_PIPE(lds + BUFB)
      if (kt + 2 < KT) { LSTORE(preA, lds) }
      __syncthreads();
    }
  } else {
    u32x4 pre[NCH];
    GLOAD(pre, 0)
    for (int kt = 0; kt < KT; ++kt) {
      __syncthreads();
      LSTORE(pre, lds)
      __syncthreads();
      if (kt + 1 < KT) { GLOAD(pre, kt + 1) }
      if (INS >= 4) COMPUTE_FLAT(lds) else COMPUTE_PIPE(lds)
    }
  }
#undef GLOAD
#undef LSTORE
#undef COMPUTE_PIPE
#undef COMPUTE_FLAT
}

constexpr float M_INIT = -1e29f;
template <class MaskF>
DI void attn_tile(const int tid, const char* ldsK, const char* ldsV, const bf16x8 (&qr)[4], f32x16 (&o)[2], float& m, float& l, const bool MASKED, MaskF mask) {
  const int lane = tid & 63, l31 = lane & 31, hi = lane >> 5;
  f32x16 p0, p1;
#pragma unroll
  for (int r = 0; r < 16; ++r) { p0[r] = 0.f; p1[r] = 0.f; }
  const char* kp = ldsK + l31 * 144 + hi * 16;
#pragma unroll
  for (int s = 0; s < 4; ++s) {
    const bf16x8 k0 = *(const bf16x8*)(kp + s * 32), k1 = *(const bf16x8*)(kp + 32 * 144 + s * 32);
    p0 = MFMA(k0, qr[s], p0); p1 = MFMA(k1, qr[s], p1);
  }
  if (MASKED) {
#pragma unroll
    for (int r = 0; r < 16; ++r) {
      const int kr = crow(r, hi);
      p0[r] = mask(kr) ? p0[r] : NEGB; p1[r] = mask(kr + 32) ? p1[r] : NEGB;
    }
  }
  const char* vb = ldsV + (4 * hi + ((lane & 15) >> 2)) * 144 + ((lane >> 4) & 1) * 32 + (lane & 3) * 8;
  s16x4 vlo[8], vhi[8];
#pragma unroll
  for (int s4 = 0; s4 < 4; ++s4)
#pragma unroll
    for (int db = 0; db < 2; ++db) { vlo[s4 * 2 + db] = trread(vb + (16 * s4) * 144 + db * 64); vhi[s4 * 2 + db] = trread(vb + (16 * s4 + 8) * 144 + db * 64); }
  __builtin_amdgcn_sched_barrier(0);
  float mx = fmaxf(p0[0], p1[0]);
#pragma unroll
  for (int r = 1; r < 16; ++r) mx = fmaxf(fmaxf(mx, p0[r]), p1[r]);
  { auto rr = __builtin_amdgcn_permlane32_swap(__float_as_uint(mx), __float_as_uint(mx), false, false); mx = fmaxf(__uint_as_float(rr[0]), __uint_as_float(rr[1])); }
  const float mxs = mx * C2;
  if (__any(mxs > m + 8.f)) {
    const float mn = fmaxf(m, mxs), alpha = ex2(m - mn);
    m = mn; l *= alpha;
#pragma unroll
    for (int r = 0; r < 16; ++r) { o[0][r] *= alpha; o[1][r] *= alpha; }
  }
  const float nm = -m;
  float rs = 0.f;
#pragma unroll
  for (int r = 0; r < 16; ++r) { p0[r] = ex2(__builtin_fmaf(p0[r], C2, nm)); p1[r] = ex2(__builtin_fmaf(p1[r], C2, nm)); rs += p0[r] + p1[r]; }
  l += rs;
  bf16x8 pw[4];
  pw[0] = pack8(p0, 0); pw[1] = pack8(p0, 1); pw[2] = pack8(p1, 0); pw[3] = pack8(p1, 1);
#pragma unroll
  for (int s4 = 0; s4 < 4; ++s4) {
#pragma unroll
    for (int db = 0; db < 2; ++db) {
      const s16x4 lo = vlo[s4 * 2 + db], hh = vhi[s4 * 2 + db];
      const bf16x8 vf = {lo[0], lo[1], lo[2], lo[3], hh[0], hh[1], hh[2], hh[3]};
      o[db] = MFMA(vf, pw[s4], o[db]);
    }
  }
}

template <class RowF>
DI void kv_load(const int tid, u32x4 (&pre)[4], RowF rowtok, const u16* proj, int kcol, int vcol) {
#pragma unroll
  for (int i = 0; i < 2; ++i) {
    const int c = tid + 256 * i, row = c >> 3, ch = c & 7;
    const u16* p = proj + (size_t)rowtok(row) * NP + ch * 8;
    pre[i] = *(const u32x4*)(p + kcol); pre[2 + i] = *(const u32x4*)(p + vcol);
  }
}
DI void kv_store(const int tid, const u32x4 (&pre)[4], char* ldsK, char* ldsV) {
#pragma unroll
  for (int i = 0; i < 2; ++i) {
    const int c = tid + 256 * i, row = c >> 3, ch = c & 7;
    *(u32x4*)(ldsK + row * 144 + ch * 16) = pre[i]; *(u32x4*)(ldsV + row * 144 + ch * 16) = pre[2 + i];
  }
}

template <class RowF, class FullF, class MaskF>
DI void attn_stream(const int tid, const u16* proj, const int kcol, const int vcol, const int nt, RowF rowtok, FullF full, MaskF mask,
                    const bf16x8 (&qr)[4], f32x16 (&o)[2], float& m, float& l, char* lds) {
  u32x4 preA[4], preB[4];
  if (nt > 0) kv_load(tid, preA, [&](int row) { return rowtok(0, row); }, proj, kcol, vcol);
  if (nt > 1) kv_load(tid, preB, [&](int row) { return rowtok(1, row); }, proj, kcol, vcol);
  for (int ti = 0; ti < nt; ti += 2) {
    kv_store(tid, preA, lds, lds + 9216);
    __syncthreads();
    if (ti + 2 < nt) kv_load(tid, preA, [&](int row) { return rowtok(ti + 2, row); }, proj, kcol, vcol);
    attn_tile(tid, lds, lds + 9216, qr, o, m, l, !full(ti), [&](int kr) { return mask(ti, kr); });
    if (ti + 1 < nt) {
      kv_store(tid, preB, lds + 18432, lds + 27648);
      __syncthreads();
      if (ti + 3 < nt) kv_load(tid, preB, [&](int row) { return rowtok(ti + 3, row); }, proj, kcol, vcol);
      attn_tile(tid, lds + 18432, lds + 27648, qr, o, m, l, !full(ti + 1), [&](int kr) { return mask(ti + 1, kr); });
    }
  }
}

DI int mapcol(int n, int mode) {
  if (mode == 0) return n;
  if (n < 640) return n;
  if (n < 3200) return n + 12;
  if (n < 3212) return n - 3200 + 640;
  return -1;
}
DI void tr_tile(const float* src, int ldsrc, u16* dst, int ldd, int k0, int n0, const float* g, int mode, char* lds) {
  float* t = (float*)lds;
  const int tid = threadIdx.x;
  float v[16];
#pragma unroll
  for (int i = 0; i < 16; ++i) {
    const int e = tid + 256 * i, kk = e >> 6, nn = e & 63;
    const int sc = mapcol(n0 + nn, mode);
    v[i] = sc >= 0 ? src[(size_t)(k0 + kk) * ldsrc + sc] : 0.f;
  }
  if (g) {
#pragma unroll
    for (int i = 0; i < 16; ++i) v[i] *= g[k0 + ((tid + 256 * i) >> 6)];
  }
#pragma unroll
  for (int i = 0; i < 16; ++i) { const int e = tid + 256 * i, kk = e >> 6, nn = e & 63; t[kk * 65 + nn] = v[i]; }
  __syncthreads();
#pragma unroll
  for (int i = 0; i < 2; ++i) {
    const int e = tid + 256 * i, nn = e >> 3, k8 = (e & 7) * 8;
    u32x4 o;
    o[0] = pk2(t[(k8 + 0) * 65 + nn], t[(k8 + 1) * 65 + nn]); o[1] = pk2(t[(k8 + 2) * 65 + nn], t[(k8 + 3) * 65 + nn]);
    o[2] = pk2(t[(k8 + 4) * 65 + nn], t[(k8 + 5) * 65 + nn]); o[3] = pk2(t[(k8 + 6) * 65 + nn], t[(k8 + 7) * 65 + nn]);
    *(u32x4*)(dst + (size_t)(n0 + nn) * ldd + k0 + k8) = o;
  }
  __syncthreads();
}

template <int NR>
DI void rows_convert(const float* x0, u16* xb0, float* rn0) {
  const int lane = tidx() & 63;
  f32x4 v[NR][4];
#pragma unroll
  for (int r = 0; r < NR; ++r)
#pragma unroll
    for (int i = 0; i < 4; ++i) v[r][i] = *(const f32x4*)(x0 + (size_t)r * 1024 + i * 256 + lane * 4);
#pragma unroll
  for (int r = 0; r < NR; ++r) {
    float ss = 0.f;
#pragma unroll
    for (int i = 0; i < 4; ++i) {
      ss += v[r][i][0] * v[r][i][0] + v[r][i][1] * v[r][i][1] + v[r][i][2] * v[r][i][2] + v[r][i][3] * v[r][i][3];
      u32x2 o; o[0] = pk2(v[r][i][0], v[r][i][1]); o[1] = pk2(v[r][i][2], v[r][i][3]);
      *(u32x2*)(xb0 + (size_t)r * 1024 + i * 256 + lane * 4) = o;
    }
    ss = wave_sum(ss);
    if (lane == 0) rn0[r] = rsqrtf(ss * (1.f / 1024.f) + 1e-6f);
  }
}

template <int NTW>
DI void inproj_tile(const Params& p, int l, int mt, int ntile, char* lds) {
  char* const ws_ = opq(p.ws);
  const u16* W = (const u16*)(ws_ + OFF_WIN) + ((size_t)l * NP + ntile * 64 * NTW) * 1024;
  const u16* X = (const u16*)(ws_ + OFF_XB) + (size_t)mt * 128 * 1024;
  f32x16 acc[NTW][2];
  const int tid = tidx();
  gemm_core<2, NTW, 2, (NTW == 2)>(acc, 16, [&](int i, int r0, int k) -> u32x4 { return *(const u32x4*)((W + i * 32768) + (unsigned)(r0 * 1024 + k)); },
               [&](int i, int r0, int k) -> u32x4 { return *(const u32x4*)((X + i * 32768) + (unsigned)(r0 * 1024 + k)); }, lds, tid);
  const int lane = tid & 63, wid = tid >> 6, l31 = lane & 31, hi = lane >> 5, wn = wid >> 1, wm = wid & 1;
  const float* rn = (const float*)(ws_ + OFF_RN);
  u16* proj = (u16*)(ws_ + OFF_PROJ);
  constexpr int NCOLS = 64 * NTW, RS = NCOLS * 2 + 16;
  __syncthreads();
#pragma unroll
  for (int im = 0; im < 2; ++im) {
    const int tl = wm * 64 + im * 32 + l31;
    const float r = rn[(size_t)mt * 128 + tl];
#pragma unroll
    for (int in = 0; in < NTW; ++in)
#pragma unroll
      for (int g = 0; g < 4; ++g) {
        const int n = wn * 32 * NTW + in * 32 + 8 * g + 4 * hi;
        u32x2 o; o[0] = pk2(acc[in][im][4 * g] * r, acc[in][im][4 * g + 1] * r); o[1] = pk2(acc[in][im][4 * g + 2] * r, acc[in][im][4 * g + 3] * r);
        *(u32x2*)(lds + tl * RS + n * 2) = o;
      }
  }
  __syncthreads();
#pragma unroll 4
  for (int i = 0; i < NCOLS / 16; ++i) {
    const int c = tid + 256 * i, tl = c / (NCOLS / 8), ch = c % (NCOLS / 8);
    const u32x4 v = *(const u32x4*)(lds + tl * RS + ch * 16);
    *(u32x4*)(proj + ((size_t)mt * 128 + tl) * NP + ntile * NCOLS + ch * 8) = v;
  }
}

DI void outproj_item(const Params& p, int l, int it, char* lds) {
  char* const ws_ = opq(p.ws);
  const int mt = (it & 7) * 16 + ((it >> 3) & 15), nt = it >> 7;
  const u16* W = (const u16*)(ws_ + OFF_WOUT) + ((size_t)l * 1024 + nt * 256) * 1024;
  const u16* Y = (const u16*)(ws_ + OFF_XB) + (size_t)mt * 128 * 1024;
  f32x16 acc[4][2];
  const int tid = tidx();
  gemm_core<2, 4, 2, false>(acc, 16, [&](int i, int r0, int k) -> u32x4 { return *(const u32x4*)((W + i * 32768) + (unsigned)(r0 * 1024 + k)); },
               [&](int i, int r0, int k) -> u32x4 { return *(const u32x4*)((Y + i * 32768) + (unsigned)(r0 * 1024 + k)); }, lds, tid);
  const int lane = tid & 63, wid = tid >> 6, l31 = lane & 31, hi = lane >> 5, wn = wid >> 1, wm = wid & 1;
  u16* outb = (u16*)(ws_ + OFF_OUTB);
  float* ssq = (float*)(ws_ + OFF_SSQ);
  constexpr int RS = 256 * 2 + 16;
  __syncthreads();
#pragma unroll
  for (int im = 0; im < 2; ++im) {
    const int tl = wm * 64 + im * 32 + l31;
    float ss = 0.f;
#pragma unroll
    for (int in = 0; in < 4; ++in)
#pragma unroll
      for (int g = 0; g < 4; ++g) {
        const int n = wn * 128 + in * 32 + 8 * g + 4 * hi;
        const float o0 = acc[in][im][4 * g], o1 = acc[in][im][4 * g + 1], o2 = acc[in][im][4 * g + 2], o3 = acc[in][im][4 * g + 3];
        ss += o0 * o0 + o1 * o1 + o2 * o2 + o3 * o3;
        u32x2 v; v[0] = pk2(o0, o1); v[1] = pk2(o2, o3);
        *(u32x2*)(lds + tl * RS + n * 2) = v;
      }
    ss += __shfl_xor(ss, 32, 64);
    if (hi == 0) ssq[((size_t)mt * 128 + tl) * 16 + nt * 2 + wn] = ss;
  }
  __syncthreads();
#pragma unroll 4
  for (int i = 0; i < 16; ++i) {
    const int c = tid + 256 * i, tl = c >> 5, ch = c & 31;
    const u32x4 v = *(const u32x4*)(lds + tl * RS + ch * 16);
    *(u32x4*)(outb + ((size_t)mt * 128 + tl) * 1024 + nt * 256 + ch * 8) = v;
  }
}

template <int NR>
DI void resid_rows(const Params& p, int l, int row0, const float* xin) {
  char* const ws_ = opq(p.ws);
  const int lane = tidx() & 63;
  const u16* outb = (const u16*)(ws_ + OFF_OUTB);
  const float* ssq = (const float*)(ws_ + OFF_SSQ);
  u32x2 ob[NR][4]; f32x4 xv[NR][4]; f32x4 sq[NR][2];
#pragma unroll
  for (int r = 0; r < NR; ++r) {
    const size_t row = (size_t)(row0 + r);
    sq[r][0] = *(const f32x4*)(ssq + row * 16); sq[r][1] = *(const f32x4*)(ssq + row * 16 + 4);
#pragma unroll
    for (int i = 0; i < 4; ++i) { const int idx = i * 256 + lane * 4; ob[r][i] = *(const u32x2*)(outb + row * 1024 + idx); xv[r][i] = *(const f32x4*)(xin + row * 1024 + idx); }
  }
  f32x4 gq[4];
#pragma unroll
  for (int i = 0; i < 4; ++i) gq[i] = *(const f32x4*)(p.g_post + l * 1024 + i * 256 + lane * 4);
  u16* xb = (u16*)(ws_ + OFF_XB);
#pragma unroll
  for (int r = 0; r < NR; ++r) {
    const size_t row = (size_t)(row0 + r);
    const float ss = ((sq[r][0][0] + sq[r][0][1]) + (sq[r][0][2] + sq[r][0][3])) + ((sq[r][1][0] + sq[r][1][1]) + (sq[r][1][2] + sq[r][1][3]));
    const float r2 = rsqrtf(ss * (1.f / 1024.f) + 1e-6f);
    float s2 = 0.f;
#pragma unroll
    for (int i = 0; i < 4; ++i) {
      const int idx = i * 256 + lane * 4;
      const f32x4 o = {lo16(ob[r][i][0]), hi16(ob[r][i][0]), lo16(ob[r][i][1]), hi16(ob[r][i][1])};
      f32x4 xn;
#pragma unroll
      for (int e = 0; e < 4; ++e) { xn[e] = xv[r][i][e] + o[e] * r2 * gq[i][e]; s2 += xn[e] * xn[e]; }
      *(f32x4*)(p.out + row * 1024 + idx) = xn;
      if (l < 3) { u32x2 o2; o2[0] = pk2(xn[0], xn[1]); o2[1] = pk2(xn[2], xn[3]); *(u32x2*)(xb + row * 1024 + idx) = o2; }
    }
    s2 = wave_sum(s2);
    if (lane == 0) ((float*)(ws_ + OFF_RN))[row] = rsqrtf(s2 * (1.f / 1024.f) + 1e-6f);
  }
}

DI void cmp_item(const Params& p, int l, int it, char* lds) {
  char* const ws_ = opq(p.ws);
  const int j = it >> 5, mt = (it & 7) * 4 + ((it >> 3) & 3);
  const u16* proj = (const u16*)(ws_ + OFF_PROJ);
  const u16* W1 = (const u16*)(ws_ + OFF_W1) + (size_t)(l * 2 + j) * 256 * 2048;
  const u16* W2 = (const u16*)(ws_ + OFF_W2) + (size_t)(l * 2 + j) * 64 * 256;
  const float* pe = p.pe_cmp + (size_t)(l * 2 + j) * 32 * 64;
  const int kvcol = C_KCMP + 64 * j;
  f32x16 acc[2][1];
  const int tid = tidx();
  gemm_core<4, 2, 1, false>(acc, 32, [&](int i, int r0, int k) -> u32x4 { return *(const u32x4*)((W1 + i * 65536) + (unsigned)(r0 * 2048 + k)); },
   [&](int i, int row, int k) -> u32x4 {
    const int rr = mt * 32 + row, b = rr >> 7; int n = rr & 127; if (n > 126) n = 126;
    const int l32 = k >> 6, d = k & 63;
    const u32x4 raw = *(const u32x4*)(proj + ((size_t)b * S_ + 16 * n + l32) * NP + kvcol + d);
    const f32x4 e0 = *(const f32x4*)(pe + l32 * 64 + d), e1 = *(const f32x4*)(pe + l32 * 64 + d + 4);
    u32x4 o;
    o[0] = pk2(lo16(raw[0]) + e0[0], hi16(raw[0]) + e0[1]); o[1] = pk2(lo16(raw[1]) + e0[2], hi16(raw[1]) + e0[3]);
    o[2] = pk2(lo16(raw[2]) + e1[0], hi16(raw[2]) + e1[1]); o[3] = pk2(lo16(raw[3]) + e1[2], hi16(raw[3]) + e1[3]);
    return o; }, lds, tid);
  const int lane = tid & 63, wid = tid >> 6, l31 = lane & 31, hi = lane >> 5;
#pragma unroll
  for (int a = 0; a < 2; ++a)
#pragma unroll
    for (int r = 0; r < 16; ++r) {
      const float x = acc[a][0][r]; const float u = 0.7978845608028654f * (x + 0.044715f * x * x * x);
      acc[a][0][r] = x / (1.f + __expf(-2.f * u));
    }
  f32x16 c2[2];
#pragma unroll
  for (int r = 0; r < 16; ++r) { c2[0][r] = 0.f; c2[1][r] = 0.f; }
#pragma unroll
  for (int in = 0; in < 2; ++in)
#pragma unroll
    for (int s2 = 0; s2 < 2; ++s2) {
      const bf16x8 h0 = pack8(acc[in][0], s2);
#pragma unroll
      for (int dt = 0; dt < 2; ++dt) {
        const u16* wp = W2 + (size_t)(dt * 32 + l31) * 256 + wid * 64 + in * 32 + 16 * s2 + 4 * hi;
        const s16x4 lo = *(const s16x4*)wp, hh = *(const s16x4*)(wp + 8);
        const bf16x8 wf = {lo[0], lo[1], lo[2], lo[3], hh[0], hh[1], hh[2], hh[3]};
        c2[dt] = MFMA(wf, h0, c2[dt]);
      }
    }
  float* red = (float*)lds;
  __syncthreads();
  for (int w = 0; w < 4; ++w) {
    if (wid == w) {
#pragma unroll
      for (int dt = 0; dt < 2; ++dt)
#pragma unroll
        for (int r = 0; r < 16; ++r) {
          float* q = red + (dt * 32 + crow(r, hi)) * 32 + l31;
          if (w == 0) *q = c2[dt][r]; else *q += c2[dt][r];
        }
    }
    __syncthreads();
  }
  u16* kc = (u16*)(ws_ + OFF_KC); u16* vct = (u16*)(ws_ + OFF_VCT);
#pragma unroll 4
  for (int i = 0; i < 8; ++i) {
    const int e = tid + 256 * i;
    if (j == 0) { const int tok = e >> 6, d = e & 63; const int rr = mt * 32 + tok; kc[(size_t)rr * 64 + d] = f2bf(red[d * 32 + tok]); }
    else { const int d = e >> 5, tok = e & 31; const int rr = mt * 32 + tok, b = rr >> 7, n = rr & 127; vct[((size_t)b * 64 + d) * 128 + n] = f2bf(red[d * 32 + tok]); }
  }
  __syncthreads();
}

DI void win_item(const Params& p, int it, char* lds) {
  char* const ws_ = opq(p.ws);
  const int b = it & 7, qt = it >> 3, q0 = qt * 32;
  const int tid = tidx(), lane = tid & 63, h = tid >> 6, l31 = lane & 31, hi = lane >> 5;
  const u16* proj = (const u16*)(ws_ + OFF_PROJ);
  const int t = q0 + l31; const size_t tok = (size_t)b * S_ + t;
  bf16x8 qr[4];
#pragma unroll
  for (int s = 0; s < 4; ++s) qr[s] = *(const bf16x8*)(proj + tok * NP + C_AQ + h * 64 + 16 * s + 8 * hi);
  char* ldsK = lds; char* ldsV = lds + 9216;
  f32x16 o[2];
#pragma unroll
  for (int r = 0; r < 16; ++r) { o[0][r] = 0.f; o[1][r] = 0.f; }
  float m = M_INIT, lsum = 0.f;
  const int klo = (q0 - 511 > 0 ? q0 - 511 : 0) >> 6, khi = (q0 + 31) >> 6;
  __syncthreads();
  attn_stream(tid, proj, C_KWIN, C_VWIN, khi - klo + 1,
              [&](int ti, int row) { return b * S_ + (klo + ti) * 64 + row; },
              [&](int ti) { const int k0 = (klo + ti) * 64; return (k0 + 63 <= q0) && (k0 >= q0 + 31 - 511); },
              [&](int ti, int kr) { return (unsigned)(t - ((klo + ti) * 64 + kr)) <= 511u; },
              qr, o, m, lsum, lds);
  lsum += __shfl_xor(lsum, 32, 64);
  const float il = 1.f / lsum;
  u16* ow = (u16*)(ws_ + OFF_OWIN);
#pragma unroll
  for (int db = 0; db < 2; ++db)
#pragma unroll
    for (int g = 0; g < 4; ++g) {
      const int d0 = 32 * db + 8 * g + 4 * hi;
      u32x2 v; v[0] = pk2(o[db][4 * g] * il, o[db][4 * g + 1] * il); v[1] = pk2(o[db][4 * g + 2] * il, o[db][4 * g + 3] * il);
      *(u32x2*)(ow + tok * 256 + h * 64 + d0) = v;
    }
}

DI void dil_item(const Params& p, int it, char* lds) {
  char* const ws_ = opq(p.ws);
  const int di = it >> 9, rem = it & 511, b = rem & 7, h = (rem >> 3) & 3, c = rem >> 5;
  const int sh = 2 * di, dil = 1 << sh;
  const int tpr = 16 >> sh;
  const int r = c / tpr, mt = c % tpr, m0 = mt * 128;
  const int tid = tidx(), lane = tid & 63, wid = tid >> 6, l31 = lane & 31, hi = lane >> 5;
  const u16* proj = (const u16*)(ws_ + OFF_PROJ);
  const int mq = m0 + 32 * wid + l31;
  const size_t tok = (size_t)b * S_ + mq * dil + r;
  bf16x8 qr[4];
#pragma unroll
  for (int s = 0; s < 4; ++s) qr[s] = *(const bf16x8*)(proj + tok * NP + C_BQ + h * 64 + 16 * s + 8 * hi);
  const int tt0 = (m0 == 0) ? 2 : 0;
  {
    u32x4 pre[4][4];
#pragma unroll
    for (int tt = 0; tt < 4; ++tt)
      if (tt >= tt0) kv_load(tid, pre[tt], [&](int row) { return b * S_ + (m0 - 128 + 64 * tt + row) * dil + r; }, proj, C_BK + h * 64, C_BV + h * 64);
    __syncthreads();
#pragma unroll
    for (int tt = 0; tt < 4; ++tt)
      if (tt >= tt0) kv_store(tid, pre[tt], lds + tt * 18432, lds + tt * 18432 + 9216);
    __syncthreads();
  }
  f32x16 o[2];
#pragma unroll
  for (int rr = 0; rr < 16; ++rr) { o[0][rr] = 0.f; o[1][rr] = 0.f; }
  float m = M_INIT, lsum = 0.f;
  const int widu = __builtin_amdgcn_readfirstlane(wid);
  const int wlo = m0 + 32 * widu - 128, whi = m0 + 32 * widu + 31;
  for (int tt = tt0; tt < 4; ++tt) {
    const int tk0 = m0 - 128 + 64 * tt;
    if (tk0 + 63 >= wlo && tk0 <= whi) {
      attn_tile(tid, lds + tt * 18432, lds + tt * 18432 + 9216, qr, o, m, lsum, !(tk0 + 63 <= wlo + 128 && tk0 >= whi - 128), [&](int kr) { return (unsigned)(mq - (tk0 + kr)) <= 128u; });
    }
  }
  lsum += __shfl_xor(lsum, 32, 64);
  const float il = 1.f / lsum;
  u16* od = (u16*)(ws_ + OFF_ODIL) + (size_t)di * T_ * 256;
#pragma unroll
  for (int db = 0; db < 2; ++db)
#pragma unroll
    for (int g = 0; g < 4; ++g) {
      const int d0 = 32 * db + 8 * g + 4 * hi;
      u32x2 v; v[0] = pk2(o[db][4 * g] * il, o[db][4 * g + 1] * il); v[1] = pk2(o[db][4 * g + 2] * il, o[db][4 * g + 3] * il);
      *(u32x2*)(od + tok * 256 + h * 64 + d0) = v;
    }
  if (hi == 0) ((float*)(ws_ + OFF_LSE))[((size_t)di * T_ + tok) * 4 + h] = m * 0.6931471805599453f + __logf(lsum);
}

DI void pool_item(const Params& p, int l, int it, char* lds) {
  char* const ws_ = opq(p.ws);
  const int b = it & 7, qt = it >> 3, q0 = qt * 32;
  const int tid = tidx(), lane = tid & 63, g = tid >> 6, l31 = lane & 31, hi = lane >> 5;
  const u16* proj = (const u16*)(ws_ + OFF_PROJ);
  u16* cin = (u16*)lds;
  char* pl = lds + 48 * 512;
  u32x4 cv[6];
#pragma unroll
  for (int i = 0; i < 6; ++i) {
    const int c = tid + 256 * i, row = c >> 5, ch = c & 31; const int t = q0 - 16 + row;
    cv[i] = u32x4{0u, 0u, 0u, 0u};
    if (t >= 0) cv[i] = *(const u32x4*)(proj + ((size_t)b * S_ + t) * NP + C_CIN + ch * 8);
  }
  const u16* wpt = (const u16*)(ws_ + OFF_WPT) + (size_t)(l * 4 + g) * 4096;
  bf16x8 af[8];
#pragma unroll
  for (int q = 0; q < 8; ++q) af[q] = *(const bf16x8*)(wpt + ((q & 1) * 32 + l31) * 64 + 16 * (q >> 1) + 8 * hi);
  const size_t tok = (size_t)b * S_ + q0 + l31;
  f32x4 psv[8]; u32x2 zv[8];
#pragma unroll
  for (int q = 0; q < 8; ++q) {
    const int col = g * 64 + (q >> 2) * 32 + 8 * (q & 3) + 4 * hi;
    psv[q] = *(const f32x4*)(p.pool_scale + l * 256 + col); zv[q] = *(const u32x2*)(proj + tok * NP + C_CZ + col);
  }
  __syncthreads();
#pragma unroll
  for (int i = 0; i < 6; ++i) { const int c = tid + 256 * i, row = c >> 5, ch = c & 31; *(u32x4*)(cin + row * 256 + ch * 8) = cv[i]; }
  __syncthreads();
  {
    const int ch = tid, w = 2 << g;
    float s = 0.f;
    for (int r = 17 - w; r <= 16; ++r) s += bf2f(cin[r * 256 + ch]);
#pragma unroll 4
    for (int i = 0; i < 32; ++i) {
      const int t = q0 + i; const int cnt = (t + 1 < w) ? t + 1 : w;
      const float self = bf2f(cin[(i + 16) * 256 + ch]);
      *(u16*)(pl + i * 528 + ch * 2) = f2bf(s / (float)cnt - self);
      s += bf2f(cin[(i + 17) * 256 + ch]) - bf2f(cin[(i + 17 - w) * 256 + ch]);
    }
  }
  __syncthreads();
  f32x16 acc[2];
#pragma unroll
  for (int r = 0; r < 16; ++r) { acc[0][r] = 0.f; acc[1][r] = 0.f; }
#pragma unroll
  for (int s4 = 0; s4 < 4; ++s4) {
    const bf16x8 bf = *(const bf16x8*)(pl + l31 * 528 + (g * 64 + 16 * s4 + 8 * hi) * 2);
#pragma unroll
    for (int dt = 0; dt < 2; ++dt) acc[dt] = MFMA(af[s4 * 2 + dt], bf, acc[dt]);
  }
  u16* y = (u16*)(ws_ + OFF_XB);
#pragma unroll
  for (int dt = 0; dt < 2; ++dt)
#pragma unroll
    for (int g4 = 0; g4 < 4; ++g4) {
      const int col = g * 64 + dt * 32 + 8 * g4 + 4 * hi;
      const f32x4 ps = psv[dt * 4 + g4];
      const u32x2 z = zv[dt * 4 + g4];
      u32x2 v;
      v[0] = pk2(acc[dt][4 * g4] * ps[0] * siluf_(lo16(z[0])), acc[dt][4 * g4 + 1] * ps[1] * siluf_(hi16(z[0])));
      v[1] = pk2(acc[dt][4 * g4 + 2] * ps[2] * siluf_(lo16(z[1])), acc[dt][4 * g4 + 3] * ps[3] * siluf_(hi16(z[1])));
      *(u32x2*)(y + tok * 1024 + 512 + col) = v;
    }
}

DI void sgu_item(const Params& p, int l, int it, char* lds) {
  char* const ws_ = opq(p.ws);
  const int b = it & 7, c = (it >> 5) & 15, g = (it >> 3) & 3, t0 = c * 128;
  const int tid = tidx(), lane = tid & 63, l31 = lane & 31, hi = lane >> 5;
  const int wid = __builtin_amdgcn_readfirstlane(tid >> 6);
  const u16* proj = (const u16*)(ws_ + OFF_PROJ);
  char* vn = lds;
  __syncthreads();
  {
    const int j = tid >> 1, half = tid & 1;
    const u16* vp = proj + ((size_t)b * S_ + t0 + j) * NP + C_DV + half * 128;
    u32x4 raw[16];
#pragma unroll
    for (int i = 0; i < 16; ++i) raw[i] = *(const u32x4*)(vp + i * 8);
    float s1 = 0.f;
#pragma unroll
    for (int i = 0; i < 16; ++i)
#pragma unroll
      for (int e = 0; e < 4; ++e) s1 += lo16(raw[i][e]) + hi16(raw[i][e]);
    s1 += __shfl_xor(s1, 1, 64);
    const float mu = s1 * (1.f / 256.f);
    float s2 = 0.f;
#pragma unroll
    for (int i = 0; i < 16; ++i)
#pragma unroll
      for (int e = 0; e < 4; ++e) { const float a = lo16(raw[i][e]) - mu, bb = hi16(raw[i][e]) - mu; s2 += a * a + bb * bb; }
    s2 += __shfl_xor(s2, 1, 64);
    const float rstd = rsqrtf(s2 * (1.f / 256.f) + 1e-5f);
    if (half == (g >> 1)) {
      const float* lg = p.sg_ln_g + l * 256 + g * 64; const float* lb = p.sg_ln_b + l * 256 + g * 64;
      auto emit = [&](const u32x4& r, int i) {
        const f32x4 g0 = *(const f32x4*)(lg + i * 8), g1 = *(const f32x4*)(lg + i * 8 + 4), b0 = *(const f32x4*)(lb + i * 8), b1 = *(const f32x4*)(lb + i * 8 + 4);
        u32x4 o;
        o[0] = pk2((lo16(r[0]) - mu) * rstd * g0[0] + b0[0], (hi16(r[0]) - mu) * rstd * g0[1] + b0[1]);
        o[1] = pk2((lo16(r[1]) - mu) * rstd * g0[2] + b0[2], (hi16(r[1]) - mu) * rstd * g0[3] + b0[3]);
        o[2] = pk2((lo16(r[2]) - mu) * rstd * g1[0] + b1[0], (hi16(r[2]) - mu) * rstd * g1[1] + b1[1]);
        o[3] = pk2((lo16(r[3]) - mu) * rstd * g1[2] + b1[2], (hi16(r[3]) - mu) * rstd * g1[3] + b1[3]);
        *(u32x4*)(vn + j * 144 + i * 16) = o;
      };
      if (g & 1) {
#pragma unroll
        for (int i = 0; i < 8; ++i) emit(raw[8 + i], i);
      } else {
#pragma unroll
        for (int i = 0; i < 8; ++i) emit(raw[i], i);
      }
    }
  }
  __syncthreads();
  const int i = wid * 32 + l31;
  const u16* wsp = (const u16*)(ws_ + OFF_WSP) + ((size_t)(l * 4 + g) * 128 + i) * 128;
  f32x16 acc[2];
#pragma unroll
  for (int r = 0; r < 16; ++r) { acc[0][r] = 0.f; acc[1][r] = 0.f; }
  const int nks = 2 * (wid + 1);
  bf16x8 wfr[8];
#pragma unroll
  for (int s = 0; s < 8; ++s) { if (s < nks) wfr[s] = *(const bf16x8*)(wsp + 16 * s + 8 * hi); else wfr[s] = bf16x8{0, 0, 0, 0, 0, 0, 0, 0}; }
  const char* vb = vn + (8 * hi + ((lane & 15) >> 2)) * 144 + ((lane >> 4) & 1) * 32 + (lane & 3) * 8;
#pragma unroll
  for (int s = 0; s < 8; ++s) {
    if (s < nks) {
#pragma unroll
      for (int ct = 0; ct < 2; ++ct) {
        const s16x4 lo = trread(vb + (16 * s) * 144 + ct * 64), hh = trread(vb + (16 * s + 4) * 144 + ct * 64);
        const bf16x8 af = {lo[0], lo[1], lo[2], lo[3], hh[0], hh[1], hh[2], hh[3]};
        acc[ct] = MFMA(af, wfr[s], acc[ct]);
      }
    }
  }
  const size_t tok = (size_t)b * S_ + t0 + i;
  const float bs = p.b_sp[(l * 4 + g) * 128 + i];
  u16* y = (u16*)(ws_ + OFF_XB);
#pragma unroll
  for (int ct = 0; ct < 2; ++ct)
#pragma unroll
    for (int g4 = 0; g4 < 4; ++g4) {
      const int col = g * 64 + ct * 32 + 8 * g4 + 4 * hi;
      const u32x2 u = *(const u32x2*)(proj + tok * NP + C_DU + col), z = *(const u32x2*)(proj + tok * NP + C_DZ + col);
      u32x2 v;
      v[0] = pk2(lo16(u[0]) * (acc[ct][4 * g4] + bs) * siluf_(lo16(z[0])), hi16(u[0]) * (acc[ct][4 * g4 + 1] + bs) * siluf_(hi16(z[0])));
      v[1] = pk2(lo16(u[1]) * (acc[ct][4 * g4 + 2] + bs) * siluf_(lo16(z[1])), hi16(u[1]) * (acc[ct][4 * g4 + 3] + bs) * siluf_(hi16(z[1])));
      *(u32x2*)(y + tok * 1024 + 768 + col) = v;
    }
}

DI void nsa_item(const Params& p, int it, char* lds) {
  char* const ws_ = opq(p.ws);
  const int b = it & 7, qt = 63 - (it >> 3), q0 = qt * 32;
  const int tid = tidx(), lane = tid & 63, h = tid >> 6, l31 = lane & 31, hi = lane >> 5;
  const u16* proj = (const u16*)(ws_ + OFF_PROJ);
  const int t = q0 + l31; const size_t tok = (size_t)b * S_ + t;
  bf16x8 qr[4];
#pragma unroll
  for (int s = 0; s < 4; ++s) qr[s] = *(const bf16x8*)(proj + tok * NP + C_AQ + h * 64 + 16 * s + 8 * hi);
  char* ldsK = lds; char* ldsV = lds + 9216;
  float* impS = (float*)(lds + 36864);
  float* vals = (float*)(lds + 36864 + 16384);
  unsigned* selm = (unsigned*)(lds + 73728 - 256);
  int* jlist = (int*)(lds + 73728 - 128);
  float* yst = (float*)(lds + 36864);
  __syncthreads();
  if (tid < 32) selm[tid] = 0u;
  const float g0 = sigmoidf_(bf2f(proj[tok * NP + C_AG + 0 + h])), g1 = sigmoidf_(bf2f(proj[tok * NP + C_AG + 4 + h])), g2 = sigmoidf_(bf2f(proj[tok * NP + C_AG + 8 + h]));
  f32x16 ya[2];
  {
    const u16* kc = (const u16*)(ws_ + OFF_KC); const u16* vct = (const u16*)(ws_ + OFF_VCT);
    f32x16 sc[4];
    const int nkb = (((q0 + 31 - 31) >> 4) >> 5) + 1;
#pragma unroll
    for (int kb = 0; kb < 4; ++kb) {
#pragma unroll
      for (int r = 0; r < 16; ++r) sc[kb][r] = 0.f;
      if (kb < nkb) {
#pragma unroll
        for (int s = 0; s < 4; ++s) {
          const bf16x8 kf = *(const bf16x8*)(kc + ((size_t)(b * 128 + kb * 32 + l31)) * 64 + 16 * s + 8 * hi);
          sc[kb] = MFMA(kf, qr[s], sc[kb]);
        }
      }
    }
    s16x4 vcl[16], vch[16];
#pragma unroll
    for (int q = 0; q < 16; ++q) {
      const int kb = q >> 2, s2 = (q >> 1) & 1, db = q & 1;
      const u16* vp = vct + ((size_t)(b * 64 + 32 * db + l31)) * 128 + 32 * kb + 16 * s2 + 4 * hi;
      vcl[q] = s16x4{0, 0, 0, 0}; vch[q] = s16x4{0, 0, 0, 0};
      if (kb < nkb) { vcl[q] = *(const s16x4*)vp; vch[q] = *(const s16x4*)(vp + 8); }
    }
    const int nv = (t >= 31) ? ((t - 31) >> 4) : -1;
    float mx = NEGB;
#pragma unroll
    for (int kb = 0; kb < 4; ++kb)
#pragma unroll
      for (int r = 0; r < 16; ++r) { const int n = 32 * kb + crow(r, hi); const float v = (n <= nv) ? sc[kb][r] * C2 : NEGB; sc[kb][r] = v; mx = fmaxf(mx, v); }
    mx = fmaxf(mx, __shfl_xor(mx, 32, 64));
    float sum = 0.f;
#pragma unroll
    for (int kb = 0; kb < 4; ++kb)
#pragma unroll
      for (int r = 0; r < 16; ++r) { const int n = 32 * kb + crow(r, hi); const float e = (n <= nv) ? ex2(sc[kb][r] - mx) : 0.f; sc[kb][r] = e; sum += e; }
    sum += __shfl_xor(sum, 32, 64);
    const float inv = sum > 0.f ? 1.f / sum : 0.f;
#pragma unroll
    for (int kb = 0; kb < 4; ++kb)
#pragma unroll
      for (int r = 0; r < 16; ++r) sc[kb][r] *= inv;
    float* myimp = impS + (h * 32 + l31) * 32;
#pragma unroll
    for (int kb = 0; kb < 4; ++kb)
#pragma unroll
      for (int g = 0; g < 4; ++g) myimp[8 * kb + 2 * g + hi] = ((sc[kb][4 * g] + sc[kb][4 * g + 1]) + sc[kb][4 * g + 2]) + sc[kb][4 * g + 3];
    __syncthreads();
#pragma unroll
    for (int kb = 0; kb < 4; ++kb)
#pragma unroll
      for (int g = 0; g < 4; ++g) { const int j1 = 8 * kb + 2 * g + hi + 1; if (j1 < 32) myimp[j1] += sc[kb][4 * g + 3]; }
    f32x16 oc[2];
#pragma unroll
    for (int r = 0; r < 16; ++r) { oc[0][r] = 0.f; oc[1][r] = 0.f; }
#pragma unroll
    for (int kb = 0; kb < 4; ++kb)
#pragma unroll
      for (int s2 = 0; s2 < 2; ++s2) {
        if (kb >= nkb) continue;
        const bf16x8 pf = pack8(sc[kb], s2);
#pragma unroll
        for (int db = 0; db < 2; ++db) {
          const s16x4 lo = vcl[(kb * 2 + s2) * 2 + db], hh = vch[(kb * 2 + s2) * 2 + db];
          const bf16x8 vf = {lo[0], lo[1], lo[2], lo[3], hh[0], hh[1], hh[2], hh[3]};
          oc[db] = MFMA(vf, pf, oc[db]);
        }
      }
#pragma unroll
    for (int r = 0; r < 16; ++r) { ya[0][r] = oc[0][r] * g0; ya[1][r] = oc[1][r] * g0; }
  }
  __syncthreads();
  const int cur = q0 >> 6;
  {
    const int q = tid >> 3, sub = tid & 7;
#pragma unroll
    for (int jj = 0; jj < 4; ++jj) {
      const int j = sub * 4 + jj;
      float v = ((impS[(0 * 32 + q) * 32 + j] + impS[(1 * 32 + q) * 32 + j]) + impS[(2 * 32 + q) * 32 + j]) + impS[(3 * 32 + q) * 32 + j];
      const bool forced = (j == 0) || (j == cur) || (j == cur - 1);
      v = forced ? 1e4f : ((j <= cur) ? v : -1e4f);
      vals[q * 32 + j] = v;
    }
    __syncthreads();
    f32x4 vv[8];
#pragma unroll
    for (int i = 0; i < 8; ++i) vv[i] = *(const f32x4*)(vals + q * 32 + i * 4);
    unsigned bits = 0u;
#pragma unroll
    for (int jj = 0; jj < 4; ++jj) {
      const int j = sub * 4 + jj; const float v = vals[q * 32 + j];
      int cnt = 0;
#pragma unroll
      for (int j2 = 0; j2 < 32; ++j2) { const float w = vv[j2 >> 2][j2 & 3]; cnt += ((w > v) || (w == v && j2 < j)) ? 1 : 0; }
      if (cnt < 16 && j <= cur) bits |= 1u << j;
    }
    if (bits) atomicOr(&selm[q], bits);
  }
  __syncthreads();
  const unsigned mymask = selm[l31];
  unsigned anym = mymask, allm = mymask;
#pragma unroll
  for (int o = 16; o >= 1; o >>= 1) { anym |= (unsigned)__shfl_xor((int)anym, o, 64); allm &= (unsigned)__shfl_xor((int)allm, o, 64); }
  anym = __builtin_amdgcn_readfirstlane(anym);
  allm = __builtin_amdgcn_readfirstlane(allm);
  if (tid < 32) { if ((anym >> tid) & 1u) jlist[__builtin_popcount(anym & ((1u << tid) - 1u))] = tid; }
  f32x16 o[2];
#pragma unroll
  for (int r = 0; r < 16; ++r) { o[0][r] = 0.f; o[1][r] = 0.f; }
  float m = M_INIT, lsum = 0.f;
#pragma unroll
  for (int r = 0; r < 16; ++r) { yst[r * 256 + tid] = ya[0][r]; yst[(16 + r) * 256 + tid] = ya[1][r]; }
  __syncthreads();
  attn_stream(tid, proj, C_KSLC, C_VSLC, __builtin_popcount(anym),
              [&](int ti, int row) { return b * S_ + jlist[ti] * 64 + row; },
              [&](int ti) { const int jb = jlist[ti]; return (jb < cur) && ((allm >> jb) & 1u); },
              [&](int ti, int kr) { const int jb = jlist[ti]; return ((mymask >> jb) & 1u) && (jb * 64 + kr <= t); },
              qr, o, m, lsum, lds);
#pragma unroll
  for (int r = 0; r < 16; ++r) { ya[0][r] = yst[r * 256 + tid]; ya[1][r] = yst[(16 + r) * 256 + tid]; }
  lsum += __shfl_xor(lsum, 32, 64);
  const float il = g1 / lsum;
  const u16* ow = (const u16*)(ws_ + OFF_OWIN);
  u16* y = (u16*)(ws_ + OFF_XB);
#pragma unroll
  for (int db = 0; db < 2; ++db)
#pragma unroll
    for (int g = 0; g < 4; ++g) {
      const int col = h * 64 + 32 * db + 8 * g + 4 * hi;
      const u32x2 w = *(const u32x2*)(ow + tok * 256 + col), az = *(const u32x2*)(proj + tok * NP + C_AZ + col);
      const float v0 = (ya[db][4 * g] + o[db][4 * g] * il + g2 * lo16(w[0])) * siluf_(lo16(az[0]));
      const float v1 = (ya[db][4 * g + 1] + o[db][4 * g + 1] * il + g2 * hi16(w[0])) * siluf_(hi16(az[0]));
      const float v2 = (ya[db][4 * g + 2] + o[db][4 * g + 2] * il + g2 * lo16(w[1])) * siluf_(lo16(az[1]));
      const float v3 = (ya[db][4 * g + 3] + o[db][4 * g + 3] * il + g2 * hi16(w[1])) * siluf_(hi16(az[1]));
      u32x2 v; v[0] = pk2(v0, v1); v[1] = pk2(v2, v3);
      *(u32x2*)(y + tok * 1024 + col) = v;
    }
}

DI void dilcomb_item(const Params& p, int it) {
  char* const ws_ = opq(p.ws);
  const u16* proj = (const u16*)(ws_ + OFF_PROJ);
  const u16* od = (const u16*)(ws_ + OFF_ODIL);
  const float* lse = (const float*)(ws_ + OFF_LSE);
  u16* y = (u16*)(ws_ + OFF_XB);
#pragma unroll
  for (int i = 0; i < 4; ++i) {
    const int idx = it * 1024 + i * 256 + threadIdx.x;
    const size_t tok = idx >> 5; const int c8 = idx & 31, h = c8 >> 3;
    const float l0 = lse[((size_t)0 * T_ + tok) * 4 + h], l1 = lse[((size_t)1 * T_ + tok) * 4 + h], l2 = lse[((size_t)2 * T_ + tok) * 4 + h];
    const float mx = fmaxf(l0, fmaxf(l1, l2));
    float w0 = __expf(l0 - mx), w1 = __expf(l1 - mx), w2 = __expf(l2 - mx);
    const float iw = 1.f / (w0 + w1 + w2); w0 *= iw; w1 *= iw; w2 *= iw;
    const u32x4 a = *(const u32x4*)(od + ((size_t)0 * T_ + tok) * 256 + c8 * 8), bq = *(const u32x4*)(od + ((size_t)1 * T_ + tok) * 256 + c8 * 8), cq = *(const u32x4*)(od + ((size_t)2 * T_ + tok) * 256 + c8 * 8);
    const u32x4 z = *(const u32x4*)(proj + tok * NP + C_BZ + c8 * 8);
    u32x4 r;
#pragma unroll
    for (int e = 0; e < 4; ++e) {
      const float v0 = (w0 * lo16(a[e]) + w1 * lo16(bq[e]) + w2 * lo16(cq[e])) * siluf_(lo16(z[e]));
      const float v1 = (w0 * hi16(a[e]) + w1 * hi16(bq[e]) + w2 * hi16(cq[e])) * siluf_(hi16(z[e]));
      r[e] = pk2(v0, v1);
    }
    *(u32x4*)(y + tok * 1024 + 256 + c8 * 8) = r;
  }
}

__global__ void __launch_bounds__(256, 2) hybrid_megakernel(Params p) {
  __shared__ __attribute__((aligned(16))) char lds[73728];
  __shared__ uint4 xb_words;
  __shared__ uint4 xg_words;
  cg::grid_group grid = cg::this_grid();
  char* const ws_ = p.ws;
  if (p.ws == nullptr) grid.sync();
  if (threadIdx.x == 0) { xb_words = make_uint4(0u, 0u, 0u, 0u); xg_words = make_uint4(0u, 0u, 0u, 0u); }
  __syncthreads();
  const XcdBarrier xb = xcd_barrier_post((unsigned*)(ws_ + OFF_BAR), (volatile LAS unsigned*)&xb_words, gridDim.x);
  const bool grp = (gridDim.x % 8u) == 0u;
  const XcdBarrier xg = grp ? xcd_barrier_post((unsigned*)(ws_ + OFF_BAR) + (1 + (blockIdx.x & 7)) * 4096, (volatile LAS unsigned*)&xg_words, gridDim.x / 8u) : xb;
  const int nb = gridDim.x, bid = blockIdx.x;
  const int wid = threadIdx.x >> 6;
  for (int it = bid; it < 3328 + 1024 + 1024 + 32 + 16 + 64; it += nb) {
    if (it < 3328) { const int l = it / 832, r = it % 832, ntile = r >> 4, ktile = r & 15;
      tr_tile(p.w_in + (size_t)l * 1024 * 3212, 3212, (u16*)(ws_ + OFF_WIN) + (size_t)l * NP * 1024, 1024, ktile * 64, ntile * 64, p.g_pre + l * 1024, 1, lds); }
    else if (it < 4352) { const int i2 = it - 3328, l = i2 >> 8, r = i2 & 255, ntile = r >> 4, ktile = r & 15;
      tr_tile(p.w_out + (size_t)l * 1024 * 1024, 1024, (u16*)(ws_ + OFF_WOUT) + (size_t)l * 1024 * 1024, 1024, ktile * 64, ntile * 64, nullptr, 0, lds); }
    else if (it < 5376) { const int i2 = it - 4352, mtx = i2 >> 7, r = i2 & 127, ntile = r >> 5, ktile = r & 31;
      tr_tile(p.w_cmp1 + (size_t)mtx * 2048 * 256, 256, (u16*)(ws_ + OFF_W1) + (size_t)mtx * 256 * 2048, 2048, ktile * 64, ntile * 64, nullptr, 0, lds); }
    else if (it < 5408) { const int i2 = it - 5376, mtx = i2 >> 2, ktile = i2 & 3;
      tr_tile(p.w_cmp2 + (size_t)mtx * 256 * 64, 64, (u16*)(ws_ + OFF_W2) + (size_t)mtx * 64 * 256, 256, ktile * 64, 0, nullptr, 0, lds); }
    else if (it < 5424) { const int mtx = it - 5408;
      tr_tile(p.w_pool + (size_t)mtx * 4096, 64, (u16*)(ws_ + OFF_WPT) + (size_t)mtx * 4096, 64, 0, 0, nullptr, 0, lds); }
    else { const int i2 = it - 5424, mtx = i2 >> 2, qd = i2 & 3;
      const float* src = p.w_sp + (size_t)mtx * 16384 + qd * 4096; u16* dst = (u16*)(ws_ + OFF_WSP) + (size_t)mtx * 16384 + qd * 4096;
      f32x4 v[4];
#pragma unroll
      for (int k = 0; k < 4; ++k) v[k] = *(const f32x4*)(src + (threadIdx.x + 256 * k) * 4);
#pragma unroll
      for (int k = 0; k < 4; ++k) {
        const int e = qd * 4096 + (threadIdx.x + 256 * k) * 4, i = e >> 7, j = e & 127;
        u32x2 o; o[0] = pk2(j <= i ? v[k][0] : 0.f, j + 1 <= i ? v[k][1] : 0.f); o[1] = pk2(j + 2 <= i ? v[k][2] : 0.f, j + 3 <= i ? v[k][3] : 0.f);
        *(u32x2*)(dst + (threadIdx.x + 256 * k) * 4) = o;
      } }
  }
  for (int it = bid; it < T_ / 32; it += nb) {
    const int row = it * 32 + wid * 8;
    rows_convert<8>(p.x + (size_t)row * 1024, (u16*)(ws_ + OFF_XB) + (size_t)row * 1024, (float*)(ws_ + OFF_RN) + row);
  }
  xcd_barrier(xb);
  for (int l = 0; l < 4; ++l) {
    for (int it = bid; it < 1024; it += nb) { const int q = it >> 3; inproj_tile<4>(p, l, (it & 7) * 16 + (q & 15), q >> 4, lds); }
    xcd_barrier(xg);
    for (int vb = bid; vb < 512; vb += nb) {
      { const int q2 = vb >> 3; inproj_tile<4>(p, l, (vb & 7) * 16 + (q2 & 15), 8 + (q2 >> 4), lds); }
      if (vb < 64) cmp_item(p, l, vb, lds);
      else {
        const int j = vb - 64;
        if (vb >= 256) { const int i2 = (vb - 256) >> 3; inproj_tile<2>(p, l, (vb & 7) * 16 + (i2 & 15), 24 + (i2 >> 4), lds); }
        win_item(p, j, lds);
        if (j + 448 < 512) win_item(p, j + 448, lds);
        for (int it = j; it < 1536; it += 448) dil_item(p, it, lds);
      }
    }
    xcd_barrier(xg);
    for (int vb = bid; vb < 512; vb += nb) {
      nsa_item(p, vb, lds);
      const int gi = vb >> 4;
      int start = 0, mine = 0;
      for (int g2 = 0; g2 <= gi; ++g2) {
        const int n = 32 - g2;
        const int d = (n <= 10) ? 2 : (n <= 22) ? 1 : 0;
        if (g2 < gi) start += 2 * d; else mine = d;
      }
      start += ((vb >> 3) & 1) * mine;
      const int x = vb & 7;
      for (int k = 0; k < mine; ++k) { const int slot = start + k; sgu_item(p, l, slot * 8 + x, lds); pool_item(p, l, slot * 8 + x, lds); dilcomb_item(p, x * 64 + slot); }
    }
    xcd_barrier(xg);
    for (int it = bid; it < 512; it += nb) outproj_item(p, l, it, lds);
    xcd_barrier(xg);
    const float* xin = (l == 0) ? p.x : p.out;
    for (int vb = bid; vb < 512; vb += nb)
      for (int j = vb >> 3; j < 128; j += 64) resid_rows<4>(p, l, (vb & 7) * 2048 + j * 16 + wid * 4, xin);
    if (l < 3) xcd_barrier(xg);
  }
}

extern "C" void kernel_launch(void* const* d_in, const int* in_sizes, int n_in, void* d_out, int out_size, void* d_ws, size_t ws_size, hipStream_t stream) {
  static int grid_blocks = 0;
  if (!grid_blocks) {
    int dev = 0, cus = 0, per_cu = 0;
    hipGetDevice(&dev);
    hipDeviceGetAttribute(&cus, hipDeviceAttributeMultiprocessorCount, dev);
    hipOccupancyMaxActiveBlocksPerMultiprocessor(&per_cu, hybrid_megakernel, 256, 0);
    if (per_cu > 2) per_cu = 2;
    if (per_cu < 1) per_cu = 1;
    grid_blocks = cus * per_cu;
  }
  if (ws_size < WS_TOTAL) { fprintf(stderr, "workspace too small: %zu < %zu\n", ws_size, (size_t)WS_TOTAL); return; }
  Params p{};
  p.x = (const float*)d_in[0]; p.g_pre = (const float*)d_in[1]; p.w_in = (const float*)d_in[2]; p.pe_cmp = (const float*)d_in[3];
  p.w_cmp1 = (const float*)d_in[4]; p.w_cmp2 = (const float*)d_in[5]; p.w_pool = (const float*)d_in[6]; p.pool_scale = (const float*)d_in[7];
  p.sg_ln_g = (const float*)d_in[8]; p.sg_ln_b = (const float*)d_in[9]; p.w_sp = (const float*)d_in[10]; p.b_sp = (const float*)d_in[11];
  p.w_out = (const float*)d_in[12]; p.g_post = (const float*)d_in[13];
  p.out = (float*)d_out; p.ws = (char*)d_ws;
  hipMemsetAsync((char*)d_ws + OFF_BAR, 0, 9 * 16384, stream);
  void* args[] = {&p};
  hipError_t e = hipLaunchCooperativeKernel((void*)hybrid_megakernel, dim3(grid_blocks), dim3(256), args, 0, stream);
  if (e != hipSuccess) fprintf(stderr, "cooperative launch failed: %s (grid %d)\n", hipGetErrorString(e), grid_blocks);
}
```

```cpp
#include <hip/hip_runtime.h>
#include <hip/hip_cooperative_groups.h>
#include <cstdio>
namespace cg = cooperative_groups;

typedef unsigned short u16;
using bf16x8 = __attribute__((ext_vector_type(8))) short;
using s16x4 = __attribute__((ext_vector_type(4))) short;
using f32x16 = __attribute__((ext_vector_type(16))) float;
using f32x4 = __attribute__((ext_vector_type(4))) float;
using u32x4 = __attribute__((ext_vector_type(4))) unsigned;
using u32x2 = __attribute__((ext_vector_type(2))) unsigned;
typedef short v4i16_t __attribute__((ext_vector_type(4)));
#define DI __device__ __forceinline__
#define MFMA(a, b, c) __builtin_amdgcn_mfma_f32_32x32x16_bf16((a), (b), (c), 0, 0, 0)

constexpr int T_ = 16384, S_ = 2048, NP = 3328;
constexpr float C2 = 0.125f * 1.4426950408889634f;
constexpr float NEGB = -1e30f;

constexpr int C_AQ = 0, C_KCMP = 256, C_KSLC = 384, C_VSLC = 448, C_KWIN = 512, C_VWIN = 576, C_AZ = 640;
constexpr int C_BQ = 896, C_BK = 1152, C_BV = 1408, C_BZ = 1664, C_CIN = 1920, C_CZ = 2176, C_DU = 2432, C_DV = 2688, C_DZ = 2944, C_AG = 3200;

constexpr size_t al(size_t x) { return (x + 255) & ~(size_t)255; }
constexpr size_t OFF_WIN = 0;
constexpr size_t OFF_WOUT = OFF_WIN + al((size_t)4 * NP * 1024 * 2);
constexpr size_t OFF_W1 = OFF_WOUT + al((size_t)4 * 1024 * 1024 * 2);
constexpr size_t OFF_W2 = OFF_W1 + al((size_t)4 * 2 * 256 * 2048 * 2);
constexpr size_t OFF_XB = OFF_W2 + al((size_t)4 * 2 * 64 * 256 * 2);
constexpr size_t OFF_RN = OFF_XB + al((size_t)T_ * 1024 * 2);
constexpr size_t OFF_PROJ = OFF_RN + al((size_t)T_ * 4);
constexpr size_t OFF_SSQ = OFF_PROJ + al((size_t)T_ * NP * 2);
constexpr size_t OFF_KC = OFF_SSQ + al((size_t)T_ * 16 * 4);
constexpr size_t OFF_VCT = OFF_KC + al((size_t)8 * 128 * 64 * 2);
constexpr size_t OFF_OWIN = OFF_VCT + al((size_t)8 * 128 * 64 * 2);
constexpr size_t OFF_ODIL = OFF_OWIN + al((size_t)T_ * 256 * 2);
constexpr size_t OFF_LSE = OFF_ODIL + al((size_t)3 * T_ * 256 * 2);
constexpr size_t OFF_WPT = OFF_LSE + al((size_t)3 * T_ * 4 * 4);
constexpr size_t OFF_WSP = OFF_WPT + al((size_t)16 * 64 * 64 * 2);
constexpr size_t OFF_OUTB = OFF_WSP + al((size_t)16 * 128 * 128 * 2);
constexpr size_t OFF_BAR = OFF_OUTB + al((size_t)T_ * 1024 * 2);
constexpr size_t WS_TOTAL = OFF_BAR + 9 * 16384;
static_assert(WS_TOTAL <= (size_t)256 * 1024 * 1024, "workspace layout exceeds the guaranteed 256 MiB");

struct Params {
  const float *x, *g_pre, *w_in, *pe_cmp, *w_cmp1, *w_cmp2, *w_pool, *pool_scale, *sg_ln_g, *sg_ln_b, *w_sp, *b_sp, *w_out, *g_post;
  float* out;
  char* ws;
};

DI char* opq(char* q) { size_t z = 0; asm volatile("" : "+s"(z)); return q + z; }
DI int tidx() { int t = threadIdx.x; asm volatile("" : "+v"(t)); return t; }
DI float bf2f(u16 v) { return __uint_as_float((unsigned)v << 16); }
DI unsigned pk2(float a, float b) {
  typedef __bf16 bf2 __attribute__((ext_vector_type(2)));
  typedef float f2 __attribute__((ext_vector_type(2)));
  f2 v = {a, b};
  bf2 r = __builtin_convertvector(v, bf2);
  return __builtin_bit_cast(unsigned, r);
}
DI u16 f2bf(float x) { return (u16)(pk2(x, 0.f) & 0xffffu); }
DI float lo16(unsigned w) { return __uint_as_float(w << 16); }
DI float hi16(unsigned w) { return __uint_as_float(w & 0xffff0000u); }
DI int crow(int r, int hi) { return (r & 3) + 8 * (r >> 2) + 4 * hi; }
DI float ex2(float x) { return __builtin_amdgcn_exp2f(x); }
DI float sigmoidf_(float x) { return 1.f / (1.f + __expf(-x)); }
DI float siluf_(float x) { return x / (1.f + __expf(-x)); }
DI float wave_sum(float v) {
#pragma unroll
  for (int o = 32; o >= 1; o >>= 1) v += __shfl_xor(v, o, 64);
  return v;
}
DI bf16x8 pack8(const f32x16& x, int s8) {
  u32x4 p;
  p[0] = pk2(x[8 * s8 + 0], x[8 * s8 + 1]); p[1] = pk2(x[8 * s8 + 2], x[8 * s8 + 3]);
  p[2] = pk2(x[8 * s8 + 4], x[8 * s8 + 5]); p[3] = pk2(x[8 * s8 + 6], x[8 * s8 + 7]);
  return __builtin_bit_cast(bf16x8, p);
}
DI s16x4 trread(const char* p) {
  return __builtin_bit_cast(s16x4, __builtin_amdgcn_ds_read_tr16_b64_v4i16((__attribute__((address_space(3))) v4i16_t*)p));
}


#define XB_TMO      128
#define XB_XCNT(j)  (256  + 64 * (j))
#define XB_XSUB(j)  (1280 + 64 * (j))
#define XB_XGEN(j)  (2304 + 64 * (j))
#define XB_TOP      3328
#define XB_TOPGEN   3392
#define XCD_BAR_WORDS 3456
#define XB_SPIN_CAP (1u << 22)
#define LAS __attribute__((address_space(3)))
DI unsigned xb_ld(unsigned* p)              { return __hip_atomic_load(p, __ATOMIC_RELAXED, __HIP_MEMORY_SCOPE_AGENT); }
DI unsigned xb_add(unsigned* p, unsigned v) { return __hip_atomic_fetch_add(p, v, __ATOMIC_RELAXED, __HIP_MEMORY_SCOPE_AGENT); }
DI unsigned xb_xcc_id() { return (unsigned)__builtin_amdgcn_s_getreg((3 << 11) | 20) & 0xFu; }
#define XB_SPIN(cond, bar) do { unsigned _sp = 0; while (cond) { __builtin_amdgcn_s_sleep(1); \
    if ((++_sp & 255u) == 0u) { if (xb_ld(&(bar)[XB_TMO])) break; if (_sp > XB_SPIN_CAP) { atomicAdd(&(bar)[XB_TMO], 1u); break; } } } } while (0)
struct XcdBarrier { unsigned* bar; unsigned x; volatile LAS unsigned* st; unsigned G; };
DI XcdBarrier xcd_barrier_post(unsigned* bar, volatile LAS unsigned* st, unsigned G) {
    XcdBarrier b; b.bar = bar; b.x = xb_xcc_id(); b.st = st; b.G = G;
    if (threadIdx.x == 0) (void)xb_add(&bar[XB_XCNT(b.x)], 1u);
    return b;
}
DI void xcd_barrier_complete(unsigned* bar, unsigned x, unsigned G, unsigned& nloc, unsigned& nx) {
    unsigned sum, cnt, mine, sp = 0u;
    for (;;) {
        sum = 0u; cnt = 0u; mine = 0u;
#pragma unroll
        for (unsigned j = 0; j < 16; ++j) { const unsigned c = xb_ld(&bar[XB_XCNT(j)]); sum += c; cnt += (c > 0u) ? 1u : 0u; mine = (j == x) ? c : mine; }
        if (sum == G) break;
        __builtin_amdgcn_s_sleep(1);
        if ((++sp & 255u) == 0u) { if (xb_ld(&bar[XB_TMO])) break; if (sp > XB_SPIN_CAP) { atomicAdd(&bar[XB_TMO], 1u); break; } }
    }
    nloc = mine > 0u ? mine : 1u; nx = cnt > 0u ? cnt : 1u;
}
DI void xcd_barrier(const XcdBarrier& b) {
    asm volatile("s_waitcnt vmcnt(0)" ::: "memory");
    __syncthreads();
    if (threadIdx.x == 0) {
        unsigned* bar = b.bar;
        __builtin_amdgcn_s_waitcnt(0);
        unsigned nloc = b.st[0], nx = b.st[1];
        if (nloc == 0u) { xcd_barrier_complete(bar, b.x, b.G, nloc, nx); b.st[0] = nloc; b.st[1] = nx; }
        const unsigned old = xb_add(&bar[XB_XSUB(b.x)], 1u);
        const unsigned gen = old / nloc;
        if (old + 1u == (gen + 1u) * nloc) {
            __builtin_amdgcn_fence(__ATOMIC_RELEASE, "agent");
            asm volatile("s_waitcnt vmcnt(0)" ::: "memory");
            if (nx > 1u) {
              const unsigned og = xb_add(&bar[XB_TOP], 1u);
              const unsigned tg = og / nx;
              if (og + 1u == (tg + 1u) * nx) xb_add(&bar[XB_TOPGEN], 1u);
              else XB_SPIN(xb_ld(&bar[XB_TOPGEN]) == tg, bar);
            }
            __builtin_amdgcn_fence(__ATOMIC_ACQUIRE, "agent");
            xb_add(&bar[XB_XGEN(b.x)], 1u);
            asm volatile("s_waitcnt vmcnt(0)" ::: "memory");
        } else {
            XB_SPIN(xb_ld(&bar[XB_XGEN(b.x)]) == gen, bar);
            __builtin_amdgcn_fence(__ATOMIC_ACQUIRE, "agent");
            asm volatile("s_waitcnt vmcnt(0)" ::: "memory");
        }
    }
    __syncthreads();
}

template <int WGN, int INS, int IMS, bool DB, class LdW, class LdX>
DI void gemm_core(f32x16 (&acc)[INS][IMS], const int KT, LdW ldw, LdX ldx, char* lds, const int tid) {
  constexpr int WGM = 4 / WGN;
  constexpr int WROWS = WGN * 32 * INS, XROWS = WGM * 32 * IMS, NROWS = WROWS + XROWS, NCH = NROWS / 32, NCHW = WROWS / 32, BUFB = NROWS * 144;
  const int lane = tid & 63, wid = tid >> 6, l31 = lane & 31, hi = lane >> 5;
  const int wn = (WGN == 2) ? (wid >> 1) : wid, wm = (WGN == 2) ? (wid & 1) : 0;
  const int offa = (wn * 32 * INS + l31) * 144 + hi * 16;
  const int offb = (WROWS + wm * 32 * IMS + l31) * 144 + hi * 16;
#pragma unroll
  for (int a = 0; a < INS; ++a)
#pragma unroll
    for (int b = 0; b < IMS; ++b)
#pragma unroll
      for (int r = 0; r < 16; ++r) acc[a][b][r] = 0.f;
#define GLOAD(dst, kt_) _Pragma("unroll") for (int i = 0; i < NCH; ++i) { dst[i] = (i < NCHW) ? ldw(i, tid >> 3, (kt_) * 64 + (tid & 7) * 8) : ldx(i - NCHW, tid >> 3, (kt_) * 64 + (tid & 7) * 8); }
#define LSTORE(src, base) _Pragma("unroll") for (int i = 0; i < NCH; ++i) { const int c = tid + 256 * i; *(u32x4*)((base) + (c >> 3) * 144 + (c & 7) * 16) = src[i]; }
#define COMPUTE_PIPE(buf) { const char* pa = (buf) + offa; const char* pb = (buf) + offb; \
    bf16x8 fa[2][INS], fb[2][IMS]; \
    _Pragma("unroll") for (int in = 0; in < INS; ++in) fa[0][in] = *(const bf16x8*)(pa + in * 32 * 144); \
    _Pragma("unroll") for (int im = 0; im < IMS; ++im) fb[0][im] = *(const bf16x8*)(pb + im * 32 * 144); \
    _Pragma("unroll") for (int s = 0; s < 4; ++s) { \
      if (s < 3) { _Pragma("unroll") for (int in = 0; in < INS; ++in) fa[(s + 1) & 1][in] = *(const bf16x8*)(pa + in * 32 * 144 + (s + 1) * 32); \
        _Pragma("unroll") for (int im = 0; im < IMS; ++im) fb[(s + 1) & 1][im] = *(const bf16x8*)(pb + im * 32 * 144 + (s + 1) * 32); } \
      _Pragma("unroll") for (int im = 0; im < IMS; ++im) _Pragma("unroll") for (int in = 0; in < INS; ++in) \
        acc[in][im] = MFMA(fa[s & 1][in], fb[s & 1][im], acc[in][im]); } }
#define COMPUTE_FLAT(buf) { const char* pa = (buf) + offa; const char* pb = (buf) + offb; \
    _Pragma("unroll") for (int s = 0; s < 4; ++s) { \
      bf16x8 fa[INS], fb[IMS]; \
      _Pragma("unroll") for (int in = 0; in < INS; ++in) fa[in] = *(const bf16x8*)(pa + in * 32 * 144 + s * 32); \
      _Pragma("unroll") for (int im = 0; im < IMS; ++im) fb[im] = *(const bf16x8*)(pb + im * 32 * 144 + s * 32); \
      _Pragma("unroll") for (int im = 0; im < IMS; ++im) _Pragma("unroll") for (int in = 0; in < INS; ++in) \
        acc[in][im] = MFMA(fa[in], fb[im], acc[in][im]); } }
  if (DB) {
    u32x4 preA[NCH], preB[NCH];
    GLOAD(preA, 0)
    GLOAD(preB, 1)
    __syncthreads();
    LSTORE(preA, lds)
    __syncthreads();
    for (int kt = 0; kt < KT; kt += 2) {
      if (kt + 2 < KT) { GLOAD(preA, kt + 2) }
      COMPUTE_PIPE(lds)
      LSTORE(preB, lds + BUFB)
      __syncthreads();
      if (kt + 3 < KT) { GLOAD(preB, kt + 3) }
      COMPUTE_PIPE(lds + BUFB)
      if (kt + 2 < KT) { LSTORE(preA, lds) }
      __syncthreads();
    }
  } else {
    u32x4 pre[NCH];
    GLOAD(pre, 0)
    for (int kt = 0; kt < KT; ++kt) {
      __syncthreads();
      LSTORE(pre, lds)
      __syncthreads();
      if (kt + 1 < KT) { GLOAD(pre, kt + 1) }
      if (INS >= 4) COMPUTE_FLAT(lds) else COMPUTE_PIPE(lds)
    }
  }
#undef GLOAD
#undef LSTORE
#undef COMPUTE_PIPE
#undef COMPUTE_FLAT
}

constexpr float M_INIT = -1e29f;
template <class MaskF>
DI void attn_tile(const int tid, const char* ldsK, const char* ldsV, const bf16x8 (&qr)[4], f32x16 (&o)[2], float& m, float& l, const bool MASKED, MaskF mask) {
  const int lane = tid & 63, l31 = lane & 31, hi = lane >> 5;
  f32x16 p0, p1;
#pragma unroll
  for (int r = 0; r < 16; ++r) { p0[r] = 0.f; p1[r] = 0.f; }
  const char* kp = ldsK + l31 * 144 + hi * 16;
#pragma unroll
  for (int s = 0; s < 4; ++s) {
    const bf16x8 k0 = *(const bf16x8*)(kp + s * 32), k1 = *(const bf16x8*)(kp + 32 * 144 + s * 32);
    p0 = MFMA(k0, qr[s], p0); p1 = MFMA(k1, qr[s], p1);
  }
  if (MASKED) {
#pragma unroll
    for (int r = 0; r < 16; ++r) {
      const int kr = crow(r, hi);
      p0[r] = mask(kr) ? p0[r] : NEGB; p1[r] = mask(kr + 32) ? p1[r] : NEGB;
    }
  }
  const char* vb = ldsV + (4 * hi + ((lane & 15) >> 2)) * 144 + ((lane >> 4) & 1) * 32 + (lane & 3) * 8;
  s16x4 vlo[8], vhi[8];
#pragma unroll
  for (int s4 = 0; s4 < 4; ++s4)
#pragma unroll
    for (int db = 0; db < 2; ++db) { vlo[s4 * 2 + db] = trread(vb + (16 * s4) * 144 + db * 64); vhi[s4 * 2 + db] = trread(vb + (16 * s4 + 8) * 144 + db * 64); }
  __builtin_amdgcn_sched_barrier(0);
  float mx = fmaxf(p0[0], p1[0]);
#pragma unroll
  for (int r = 1; r < 16; ++r) mx = fmaxf(fmaxf(mx, p0[r]), p1[r]);
  { auto rr = __builtin_amdgcn_permlane32_swap(__float_as_uint(mx), __float_as_uint(mx), false, false); mx = fmaxf(__uint_as_float(rr[0]), __uint_as_float(rr[1])); }
  const float mxs = mx * C2;
  if (__any(mxs > m + 8.f)) {
    const float mn = fmaxf(m, mxs), alpha = ex2(m - mn);
    m = mn; l *= alpha;
#pragma unroll
    for (int r = 0; r < 16; ++r) { o[0][r] *= alpha; o[1][r] *= alpha; }
  }
  const float nm = -m;
  float rs = 0.f;
#pragma unroll
  for (int r = 0; r < 16; ++r) { p0[r] = ex2(__builtin_fmaf(p0[r], C2, nm)); p1[r] = ex2(__builtin_fmaf(p1[r], C2, nm)); rs += p0[r] + p1[r]; }
  l += rs;
  bf16x8 pw[4];
  pw[0] = pack8(p0, 0); pw[1] = pack8(p0, 1); pw[2] = pack8(p1, 0); pw[3] = pack8(p1, 1);
#pragma unroll
  for (int s4 = 0; s4 < 4; ++s4) {
#pragma unroll
    for (int db = 0; db < 2; ++db) {
      const s16x4 lo = vlo[s4 * 2 + db], hh = vhi[s4 * 2 + db];
      const bf16x8 vf = {lo[0], lo[1], lo[2], lo[3], hh[0], hh[1], hh[2], hh[3]};
      o[db] = MFMA(vf, pw[s4], o[db]);
    }
  }
}

template <class RowF>
DI void kv_load(const int tid, u32x4 (&pre)[4], RowF rowtok, const u16* proj, int kcol, int vcol) {
#pragma unroll
  for (int i = 0; i < 2; ++i) {
    const int c = tid + 256 * i, row = c >> 3, ch = c & 7;
    const u16* p = proj + (size_t)rowtok(row) * NP + ch * 8;
    pre[i] = *(const u32x4*)(p + kcol); pre[2 + i] = *(const u32x4*)(p + vcol);
  }
}
DI void kv_store(const int tid, const u32x4 (&pre)[4], char* ldsK, char* ldsV) {
#pragma unroll
  for (int i = 0; i < 2; ++i) {
    const int c = tid + 256 * i, row = c >> 3, ch = c & 7;
    *(u32x4*)(ldsK + row * 144 + ch * 16) = pre[i]; *(u32x4*)(ldsV + row * 144 + ch * 16) = pre[2 + i];
  }
}

template <class RowF, class FullF, class MaskF>
DI void attn_stream(const int tid, const u16* proj, const int kcol, const int vcol, const int nt, RowF rowtok, FullF full, MaskF mask,
                    const bf16x8 (&qr)[4], f32x16 (&o)[2], float& m, float& l, char* lds) {
  u32x4 preA[4], preB[4];
  if (nt > 0) kv_load(tid, preA, [&](int row) { return rowtok(0, row); }, proj, kcol, vcol);
  if (nt > 1) kv_load(tid, preB, [&](int row) { return rowtok(1, row); }, proj, kcol, vcol);
  for (int ti = 0; ti < nt; ti += 2) {
    kv_store(tid, preA, lds, lds + 9216);
    __syncthreads();
    if (ti + 2 < nt) kv_load(tid, preA, [&](int row) { return rowtok(ti + 2, row); }, proj, kcol, vcol);
    attn_tile(tid, lds, lds + 9216, qr, o, m, l, !full(ti), [&](int kr) { return mask(ti, kr); });
    if (ti + 1 < nt) {
      kv_store(tid, preB, lds + 18432, lds + 27648);
      __syncthreads();
      if (ti + 3 < nt) kv_load(tid, preB, [&](int row) { return rowtok(ti + 3, row); }, proj, kcol, vcol);
      attn_tile(tid, lds + 18432, lds + 27648, qr, o, m, l, !full(ti + 1), [&](int kr) { return mask(ti + 1, kr); });
    }
  }
}

DI int mapcol(int n, int mode) {
  if (mode == 0) return n;
  if (n < 640) return n;
  if (n < 3200) return n + 12;
  if (n < 3212) return n - 3200 + 640;
  return -1;
}
DI void tr_tile(const float* src, int ldsrc, u16* dst, int ldd, int k0, int n0, const float* g, int mode, char* lds) {
  float* t = (float*)lds;
  const int tid = threadIdx.x;
  float v[16];
#pragma unroll
  for (int i = 0; i < 16; ++i) {
    const int e = tid + 256 * i, kk = e >> 6, nn = e & 63;
    const int sc = mapcol(n0 + nn, mode);
    v[i] = sc >= 0 ? src[(size_t)(k0 + kk) * ldsrc + sc] : 0.f;
  }
  if (g) {
#pragma unroll
    for (int i = 0; i < 16; ++i) v[i] *= g[k0 + ((tid + 256 * i) >> 6)];
  }
#pragma unroll
  for (int i = 0; i < 16; ++i) { const int e = tid + 256 * i, kk = e >> 6, nn = e & 63; t[kk * 65 + nn] = v[i]; }
  __syncthreads();
#pragma unroll
  for (int i = 0; i < 2; ++i) {
    const int e = tid + 256 * i, nn = e >> 3, k8 = (e & 7) * 8;
    u32x4 o;
    o[0] = pk2(t[(k8 + 0) * 65 + nn], t[(k8 + 1) * 65 + nn]); o[1] = pk2(t[(k8 + 2) * 65 + nn], t[(k8 + 3) * 65 + nn]);
    o[2] = pk2(t[(k8 + 4) * 65 + nn], t[(k8 + 5) * 65 + nn]); o[3] = pk2(t[(k8 + 6) * 65 + nn], t[(k8 + 7) * 65 + nn]);
    *(u32x4*)(dst + (size_t)(n0 + nn) * ldd + k0 + k8) = o;
  }
  __syncthreads();
}

template <int NR>
DI void rows_convert(const float* x0, u16* xb0, float* rn0) {
  const int lane = tidx() & 63;
  f32x4 v[NR][4];
#pragma unroll
  for (int r = 0; r < NR; ++r)
#pragma unroll
    for (int i = 0; i < 4; ++i) v[r][i] = *(const f32x4*)(x0 + (size_t)r * 1024 + i * 256 + lane * 4);
#pragma unroll
  for (int r = 0; r < NR; ++r) {
    float ss = 0.f;
#pragma unroll
    for (int i = 0; i < 4; ++i) {
      ss += v[r][i][0] * v[r][i][0] + v[r][i][1] * v[r][i][1] + v[r][i][2] * v[r][i][2] + v[r][i][3] * v[r][i][3];
      u32x2 o; o[0] = pk2(v[r][i][0], v[r][i][1]); o[1] = pk2(v[r][i][2], v[r][i][3]);
      *(u32x2*)(xb0 + (size_t)r * 1024 + i * 256 + lane * 4) = o;
    }
    ss = wave_sum(ss);
    if (lane == 0) rn0[r] = rsqrtf(ss * (1.f / 1024.f) + 1e-6f);
  }
}

template <int NTW>
DI void inproj_tile(const Params& p, int l, int mt, int ntile, char* lds) {
  char* const ws_ = opq(p.ws);
  const u16* W = (const u16*)(ws_ + OFF_WIN) + ((size_t)l * NP + ntile * 64 * NTW) * 1024;
  const u16* X = (const u16*)(ws_ + OFF_XB) + (size_t)mt * 128 * 1024;
  f32x16 acc[NTW][2];
  const int tid = tidx();
  gemm_core<2, NTW, 2, (NTW == 2)>(acc, 16, [&](int i, int r0, int k) -> u32x4 { return *(const u32x4*)((W + i * 32768) + (unsigned)(r0 * 1024 + k)); },
               [&](int i, int r0, int k) -> u32x4 { return *(const u32x4*)((X + i * 32768) + (unsigned)(r0 * 1024 + k)); }, lds, tid);
  const int lane = tid & 63, wid = tid >> 6, l31 = lane & 31, hi = lane >> 5, wn = wid >> 1, wm = wid & 1;
  const float* rn = (const float*)(ws_ + OFF_RN);
  u16* proj = (u16*)(ws_ + OFF_PROJ);
  constexpr int NCOLS = 64 * NTW, RS = NCOLS * 2 + 16;
  __syncthreads();
#pragma unroll
  for (int im = 0; im < 2; ++im) {
    const int tl = wm * 64 + im * 32 + l31;
    const float r = rn[(size_t)mt * 128 + tl];
#pragma unroll
    for (int in = 0; in < NTW; ++in)
#pragma unroll
      for (int g = 0; g < 4; ++g) {
        const int n = wn * 32 * NTW + in * 32 + 8 * g + 4 * hi;
        u32x2 o; o[0] = pk2(acc[in][im][4 * g] * r, acc[in][im][4 * g + 1] * r); o[1] = pk2(acc[in][im][4 * g + 2] * r, acc[in][im][4 * g + 3] * r);
        *(u32x2*)(lds + tl * RS + n * 2) = o;
      }
  }
  __syncthreads();
#pragma unroll 4
  for (int i = 0; i < NCOLS / 16; ++i) {
    const int c = tid + 256 * i, tl = c / (NCOLS / 8), ch = c % (NCOLS / 8);
    const u32x4 v = *(const u32x4*)(lds + tl * RS + ch * 16);
    *(u32x4*)(proj + ((size_t)mt * 128 + tl) * NP + ntile * NCOLS + ch * 8) = v;
  }
}

DI void outproj_item(const Params& p, int l, int it, char* lds) {
  char* const ws_ = opq(p.ws);
  const int mt = (it & 7) * 16 + ((it >> 3) & 15), nt = it >> 7;
  const u16* W = (const u16*)(ws_ + OFF_WOUT) + ((size_t)l * 1024 + nt * 256) * 1024;
  const u16* Y = (const u16*)(ws_ + OFF_XB) + (size_t)mt * 128 * 1024;
  f32x16 acc[4][2];
  const int tid = tidx();
  gemm_core<2, 4, 2, false>(acc, 16, [&](int i, int r0, int k) -> u32x4 { return *(const u32x4*)((W + i * 32768) + (unsigned)(r0 * 1024 + k)); },
               [&](int i, int r0, int k) -> u32x4 { return *(const u32x4*)((Y + i * 32768) + (unsigned)(r0 * 1024 + k)); }, lds, tid);
  const int lane = tid & 63, wid = tid >> 6, l31 = lane & 31, hi = lane >> 5, wn = wid >> 1, wm = wid & 1;
  u16* outb = (u16*)(ws_ + OFF_OUTB);
  float* ssq = (float*)(ws_ + OFF_SSQ);
  constexpr int RS = 256 * 2 + 16;
  __syncthreads();
#pragma unroll
  for (int im = 0; im < 2; ++im) {
    const int tl = wm * 64 + im * 32 + l31;
    float ss = 0.f;
#pragma unroll
    for (int in = 0; in < 4; ++in)
#pragma unroll
      for (int g = 0; g < 4; ++g) {
        const int n = wn * 128 + in * 32 + 8 * g + 4 * hi;
        const float o0 = acc[in][im][4 * g], o1 = acc[in][im][4 * g + 1], o2 = acc[in][im][4 * g + 2], o3 = acc[in][im][4 * g + 3];
        ss += o0 * o0 + o1 * o1 + o2 * o2 + o3 * o3;
        u32x2 v; v[0] = pk2(o0, o1); v[1] = pk2(o2, o3);
        *(u32x2*)(lds + tl * RS + n * 2) = v;
      }
    ss += __shfl_xor(ss, 32, 64);
    if (hi == 0) ssq[((size_t)mt * 128 + tl) * 16 + nt * 2 + wn] = ss;
  }
  __syncthreads();
#pragma unroll 4
  for (int i = 0; i < 16; ++i) {
    const int c = tid + 256 * i, tl = c >> 5, ch = c & 31;
    const u32x4 v = *(const u32x4*)(lds + tl * RS + ch * 16);
    *(u32x4*)(outb + ((size_t)mt * 128 + tl) * 1024 + nt * 256 + ch * 8) = v;
  }
}

template <int NR>
DI void resid_rows(const Params& p, int l, int row0, const float* xin) {
  char* const ws_ = opq(p.ws);
  const int lane = tidx() & 63;
  const u16* outb = (const u16*)(ws_ + OFF_OUTB);
  const float* ssq = (const float*)(ws_ + OFF_SSQ);
  u32x2 ob[NR][4]; f32x4 xv[NR][4]; f32x4 sq[NR][2];
#pragma unroll
  for (int r = 0; r < NR; ++r) {
    const size_t row = (size_t)(row0 + r);
    sq[r][0] = *(const f32x4*)(ssq + row * 16); sq[r][1] = *(const f32x4*)(ssq + row * 16 + 4);
#pragma unroll
    for (int i = 0; i < 4; ++i) { const int idx = i * 256 + lane * 4; ob[r][i] = *(const u32x2*)(outb + row * 1024 + idx); xv[r][i] = *(const f32x4*)(xin + row * 1024 + idx); }
  }
  f32x4 gq[4];
#pragma unroll
  for (int i = 0; i < 4; ++i) gq[i] = *(const f32x4*)(p.g_post + l * 1024 + i * 256 + lane * 4);
  u16* xb = (u16*)(ws_ + OFF_XB);
#pragma unroll
  for (int r = 0; r < NR; ++r) {
    const size_t row = (size_t)(row0 + r);
    const float ss = ((sq[r][0][0] + sq[r][0][1]) + (sq[r][0][2] + sq[r][0][3])) + ((sq[r][1][0] + sq[r][1][1]) + (sq[r][1][2] + sq[r][1][3]));
    const float r2 = rsqrtf(ss * (1.f / 1024.f) + 1e-6f);
    float s2 = 0.f;
#pragma unroll
    for (int i = 0; i < 4; ++i) {
      const int idx = i * 256 + lane * 4;
      const f32x4 o = {lo16(ob[r][i][0]), hi16(ob[r][i][0]), lo16(ob[r][i][1]), hi16(ob[r][i][1])};
      f32x4 xn;
#pragma unroll
      for (int e = 0; e < 4; ++e) { xn[e] = xv[r][i][e] + o[e] * r2 * gq[i][e]; s2 += xn[e] * xn[e]; }
      *(f32x4*)(p.out + row * 1024 + idx) = xn;
      if (l < 3) { u32x2 o2; o2[0] = pk2(xn[0], xn[1]); o2[1] = pk2(xn[2], xn[3]); *(u32x2*)(xb + row * 1024 + idx) = o2; }
    }
    s2 = wave_sum(s2);
    if (lane == 0) ((float*)(ws_ + OFF_RN))[row] = rsqrtf(s2 * (1.f / 1024.f) + 1e-6f);
  }
}

DI void cmp_item(const Params& p, int l, int it, char* lds) {
  char* const ws_ = opq(p.ws);
  const int j = it >> 5, mt = (it & 7) * 4 + ((it >> 3) & 3);
  const u16* proj = (const u16*)(ws_ + OFF_PROJ);
  const u16* W1 = (const u16*)(ws_ + OFF_W1) + (size_t)(l * 2 + j) * 256 * 2048;
  const u16* W2 = (const u16*)(ws_ + OFF_W2) + (size_t)(l * 2 + j) * 64 * 256;
  const float* pe = p.pe_cmp + (size_t)(l * 2 + j) * 32 * 64;
  const int kvcol = C_KCMP + 64 * j;
  f32x16 acc[2][1];
  const int tid = tidx();
  gemm_core<4, 2, 1, false>(acc, 32, [&](int i, int r0, int k) -> u32x4 { return *(const u32x4*)((W1 + i * 65536) + (unsigned)(r0 * 2048 + k)); },
   [&](int i, int row, int k) -> u32x4 {
    const int rr = mt * 32 + row, b = rr >> 7; int n = rr & 127; if (n > 126) n = 126;
    const int l32 = k >> 6, d = k & 63;
    const u32x4 raw = *(const u32x4*)(proj + ((size_t)b * S_ + 16 * n + l32) * NP + kvcol + d);
    const f32x4 e0 = *(const f32x4*)(pe + l32 * 64 + d), e1 = *(const f32x4*)(pe + l32 * 64 + d + 4);
    u32x4 o;
    o[0] = pk2(lo16(raw[0]) + e0[0], hi16(raw[0]) + e0[1]); o[1] = pk2(lo16(raw[1]) + e0[2], hi16(raw[1]) + e0[3]);
    o[2] = pk2(lo16(raw[2]) + e1[0], hi16(raw[2]) + e1[1]); o[3] = pk2(lo16(raw[3]) + e1[2], hi16(raw[3]) + e1[3]);
    return o; }, lds, tid);
  const int lane = tid & 63, wid = tid >> 6, l31 = lane & 31, hi = lane >> 5;
#pragma unroll
  for (int a = 0; a < 2; ++a)
#pragma unroll
    for (int r = 0; r < 16; ++r) {
      const float x = acc[a][0][r]; const float u = 0.7978845608028654f * (x + 0.044715f * x * x * x);
      acc[a][0][r] = x / (1.f + __expf(-2.f * u));
    }
  f32x16 c2[2];
#pragma unroll
  for (int r = 0; r < 16; ++r) { c2[0][r] = 0.f; c2[1][r] = 0.f; }
#pragma unroll
  for (int in = 0; in < 2; ++in)
#pragma unroll
    for (int s2 = 0; s2 < 2; ++s2) {
      const bf16x8 h0 = pack8(acc[in][0], s2);
#pragma unroll
      for (int dt = 0; dt < 2; ++dt) {
        const u16* wp = W2 + (size_t)(dt * 32 + l31) * 256 + wid * 64 + in * 32 + 16 * s2 + 4 * hi;
        const s16x4 lo = *(const s16x4*)wp, hh = *(const s16x4*)(wp + 8);
        const bf16x8 wf = {lo[0], lo[1], lo[2], lo[3], hh[0], hh[1], hh[2], hh[3]};
        c2[dt] = MFMA(wf, h0, c2[dt]);
      }
    }
  float* red = (float*)lds;
  __syncthreads();
  for (int w = 0; w < 4; ++w) {
    if (wid == w) {
#pragma unroll
      for (int dt = 0; dt < 2; ++dt)
#pragma unroll
        for (int r = 0; r < 16; ++r) {
          float* q = red + (dt * 32 + crow(r, hi)) * 32 + l31;
          if (w == 0) *q = c2[dt][r]; else *q += c2[dt][r];
        }
    }
    __syncthreads();
  }
  u16* kc = (u16*)(ws_ + OFF_KC); u16* vct = (u16*)(ws_ + OFF_VCT);
#pragma unroll 4
  for (int i = 0; i < 8; ++i) {
    const int e = tid + 256 * i;
    if (j == 0) { const int tok = e >> 6, d = e & 63; const int rr = mt * 32 + tok; kc[(size_t)rr * 64 + d] = f2bf(red[d * 32 + tok]); }
    else { const int d = e >> 5, tok = e & 31; const int rr = mt * 32 + tok, b = rr >> 7, n = rr & 127; vct[((size_t)b * 64 + d) * 128 + n] = f2bf(red[d * 32 + tok]); }
  }
  __syncthreads();
}

DI void win_item(const Params& p, int it, char* lds) {
  char* const ws_ = opq(p.ws);
  const int b = it & 7, qt = it >> 3, q0 = qt * 32;
  const int tid = tidx(), lane = tid & 63, h = tid >> 6, l31 = lane & 31, hi = lane >> 5;
  const u16* proj = (const u16*)(ws_ + OFF_PROJ);
  const int t = q0 + l31; const size_t tok = (size_t)b * S_ + t;
  bf16x8 qr[4];
#pragma unroll
  for (int s = 0; s < 4; ++s) qr[s] = *(const bf16x8*)(proj + tok * NP + C_AQ + h * 64 + 16 * s + 8 * hi);
  char* ldsK = lds; char* ldsV = lds + 9216;
  f32x16 o[2];
#pragma unroll
  for (int r = 0; r < 16; ++r) { o[0][r] = 0.f; o[1][r] = 0.f; }
  float m = M_INIT, lsum = 0.f;
  const int klo = (q0 - 511 > 0 ? q0 - 511 : 0) >> 6, khi = (q0 + 31) >> 6;
  __syncthreads();
  attn_stream(tid, proj, C_KWIN, C_VWIN, khi - klo + 1,
              [&](int ti, int row) { return b * S_ + (klo + ti) * 64 + row; },
              [&](int ti) { const int k0 = (klo + ti) * 64; return (k0 + 63 <= q0) && (k0 >= q0 + 31 - 511); },
              [&](int ti, int kr) { return (unsigned)(t - ((klo + ti) * 64 + kr)) <= 511u; },
              qr, o, m, lsum, lds);
  lsum += __shfl_xor(lsum, 32, 64);
  const float il = 1.f / lsum;
  u16* ow = (u16*)(ws_ + OFF_OWIN);
#pragma unroll
  for (int db = 0; db < 2; ++db)
#pragma unroll
    for (int g = 0; g < 4; ++g) {
      const int d0 = 32 * db + 8 * g + 4 * hi;
      u32x2 v; v[0] = pk2(o[db][4 * g] * il, o[db][4 * g + 1] * il); v[1] = pk2(o[db][4 * g + 2] * il, o[db][4 * g + 3] * il);
      *(u32x2*)(ow + tok * 256 + h * 64 + d0) = v;
    }
}

DI void dil_item(const Params& p, int it, char* lds) {
  char* const ws_ = opq(p.ws);
  const int di = it >> 9, rem = it & 511, b = rem & 7, h = (rem >> 3) & 3, c = rem >> 5;
  const int sh = 2 * di, dil = 1 << sh;
  const int tpr = 16 >> sh;
  const int r = c / tpr, mt = c % tpr, m0 = mt * 128;
  const int tid = tidx(), lane = tid & 63, wid = tid >> 6, l31 = lane & 31, hi = lane >> 5;
  const u16* proj = (const u16*)(ws_ + OFF_PROJ);
  const int mq = m0 + 32 * wid + l31;
  const size_t tok = (size_t)b * S_ + mq * dil + r;
  bf16x8 qr[4];
#pragma unroll
  for (int s = 0; s < 4; ++s) qr[s] = *(const bf16x8*)(proj + tok * NP + C_BQ + h * 64 + 16 * s + 8 * hi);
  const int tt0 = (m0 == 0) ? 2 : 0;
  {
    u32x4 pre[4][4];
#pragma unroll
    for (int tt = 0; tt < 4; ++tt)
      if (tt >= tt0) kv_load(tid, pre[tt], [&](int row) { return b * S_ + (m0 - 128 + 64 * tt + row) * dil + r; }, proj, C_BK + h * 64, C_BV + h * 64);
    __syncthreads();
#pragma unroll
    for (int tt = 0; tt < 4; ++tt)
      if (tt >= tt0) kv_store(tid, pre[tt], lds + tt * 18432, lds + tt * 18432 + 9216);
    __syncthreads();
  }
  f32x16 o[2];
#pragma unroll
  for (int rr = 0; rr < 16; ++rr) { o[0][rr] = 0.f; o[1][rr] = 0.f; }
  float m = M_INIT, lsum = 0.f;
  const int widu = __builtin_amdgcn_readfirstlane(wid);
  const int wlo = m0 + 32 * widu - 128, whi = m0 + 32 * widu + 31;
  for (int tt = tt0; tt < 4; ++tt) {
    const int tk0 = m0 - 128 + 64 * tt;
    if (tk0 + 63 >= wlo && tk0 <= whi) {
      attn_tile(tid, lds + tt * 18432, lds + tt * 18432 + 9216, qr, o, m, lsum, !(tk0 + 63 <= wlo + 128 && tk0 >= whi - 128), [&](int kr) { return (unsigned)(mq - (tk0 + kr)) <= 128u; });
    }
  }
  lsum += __shfl_xor(lsum, 32, 64);
  const float il = 1.f / lsum;
  u16* od = (u16*)(ws_ + OFF_ODIL) + (size_t)di * T_ * 256;
#pragma unroll
  for (int db = 0; db < 2; ++db)
#pragma unroll
    for (int g = 0; g < 4; ++g) {
      const int d0 = 32 * db + 8 * g + 4 * hi;
      u32x2 v; v[0] = pk2(o[db][4 * g] * il, o[db][4 * g + 1] * il); v[1] = pk2(o[db][4 * g + 2] * il, o[db][4 * g + 3] * il);
      *(u32x2*)(od + tok * 256 + h * 64 + d0) = v;
    }
  if (hi == 0) ((float*)(ws_ + OFF_LSE))[((size_t)di * T_ + tok) * 4 + h] = m * 0.6931471805599453f + __logf(lsum);
}

DI void pool_item(const Params& p, int l, int it, char* lds) {
  char* const ws_ = opq(p.ws);
  const int b = it & 7, qt = it >> 3, q0 = qt * 32;
  const int tid = tidx(), lane = tid & 63, g = tid >> 6, l31 = lane & 31, hi = lane >> 5;
  const u16* proj = (const u16*)(ws_ + OFF_PROJ);
  u16* cin = (u16*)lds;
  char* pl = lds + 48 * 512;
  u32x4 cv[6];
#pragma unroll
  for (int i = 0; i < 6; ++i) {
    const int c = tid + 256 * i, row = c >> 5, ch = c & 31; const int t = q0 - 16 + row;
    cv[i] = u32x4{0u, 0u, 0u, 0u};
    if (t >= 0) cv[i] = *(const u32x4*)(proj + ((size_t)b * S_ + t) * NP + C_CIN + ch * 8);
  }
  const u16* wpt = (const u16*)(ws_ + OFF_WPT) + (size_t)(l * 4 + g) * 4096;
  bf16x8 af[8];
#pragma unroll
  for (int q = 0; q < 8; ++q) af[q] = *(const bf16x8*)(wpt + ((q & 1) * 32 + l31) * 64 + 16 * (q >> 1) + 8 * hi);
  const size_t tok = (size_t)b * S_ + q0 + l31;
  f32x4 psv[8]; u32x2 zv[8];
#pragma unroll
  for (int q = 0; q < 8; ++q) {
    const int col = g * 64 + (q >> 2) * 32 + 8 * (q & 3) + 4 * hi;
    psv[q] = *(const f32x4*)(p.pool_scale + l * 256 + col); zv[q] = *(const u32x2*)(proj + tok * NP + C_CZ + col);
  }
  __syncthreads();
#pragma unroll
  for (int i = 0; i < 6; ++i) { const int c = tid + 256 * i, row = c >> 5, ch = c & 31; *(u32x4*)(cin + row * 256 + ch * 8) = cv[i]; }
  __syncthreads();
  {
    const int ch = tid, w = 2 << g;
    float s = 0.f;
    for (int r = 17 - w; r <= 16; ++r) s += bf2f(cin[r * 256 + ch]);
#pragma unroll 4
    for (int i = 0; i < 32; ++i) {
      const int t = q0 + i; const int cnt = (t + 1 < w) ? t + 1 : w;
      const float self = bf2f(cin[(i + 16) * 256 + ch]);
      *(u16*)(pl + i * 528 + ch * 2) = f2bf(s / (float)cnt - self);
      s += bf2f(cin[(i + 17) * 256 + ch]) - bf2f(cin[(i + 17 - w) * 256 + ch]);
    }
  }
  __syncthreads();
  f32x16 acc[2];
#pragma unroll
  for (int r = 0; r < 16; ++r) { acc[0][r] = 0.f; acc[1][r] = 0.f; }
#pragma unroll
  for (int s4 = 0; s4 < 4; ++s4) {
    const bf16x8 bf = *(const bf16x8*)(pl + l31 * 528 + (g * 64 + 16 * s4 + 8 * hi) * 2);
#pragma unroll
    for (int dt = 0; dt < 2; ++dt) acc[dt] = MFMA(af[s4 * 2 + dt], bf, acc[dt]);
  }
  u16* y = (u16*)(ws_ + OFF_XB);
#pragma unroll
  for (int dt = 0; dt < 2; ++dt)
#pragma unroll
    for (int g4 = 0; g4 < 4; ++g4) {
      const int col = g * 64 + dt * 32 + 8 * g4 + 4 * hi;
      const f32x4 ps = psv[dt * 4 + g4];
      const u32x2 z = zv[dt * 4 + g4];
      u32x2 v;
      v[0] = pk2(acc[dt][4 * g4] * ps[0] * siluf_(lo16(z[0])), acc[dt][4 * g4 + 1] * ps[1] * siluf_(hi16(z[0])));
      v[1] = pk2(acc[dt][4 * g4 + 2] * ps[2] * siluf_(lo16(z[1])), acc[dt][4 * g4 + 3] * ps[3] * siluf_(hi16(z[1])));
      *(u32x2*)(y + tok * 1024 + 512 + col) = v;
    }
}

DI void sgu_item(const Params& p, int l, int it, char* lds) {
  char* const ws_ = opq(p.ws);
  const int b = it & 7, c = (it >> 5) & 15, g = (it >> 3) & 3, t0 = c * 128;
  const int tid = tidx(), lane = tid & 63, l31 = lane & 31, hi = lane >> 5;
  const int wid = __builtin_amdgcn_readfirstlane(tid >> 6);
  const u16* proj = (const u16*)(ws_ + OFF_PROJ);
  char* vn = lds;
  __syncthreads();
  {
    const int j = tid >> 1, half = tid & 1;
    const u16* vp = proj + ((size_t)b * S_ + t0 + j) * NP + C_DV + half * 128;
    u32x4 raw[16];
#pragma unroll
    for (int i = 0; i < 16; ++i) raw[i] = *(const u32x4*)(vp + i * 8);
    float s1 = 0.f;
#pragma unroll
    for (int i = 0; i < 16; ++i)
#pragma unroll
      for (int e = 0; e < 4; ++e) s1 += lo16(raw[i][e]) + hi16(raw[i][e]);
    s1 += __shfl_xor(s1, 1, 64);
    const float mu = s1 * (1.f / 256.f);
    float s2 = 0.f;
#pragma unroll
    for (int i = 0; i < 16; ++i)
#pragma unroll
      for (int e = 0; e < 4; ++e) { const float a = lo16(raw[i][e]) - mu, bb = hi16(raw[i][e]) - mu; s2 += a * a + bb * bb; }
    s2 += __shfl_xor(s2, 1, 64);
    const float rstd = rsqrtf(s2 * (1.f / 256.f) + 1e-5f);
    if (half == (g >> 1)) {
      const float* lg = p.sg_ln_g + l * 256 + g * 64; const float* lb = p.sg_ln_b + l * 256 + g * 64;
      auto emit = [&](const u32x4& r, int i) {
        const f32x4 g0 = *(const f32x4*)(lg + i * 8), g1 = *(const f32x4*)(lg + i * 8 + 4), b0 = *(const f32x4*)(lb + i * 8), b1 = *(const f32x4*)(lb + i * 8 + 4);
        u32x4 o;
        o[0] = pk2((lo16(r[0]) - mu) * rstd * g0[0] + b0[0], (hi16(r[0]) - mu) * rstd * g0[1] + b0[1]);
        o[1] = pk2((lo16(r[1]) - mu) * rstd * g0[2] + b0[2], (hi16(r[1]) - mu) * rstd * g0[3] + b0[3]);
        o[2] = pk2((lo16(r[2]) - mu) * rstd * g1[0] + b1[0], (hi16(r[2]) - mu) * rstd * g1[1] + b1[1]);
        o[3] = pk2((lo16(r[3]) - mu) * rstd * g1[2] + b1[2], (hi16(r[3]) - mu) * rstd * g1[3] + b1[3]);
        *(u32x4*)(vn + j * 144 + i * 16) = o;
      };
      if (g & 1) {
#pragma unroll
        for (int i = 0; i < 8; ++i) emit(raw[8 + i], i);
      } else {
#pragma unroll
        for (int i = 0; i < 8; ++i) emit(raw[i], i);
      }
    }
  }
  __syncthreads();
  const int i = wid * 32 + l31;
  const u16* wsp = (const u16*)(ws_ + OFF_WSP) + ((size_t)(l * 4 + g) * 128 + i) * 128;
  f32x16 acc[2];
#pragma unroll
  for (int r = 0; r < 16; ++r) { acc[0][r] = 0.f; acc[1][r] = 0.f; }
  const int nks = 2 * (wid + 1);
  bf16x8 wfr[8];
#pragma unroll
  for (int s = 0; s < 8; ++s) { if (s < nks) wfr[s] = *(const bf16x8*)(wsp + 16 * s + 8 * hi); else wfr[s] = bf16x8{0, 0, 0, 0, 0, 0, 0, 0}; }
  const char* vb = vn + (8 * hi + ((lane & 15) >> 2)) * 144 + ((lane >> 4) & 1) * 32 + (lane & 3) * 8;
#pragma unroll
  for (int s = 0; s < 8; ++s) {
    if (s < nks) {
#pragma unroll
      for (int ct = 0; ct < 2; ++ct) {
        const s16x4 lo = trread(vb + (16 * s) * 144 + ct * 64), hh = trread(vb + (16 * s + 4) * 144 + ct * 64);
        const bf16x8 af = {lo[0], lo[1], lo[2], lo[3], hh[0], hh[1], hh[2], hh[3]};
        acc[ct] = MFMA(af, wfr[s], acc[ct]);
      }
    }
  }
  const size_t tok = (size_t)b * S_ + t0 + i;
  const float bs = p.b_sp[(l * 4 + g) * 128 + i];
  u16* y = (u16*)(ws_ + OFF_XB);
#pragma unroll
  for (int ct = 0; ct < 2; ++ct)
#pragma unroll
    for (int g4 = 0; g4 < 4; ++g4) {
      const int col = g * 64 + ct * 32 + 8 * g4 + 4 * hi;
      const u32x2 u = *(const u32x2*)(proj + tok * NP + C_DU + col), z = *(const u32x2*)(proj + tok * NP + C_DZ + col);
      u32x2 v;
      v[0] = pk2(lo16(u[0]) * (acc[ct][4 * g4] + bs) * siluf_(lo16(z[0])), hi16(u[0]) * (acc[ct][4 * g4 + 1] + bs) * siluf_(hi16(z[0])));
      v[1] = pk2(lo16(u[1]) * (acc[ct][4 * g4 + 2] + bs) * siluf_(lo16(z[1])), hi16(u[1]) * (acc[ct][4 * g4 + 3] + bs) * siluf_(hi16(z[1])));
      *(u32x2*)(y + tok * 1024 + 768 + col) = v;
    }
}

DI void nsa_item(const Params& p, int it, char* lds) {
  char* const ws_ = opq(p.ws);
  const int b = it & 7, qt = 63 - (it >> 3), q0 = qt * 32;
  const int tid = tidx(), lane = tid & 63, h = tid >> 6, l31 = lane & 31, hi = lane >> 5;
  const u16* proj = (const u16*)(ws_ + OFF_PROJ);
  const int t = q0 + l31; const size_t tok = (size_t)b * S_ + t;
  bf16x8 qr[4];
#pragma unroll
  for (int s = 0; s < 4; ++s) qr[s] = *(const bf16x8*)(proj + tok * NP + C_AQ + h * 64 + 16 * s + 8 * hi);
  char* ldsK = lds; char* ldsV = lds + 9216;
  float* impS = (float*)(lds + 36864);
  float* vals = (float*)(lds + 36864 + 16384);
  unsigned* selm = (unsigned*)(lds + 73728 - 256);
  int* jlist = (int*)(lds + 73728 - 128);
  float* yst = (float*)(lds + 36864);
  __syncthreads();
  if (tid < 32) selm[tid] = 0u;
  const float g0 = sigmoidf_(bf2f(proj[tok * NP + C_AG + 0 + h])), g1 = sigmoidf_(bf2f(proj[tok * NP + C_AG + 4 + h])), g2 = sigmoidf_(bf2f(proj[tok * NP + C_AG + 8 + h]));
  f32x16 ya[2];
  {
    const u16* kc = (const u16*)(ws_ + OFF_KC); const u16* vct = (const u16*)(ws_ + OFF_VCT);
    f32x16 sc[4];
    const int nkb = (((q0 + 31 - 31) >> 4) >> 5) + 1;
#pragma unroll
    for (int kb = 0; kb < 4; ++kb) {
#pragma unroll
      for (int r = 0; r < 16; ++r) sc[kb][r] = 0.f;
      if (kb < nkb) {
#pragma unroll
        for (int s = 0; s < 4; ++s) {
          const bf16x8 kf = *(const bf16x8*)(kc + ((size_t)(b * 128 + kb * 32 + l31)) * 64 + 16 * s + 8 * hi);
          sc[kb] = MFMA(kf, qr[s], sc[kb]);
        }
      }
    }
    s16x4 vcl[16], vch[16];
#pragma unroll
    for (int q = 0; q < 16; ++q) {
      const int kb = q >> 2, s2 = (q >> 1) & 1, db = q & 1;
      const u16* vp = vct + ((size_t)(b * 64 + 32 * db + l31)) * 128 + 32 * kb + 16 * s2 + 4 * hi;
      vcl[q] = s16x4{0, 0, 0, 0}; vch[q] = s16x4{0, 0, 0, 0};
      if (kb < nkb) { vcl[q] = *(const s16x4*)vp; vch[q] = *(const s16x4*)(vp + 8); }
    }
    const int nv = (t >= 31) ? ((t - 31) >> 4) : -1;
    float mx = NEGB;
#pragma unroll
    for (int kb = 0; kb < 4; ++kb)
#pragma unroll
      for (int r = 0; r < 16; ++r) { const int n = 32 * kb + crow(r, hi); const float v = (n <= nv) ? sc[kb][r] * C2 : NEGB; sc[kb][r] = v; mx = fmaxf(mx, v); }
    mx = fmaxf(mx, __shfl_xor(mx, 32, 64));
    float sum = 0.f;
#pragma unroll
    for (int kb = 0; kb < 4; ++kb)
#pragma unroll
      for (int r = 0; r < 16; ++r) { const int n = 32 * kb + crow(r, hi); const float e = (n <= nv) ? ex2(sc[kb][r] - mx) : 0.f; sc[kb][r] = e; sum += e; }
    sum += __shfl_xor(sum, 32, 64);
    const float inv = sum > 0.f ? 1.f / sum : 0.f;
#pragma unroll
    for (int kb = 0; kb < 4; ++kb)
#pragma unroll
      for (int r = 0; r < 16; ++r) sc[kb][r] *= inv;
    float* myimp = impS + (h * 32 + l31) * 32;
#pragma unroll
    for (int kb = 0; kb < 4; ++kb)
#pragma unroll
      for (int g = 0; g < 4; ++g) myimp[8 * kb + 2 * g + hi] = ((sc[kb][4 * g] + sc[kb][4 * g + 1]) + sc[kb][4 * g + 2]) + sc[kb][4 * g + 3];
    __syncthreads();
#pragma unroll
    for (int kb = 0; kb < 4; ++kb)
#pragma unroll
      for (int g = 0; g < 4; ++g) { const int j1 = 8 * kb + 2 * g + hi + 1; if (j1 < 32) myimp[j1] += sc[kb][4 * g + 3]; }
    f32x16 oc[2];
#pragma unroll
    for (int r = 0; r < 16; ++r) { oc[0][r] = 0.f; oc[1][r] = 0.f; }
#pragma unroll
    for (int kb = 0; kb < 4; ++kb)
#pragma unroll
      for (int s2 = 0; s2 < 2; ++s2) {
        if (kb >= nkb) continue;
        const bf16x8 pf = pack8(sc[kb], s2);
#pragma unroll
        for (int db = 0; db < 2; ++db) {
          const s16x4 lo = vcl[(kb * 2 + s2) * 2 + db], hh = vch[(kb * 2 + s2) * 2 + db];
          const bf16x8 vf = {lo[0], lo[1], lo[2], lo[3], hh[0], hh[1], hh[2], hh[3]};
          oc[db] = MFMA(vf, pf, oc[db]);
        }
      }
#pragma unroll
    for (int r = 0; r < 16; ++r) { ya[0][r] = oc[0][r] * g0; ya[1][r] = oc[1][r] * g0; }
  }
  __syncthreads();
  const int cur = q0 >> 6;
  {
    const int q = tid >> 3, sub = tid & 7;
#pragma unroll
    for (int jj = 0; jj < 4; ++jj) {
      const int j = sub * 4 + jj;
      float v = ((impS[(0 * 32 + q) * 32 + j] + impS[(1 * 32 + q) * 32 + j]) + impS[(2 * 32 + q) * 32 + j]) + impS[(3 * 32 + q) * 32 + j];
      const bool forced = (j == 0) || (j == cur) || (j == cur - 1);
      v = forced ? 1e4f : ((j <= cur) ? v : -1e4f);
      vals[q * 32 + j] = v;
    }
    __syncthreads();
    f32x4 vv[8];
#pragma unroll
    for (int i = 0; i < 8; ++i) vv[i] = *(const f32x4*)(vals + q * 32 + i * 4);
    unsigned bits = 0u;
#pragma unroll
    for (int jj = 0; jj < 4; ++jj) {
      const int j = sub * 4 + jj; const float v = vals[q * 32 + j];
      int cnt = 0;
#pragma unroll
      for (int j2 = 0; j2 < 32; ++j2) { const float w = vv[j2 >> 2][j2 & 3]; cnt += ((w > v) || (w == v && j2 < j)) ? 1 : 0; }
      if (cnt < 16 && j <= cur) bits |= 1u << j;
    }
    if (bits) atomicOr(&selm[q], bits);
  }
  __syncthreads();
  const unsigned mymask = selm[l31];
  unsigned anym = mymask, allm = mymask;
#pragma unroll
  for (int o = 16; o >= 1; o >>= 1) { anym |= (unsigned)__shfl_xor((int)anym, o, 64); allm &= (unsigned)__shfl_xor((int)allm, o, 64); }
  anym = __builtin_amdgcn_readfirstlane(anym);
  allm = __builtin_amdgcn_readfirstlane(allm);
  if (tid < 32) { if ((anym >> tid) & 1u) jlist[__builtin_popcount(anym & ((1u << tid) - 1u))] = tid; }
  f32x16 o[2];
#pragma unroll
  for (int r = 0; r < 16; ++r) { o[0][r] = 0.f; o[1][r] = 0.f; }
  float m = M_INIT, lsum = 0.f;
#pragma unroll
  for (int r = 0; r < 16; ++r) { yst[r * 256 + tid] = ya[0][r]; yst[(16 + r) * 256 + tid] = ya[1][r]; }
  __syncthreads();
  attn_stream(tid, proj, C_KSLC, C_VSLC, __builtin_popcount(anym),
              [&](int ti, int row) { return b * S_ + jlist[ti] * 64 + row; },
              [&](int ti) { const int jb = jlist[ti]; return (jb < cur) && ((allm >> jb) & 1u); },
              [&](int ti, int kr) { const int jb = jlist[ti]; return ((mymask >> jb) & 1u) && (jb * 64 + kr <= t); },
              qr, o, m, lsum, lds);
#pragma unroll
  for (int r = 0; r < 16; ++r) { ya[0][r] = yst[r * 256 + tid]; ya[1][r] = yst[(16 + r) * 256 + tid]; }
  lsum += __shfl_xor(lsum, 32, 64);
  const float il = g1 / lsum;
  const u16* ow = (const u16*)(ws_ + OFF_OWIN);
  u16* y = (u16*)(ws_ + OFF_XB);
#pragma unroll
  for (int db = 0; db < 2; ++db)
#pragma unroll
    for (int g = 0; g < 4; ++g) {
      const int col = h * 64 + 32 * db + 8 * g + 4 * hi;
      const u32x2 w = *(const u32x2*)(ow + tok * 256 + col), az = *(const u32x2*)(proj + tok * NP + C_AZ + col);
      const float v0 = (ya[db][4 * g] + o[db][4 * g] * il + g2 * lo16(w[0])) * siluf_(lo16(az[0]));
      const float v1 = (ya[db][4 * g + 1] + o[db][4 * g + 1] * il + g2 * hi16(w[0])) * siluf_(hi16(az[0]));
      const float v2 = (ya[db][4 * g + 2] + o[db][4 * g + 2] * il + g2 * lo16(w[1])) * siluf_(lo16(az[1]));
      const float v3 = (ya[db][4 * g + 3] + o[db][4 * g + 3] * il + g2 * hi16(w[1])) * siluf_(hi16(az[1]));
      u32x2 v; v[0] = pk2(v0, v1); v[1] = pk2(v2, v3);
      *(u32x2*)(y + tok * 1024 + col) = v;
    }
}

DI void dilcomb_item(const Params& p, int it) {
  char* const ws_ = opq(p.ws);
  const u16* proj = (const u16*)(ws_ + OFF_PROJ);
  const u16* od = (const u16*)(ws_ + OFF_ODIL);
  const float* lse = (const float*)(ws_ + OFF_LSE);
  u16* y = (u16*)(ws_ + OFF_XB);
#pragma unroll
  for (int i = 0; i < 4; ++i) {
    const int idx = it * 1024 + i * 256 + threadIdx.x;
    const size_t tok = idx >> 5; const int c8 = idx & 31, h = c8 >> 3;
    const float l0 = lse[((size_t)0 * T_ + tok) * 4 + h], l1 = lse[((size_t)1 * T_ + tok) * 4 + h], l2 = lse[((size_t)2 * T_ + tok) * 4 + h];
    const float mx = fmaxf(l0, fmaxf(l1, l2));
    float w0 = __expf(l0 - mx), w1 = __expf(l1 - mx), w2 = __expf(l2 - mx);
    const float iw = 1.f / (w0 + w1 + w2); w0 *= iw; w1 *= iw; w2 *= iw;
    const u32x4 a = *(const u32x4*)(od + ((size_t)0 * T_ + tok) * 256 + c8 * 8), bq = *(const u32x4*)(od + ((size_t)1 * T_ + tok) * 256 + c8 * 8), cq = *(const u32x4*)(od + ((size_t)2 * T_ + tok) * 256 + c8 * 8);
    const u32x4 z = *(const u32x4*)(proj + tok * NP + C_BZ + c8 * 8);
    u32x4 r;
#pragma unroll
    for (int e = 0; e < 4; ++e) {
      const float v0 = (w0 * lo16(a[e]) + w1 * lo16(bq[e]) + w2 * lo16(cq[e])) * siluf_(lo16(z[e]));
      const float v1 = (w0 * hi16(a[e]) + w1 * hi16(bq[e]) + w2 * hi16(cq[e])) * siluf_(hi16(z[e]));
      r[e] = pk2(v0, v1);
    }
    *(u32x4*)(y + tok * 1024 + 256 + c8 * 8) = r;
  }
}

__global__ void __launch_bounds__(256, 2) hybrid_megakernel(Params p) {
  __shared__ __attribute__((aligned(16))) char lds[73728];
  __shared__ uint4 xb_words;
  __shared__ uint4 xg_words;
  cg::grid_group grid = cg::this_grid();
  char* const ws_ = p.ws;
  if (p.ws == nullptr) grid.sync();
  if (threadIdx.x == 0) { xb_words = make_uint4(0u, 0u, 0u, 0u); xg_words = make_uint4(0u, 0u, 0u, 0u); }
  __syncthreads();
  const XcdBarrier xb = xcd_barrier_post((unsigned*)(ws_ + OFF_BAR), (volatile LAS unsigned*)&xb_words, gridDim.x);
  const bool grp = (gridDim.x % 8u) == 0u;
  const XcdBarrier xg = grp ? xcd_barrier_post((unsigned*)(ws_ + OFF_BAR) + (1 + (blockIdx.x & 7)) * 4096, (volatile LAS unsigned*)&xg_words, gridDim.x / 8u) : xb;
  const int nb = gridDim.x, bid = blockIdx.x;
  const int wid = threadIdx.x >> 6;
  for (int it = bid; it < 3328 + 1024 + 1024 + 32 + 16 + 64; it += nb) {
    if (it < 3328) { const int l = it / 832, r = it % 832, ntile = r >> 4, ktile = r & 15;
      tr_tile(p.w_in + (size_t)l * 1024 * 3212, 3212, (u16*)(ws_ + OFF_WIN) + (size_t)l * NP * 1024, 1024, ktile * 64, ntile * 64, p.g_pre + l * 1024, 1, lds); }
    else if (it < 4352) { const int i2 = it - 3328, l = i2 >> 8, r = i2 & 255, ntile = r >> 4, ktile = r & 15;
      tr_tile(p.w_out + (size_t)l * 1024 * 1024, 1024, (u16*)(ws_ + OFF_WOUT) + (size_t)l * 1024 * 1024, 1024, ktile * 64, ntile * 64, nullptr, 0, lds); }
    else if (it < 5376) { const int i2 = it - 4352, mtx = i2 >> 7, r = i2 & 127, ntile = r >> 5, ktile = r & 31;
      tr_tile(p.w_cmp1 + (size_t)mtx * 2048 * 256, 256, (u16*)(ws_ + OFF_W1) + (size_t)mtx * 256 * 2048, 2048, ktile * 64, ntile * 64, nullptr, 0, lds); }
    else if (it < 5408) { const int i2 = it - 5376, mtx = i2 >> 2, ktile = i2 & 3;
      tr_tile(p.w_cmp2 + (size_t)mtx * 256 * 64, 64, (u16*)(ws_ + OFF_W2) + (size_t)mtx * 64 * 256, 256, ktile * 64, 0, nullptr, 0, lds); }
    else if (it < 5424) { const int mtx = it - 5408;
      tr_tile(p.w_pool + (size_t)mtx * 4096, 64, (u16*)(ws_ + OFF_WPT) + (size_t)mtx * 4096, 64, 0, 0, nullptr, 0, lds); }
    else { const int i2 = it - 5424, mtx = i2 >> 2, qd = i2 & 3;
      const float* src = p.w_sp + (size_t)mtx * 16384 + qd * 4096; u16* dst = (u16*)(ws_ + OFF_WSP) + (size_t)mtx * 16384 + qd * 4096;
      f32x4 v[4];
#pragma unroll
      for (int k = 0; k < 4; ++k) v[k] = *(const f32x4*)(src + (threadIdx.x + 256 * k) * 4);
#pragma unroll
      for (int k = 0; k < 4; ++k) {
        const int e = qd * 4096 + (threadIdx.x + 256 * k) * 4, i = e >> 7, j = e & 127;
        u32x2 o; o[0] = pk2(j <= i ? v[k][0] : 0.f, j + 1 <= i ? v[k][1] : 0.f); o[1] = pk2(j + 2 <= i ? v[k][2] : 0.f, j + 3 <= i ? v[k][3] : 0.f);
        *(u32x2*)(dst + (threadIdx.x + 256 * k) * 4) = o;
      } }
  }
  for (int it = bid; it < T_ / 32; it += nb) {
    const int row = it * 32 + wid * 8;
    rows_convert<8>(p.x + (size_t)row * 1024, (u16*)(ws_ + OFF_XB) + (size_t)row * 1024, (float*)(ws_ + OFF_RN) + row);
  }
  xcd_barrier(xb);
  for (int l = 0; l < 4; ++l) {
    for (int it = bid; it < 1024; it += nb) { const int q = it >> 3; inproj_tile<4>(p, l, (it & 7) * 16 + (q & 15), q >> 4, lds); }
    xcd_barrier(xg);
    for (int vb = bid; vb < 512; vb += nb) {
      { const int q2 = vb >> 3; inproj_tile<4>(p, l, (vb & 7) * 16 + (q2 & 15), 8 + (q2 >> 4), lds); }
      if (vb < 64) cmp_item(p, l, vb, lds);
      else {
        const int j = vb - 64;
        if (vb >= 256) { const int i2 = (vb - 256) >> 3; inproj_tile<2>(p, l, (vb & 7) * 16 + (i2 & 15), 24 + (i2 >> 4), lds); }
        win_item(p, j, lds);
        if (j + 448 < 512) win_item(p, j + 448, lds);
        for (int it = j; it < 1536; it += 448) dil_item(p, it, lds);
      }
    }
    xcd_barrier(xg);
    for (int vb = bid; vb < 512; vb += nb) {
      nsa_item(p, vb, lds);
      const int gi = vb >> 4;
      int start = 0, mine = 0;
      for (int g2 = 0; g2 <= gi; ++g2) {
        const int n = 32 - g2;
        const int d = (n <= 10) ? 2 : (n <= 22) ? 1 : 0;
        if (g2 < gi) start += 2 * d; else mine = d;
      }
      start += ((vb >> 3) & 1) * mine;
      const int x = vb & 7;
      for (int k = 0; k < mine; ++k) { const int slot = start + k; sgu_item(p, l, slot * 8 + x, lds); pool_item(p, l, slot * 8 + x, lds); dilcomb_item(p, x * 64 + slot); }
    }
    xcd_barrier(xg);
    for (int it = bid; it < 512; it += nb) outproj_item(p, l, it, lds);
    xcd_barrier(xg);
    const float* xin = (l == 0) ? p.x : p.out;
    for (int vb = bid; vb < 512; vb += nb)
      for (int j = vb >> 3; j < 128; j += 64) resid_rows<4>(p, l, (vb & 7) * 2048 + j * 16 + wid * 4, xin);
    if (l < 3) xcd_barrier(xg);
  }
}

extern "C" void kernel_launch(void* const* d_in, const int* in_sizes, int n_in, void* d_out, int out_size, void* d_ws, size_t ws_size, hipStream_t stream) {
  static int grid_blocks = 0;
  if (!grid_blocks) {
    int dev = 0, cus = 0, per_cu = 0;
    hipGetDevice(&dev);
    hipDeviceGetAttribute(&cus, hipDeviceAttributeMultiprocessorCount, dev);
    hipOccupancyMaxActiveBlocksPerMultiprocessor(&per_cu, hybrid_megakernel, 256, 0);
    if (per_cu > 2) per_cu = 2;
    if (per_cu < 1) per_cu = 1;
    grid_blocks = cus * per_cu;
  }
  if (ws_size < WS_TOTAL) { fprintf(stderr, "workspace too small: %zu < %zu\n", ws_size, (size_t)WS_TOTAL); return; }
  Params p{};
  p.x = (const float*)d_in[0]; p.g_pre = (const float*)d_in[1]; p.w_in = (const float*)d_in[2]; p.pe_cmp = (const float*)d_in[3];
  p.w_cmp1 = (const float*)d_in[4]; p.w_cmp2 = (const float*)d_in[5]; p.w_pool = (const float*)d_in[6]; p.pool_scale = (const float*)d_in[7];
  p.sg_ln_g = (const float*)d_in[8]; p.sg_ln_b = (const float*)d_in[9]; p.w_sp = (const float*)d_in[10]; p.b_sp = (const float*)d_in[11];
  p.w_out = (const float*)d_in[12]; p.g_post = (const float*)d_in[13];
  p.out = (float*)d_out; p.ws = (char*)d_ws;
  hipMemsetAsync((char*)d_ws + OFF_BAR, 0, 9 * 16384, stream);
  void* args[] = {&p};
  hipError_t e = hipLaunchCooperativeKernel((void*)hybrid_megakernel, dim3(grid_blocks), dim3(256), args, 0, stream);
  if (e != hipSuccess) fprintf(stderr, "cooperative launch failed: %s (grid %d)\n", hipGetErrorString(e), grid_blocks);
}
```

```cpp
#include <hip/hip_runtime.h>
#include <hip/hip_cooperative_groups.h>
#include <cstdio>
namespace cg = cooperative_groups;

typedef unsigned short u16;
using bf16x8 = __attribute__((ext_vector_type(8))) short;
using s16x4 = __attribute__((ext_vector_type(4))) short;
using f32x16 = __attribute__((ext_vector_type(16))) float;
using f32x4 = __attribute__((ext_vector_type(4))) float;
using u32x4 = __attribute__((ext_vector_type(4))) unsigned;
using u32x2 = __attribute__((ext_vector_type(2))) unsigned;
typedef short v4i16_t __attribute__((ext_vector_type(4)));
#define DI __device__ __forceinline__
#define MFMA(a, b, c) __builtin_amdgcn_mfma_f32_32x32x16_bf16((a), (b), (c), 0, 0, 0)

constexpr int T_ = 16384, S_ = 2048, NP = 3328;
constexpr float C2 = 0.125f * 1.4426950408889634f;
constexpr float NEGB = -1e30f;

constexpr int C_AQ = 0, C_KCMP = 256, C_KSLC = 384, C_VSLC = 448, C_KWIN = 512, C_VWIN = 576, C_AZ = 640;
constexpr int C_BQ = 896, C_BK = 1152, C_BV = 1408, C_BZ = 1664, C_CIN = 1920, C_CZ = 2176, C_DU = 2432, C_DV = 2688, C_DZ = 2944, C_AG = 3200;

constexpr size_t al(size_t x) { return (x + 255) & ~(size_t)255; }
constexpr size_t OFF_WIN = 0;
constexpr size_t OFF_WOUT = OFF_WIN + al((size_t)4 * NP * 1024 * 2);
constexpr size_t OFF_W1 = OFF_WOUT + al((size_t)4 * 1024 * 1024 * 2);
constexpr size_t OFF_W2 = OFF_W1 + al((size_t)4 * 2 * 256 * 2048 * 2);
constexpr size_t OFF_XB = OFF_W2 + al((size_t)4 * 2 * 64 * 256 * 2);
constexpr size_t OFF_RN = OFF_XB + al((size_t)T_ * 1024 * 2);
constexpr size_t OFF_PROJ = OFF_RN + al((size_t)T_ * 4);
constexpr size_t OFF_SSQ = OFF_PROJ + al((size_t)T_ * NP * 2);
constexpr size_t OFF_KC = OFF_SSQ + al((size_t)T_ * 16 * 4);
constexpr size_t OFF_VCT = OFF_KC + al((size_t)8 * 128 * 64 * 2);
constexpr size_t OFF_OWIN = OFF_VCT + al((size_t)8 * 128 * 64 * 2);
constexpr size_t OFF_ODIL = OFF_OWIN + al((size_t)T_ * 256 * 2);
constexpr size_t OFF_LSE = OFF_ODIL + al((size_t)3 * T_ * 256 * 2);
constexpr size_t OFF_WPT = OFF_LSE + al((size_t)3 * T_ * 4 * 4);
constexpr size_t OFF_WSP = OFF_WPT + al((size_t)16 * 64 * 64 * 2);
constexpr size_t OFF_OUTB = OFF_WSP + al((size_t)16 * 128 * 128 * 2);
constexpr size_t OFF_BAR = OFF_OUTB + al((size_t)T_ * 1024 * 2);
constexpr size_t WS_TOTAL = OFF_BAR + 9 * 16384;
static_assert(WS_TOTAL <= (size_t)256 * 1024 * 1024, "workspace layout exceeds the guaranteed 256 MiB");

struct Params {
  const float *x, *g_pre, *w_in, *pe_cmp, *w_cmp1, *w_cmp2, *w_pool, *pool_scale, *sg_ln_g, *sg_ln_b, *w_sp, *b_sp, *w_out, *g_post;
  float* out;
  char* ws;
};

DI char* opq(char* q) { size_t z = 0; asm volatile("" : "+s"(z)); return q + z; }
DI int tidx() { int t = threadIdx.x; asm volatile("" : "+v"(t)); return t; }
DI float bf2f(u16 v) { return __uint_as_float((unsigned)v << 16); }
DI unsigned pk2(float a, float b) {
  typedef __bf16 bf2 __attribute__((ext_vector_type(2)));
  typedef float f2 __attribute__((ext_vector_type(2)));
  f2 v = {a, b};
  bf2 r = __builtin_convertvector(v, bf2);
  return __builtin_bit_cast(unsigned, r);
}
DI u16 f2bf(float x) { return (u16)(pk2(x, 0.f) & 0xffffu); }
DI float lo16(unsigned w) { return __uint_as_float(w << 16); }
DI float hi16(unsigned w) { return __uint_as_float(w & 0xffff0000u); }
DI int crow(int r, int hi) { return (r & 3) + 8 * (r >> 2) + 4 * hi; }
DI float ex2(float x) { return __builtin_amdgcn_exp2f(x); }
DI float sigmoidf_(float x) { return 1.f / (1.f + __expf(-x)); }
DI float siluf_(float x) { return x / (1.f + __expf(-x)); }
DI float wave_sum(float v) {
#pragma unroll
  for (int o = 32; o >= 1; o >>= 1) v += __shfl_xor(v, o, 64);
  return v;
}
DI bf16x8 pack8(const f32x16& x, int s8) {
  u32x4 p;
  p[0] = pk2(x[8 * s8 + 0], x[8 * s8 + 1]); p[1] = pk2(x[8 * s8 + 2], x[8 * s8 + 3]);
  p[2] = pk2(x[8 * s8 + 4], x[8 * s8 + 5]); p[3] = pk2(x[8 * s8 + 6], x[8 * s8 + 7]);
  return __builtin_bit_cast(bf16x8, p);
}
DI s16x4 trread(const char* p) {
  return __builtin_bit_cast(s16x4, __builtin_amdgcn_ds_read_tr16_b64_v4i16((__attribute__((address_space(3))) v4i16_t*)p));
}


#define XB_TMO      128
#define XB_XCNT(j)  (256  + 64 * (j))
#define XB_XSUB(j)  (1280 + 64 * (j))
#define XB_XGEN(j)  (2304 + 64 * (j))
#define XB_TOP      3328
#define XB_TOPGEN   3392
#define XCD_BAR_WORDS 3456
#define XB_SPIN_CAP (1u << 22)
#define LAS __attribute__((address_space(3)))
DI unsigned xb_ld(unsigned* p)              { return __hip_atomic_load(p, __ATOMIC_RELAXED, __HIP_MEMORY_SCOPE_AGENT); }
DI unsigned xb_add(unsigned* p, unsigned v) { return __hip_atomic_fetch_add(p, v, __ATOMIC_RELAXED, __HIP_MEMORY_SCOPE_AGENT); }
DI unsigned xb_xcc_id() { return (unsigned)__builtin_amdgcn_s_getreg((3 << 11) | 20) & 0xFu; }
#define XB_SPIN(cond, bar) do { unsigned _sp = 0; while (cond) { __builtin_amdgcn_s_sleep(1); \
    if ((++_sp & 255u) == 0u) { if (xb_ld(&(bar)[XB_TMO])) break; if (_sp > XB_SPIN_CAP) { atomicAdd(&(bar)[XB_TMO], 1u); break; } } } } while (0)
struct XcdBarrier { unsigned* bar; unsigned x; volatile LAS unsigned* st; unsigned G; };
DI XcdBarrier xcd_barrier_post(unsigned* bar, volatile LAS unsigned* st, unsigned G) {
    XcdBarrier b; b.bar = bar; b.x = xb_xcc_id(); b.st = st; b.G = G;
    if (threadIdx.x == 0) (void)xb_add(&bar[XB_XCNT(b.x)], 1u);
    return b;
}
DI void xcd_barrier_complete(unsigned* bar, unsigned x, unsigned G, unsigned& nloc, unsigned& nx) {
    unsigned sum, cnt, mine, sp = 0u;
    for (;;) {
        sum = 0u; cnt = 0u; mine = 0u;
#pragma unroll
        for (unsigned j = 0; j < 16; ++j) { const unsigned c = xb_ld(&bar[XB_XCNT(j)]); sum += c; cnt += (c > 0u) ? 1u : 0u; mine = (j == x) ? c : mine; }
        if (sum == G) break;
        __builtin_amdgcn_s_sleep(1);
        if ((++sp & 255u) == 0u) { if (xb_ld(&bar[XB_TMO])) break; if (sp > XB_SPIN_CAP) { atomicAdd(&bar[XB_TMO], 1u); break; } }
    }
    nloc = mine > 0u ? mine : 1u; nx = cnt > 0u ? cnt : 1u;
}
DI void xcd_barrier(const XcdBarrier& b) {
    asm volatile("s_waitcnt vmcnt(0)" ::: "memory");
    __syncthreads();
    if (threadIdx.x == 0) {
        unsigned* bar = b.bar;
        __builtin_amdgcn_s_waitcnt(0);
        unsigned nloc = b.st[0], nx = b.st[1];
        if (nloc == 0u) { xcd_barrier_complete(bar, b.x, b.G, nloc, nx); b.st[0] = nloc; b.st[1] = nx; }
        const unsigned old = xb_add(&bar[XB_XSUB(b.x)], 1u);
        const unsigned gen = old / nloc;
        if (old + 1u == (gen + 1u) * nloc) {
            if (nx > 1u) {
              __builtin_amdgcn_fence(__ATOMIC_RELEASE, "agent");
              asm volatile("s_waitcnt vmcnt(0)" ::: "memory");
              const unsigned og = xb_add(&bar[XB_TOP], 1u);
              const unsigned tg = og / nx;
              if (og + 1u == (tg + 1u) * nx) xb_add(&bar[XB_TOPGEN], 1u);
              else XB_SPIN(xb_ld(&bar[XB_TOPGEN]) == tg, bar);
            }
            __builtin_amdgcn_fence(__ATOMIC_ACQUIRE, "agent");
            xb_add(&bar[XB_XGEN(b.x)], 1u);
            asm volatile("s_waitcnt vmcnt(0)" ::: "memory");
        } else {
            XB_SPIN(xb_ld(&bar[XB_XGEN(b.x)]) == gen, bar);
            __builtin_amdgcn_fence(__ATOMIC_ACQUIRE, "agent");
            asm volatile("s_waitcnt vmcnt(0)" ::: "memory");
        }
    }
    __syncthreads();
}

template <int WGN, int INS, int IMS, bool DB, class LdW, class LdX>
DI void gemm_core(f32x16 (&acc)[INS][IMS], const int KT, LdW ldw, LdX ldx, char* lds, const int tid) {
  constexpr int WGM = 4 / WGN;
  constexpr int WROWS = WGN * 32 * INS, XROWS = WGM * 32 * IMS, NROWS = WROWS + XROWS, NCH = NROWS / 32, NCHW = WROWS / 32, BUFB = NROWS * 144;
  const int lane = tid & 63, wid = tid >> 6, l31 = lane & 31, hi = lane >> 5;
  const int wn = (WGN == 2) ? (wid >> 1) : wid, wm = (WGN == 2) ? (wid & 1) : 0;
  const int offa = (wn * 32 * INS + l31) * 144 + hi * 16;
  const int offb = (WROWS + wm * 32 * IMS + l31) * 144 + hi * 16;
#pragma unroll
  for (int a = 0; a < INS; ++a)
#pragma unroll
    for (int b = 0; b < IMS; ++b)
#pragma unroll
      for (int r = 0; r < 16; ++r) acc[a][b][r] = 0.f;
#define GLOAD(dst, kt_) _Pragma("unroll") for (int i = 0; i < NCH; ++i) { dst[i] = (i < NCHW) ? ldw(i, tid >> 3, (kt_) * 64 + (tid & 7) * 8) : ldx(i - NCHW, tid >> 3, (kt_) * 64 + (tid & 7) * 8); }
#define LSTORE(src, base) _Pragma("unroll") for (int i = 0; i < NCH; ++i) { const int c = tid + 256 * i; *(u32x4*)((base) + (c >> 3) * 144 + (c & 7) * 16) = src[i]; }
#define COMPUTE_PIPE(buf) { const char* pa = (buf) + offa; const char* pb = (buf) + offb; \
    bf16x8 fa[2][INS], fb[2][IMS]; \
    _Pragma("unroll") for (int in = 0; in < INS; ++in) fa[0][in] = *(const bf16x8*)(pa + in * 32 * 144); \
    _Pragma("unroll") for (int im = 0; im < IMS; ++im) fb[0][im] = *(const bf16x8*)(pb + im * 32 * 144); \
    _Pragma("unroll") for (int s = 0; s < 4; ++s) { \
      if (s < 3) { _Pragma("unroll") for (int in = 0; in < INS; ++in) fa[(s + 1) & 1][in] = *(const bf16x8*)(pa + in * 32 * 144 + (s + 1) * 32); \
        _Pragma("unroll") for (int im = 0; im < IMS; ++im) fb[(s + 1) & 1][im] = *(const bf16x8*)(pb + im * 32 * 144 + (s + 1) * 32); } \
      _Pragma("unroll") for (int im = 0; im < IMS; ++im) _Pragma("unroll") for (int in = 0; in < INS; ++in) \
        acc[in][im] = MFMA(fa[s & 1][in], fb[s & 1][im], acc[in][im]); } }
#define COMPUTE_FLAT(buf) { const char* pa = (buf) + offa; const char* pb = (buf) + offb; \
    _Pragma("unroll") for (int s = 0; s < 4; ++s) { \
      bf16x8 fa[INS], fb[IMS]; \
      _Pragma("unroll") for (int in = 0; in < INS; ++in) fa[in] = *(const bf16x8*)(pa + in * 32 * 144 + s * 32); \
      _Pragma("unroll") for (int im = 0; im < IMS; ++im) fb[im] = *(const bf16x8*)(pb + im * 32 * 144 + s * 32); \
      _Pragma("unroll") for (int im = 0; im < IMS; ++im) _Pragma("unroll") for (int in = 0; in < INS; ++in) \
        acc[in][im] = MFMA(fa[in], fb[im], acc[in][im]); } }
  if (DB) {
    u32x4 preA[NCH], preB[NCH];
    GLOAD(preA, 0)
    GLOAD(preB, 1)
    __syncthreads();
    LSTORE(preA, lds)
    __syncthreads();
    for (int kt = 0; kt < KT; kt += 2) {
      if (kt + 2 < KT) { GLOAD(preA, kt + 2) }
      COMPUTE_PIPE(lds)
      LSTORE(preB, lds + BUFB)
      __syncthreads();
      if (kt + 3 < KT) { GLOAD(preB, kt + 3) }
      COMPUTE_PIPE(lds + BUFB)
      if (kt + 2 < KT) { LSTORE(preA, lds) }
      __syncthreads();
    }
  } else {
    u32x4 pre[NCH];
    GLOAD(pre, 0)
    for (int kt = 0; kt < KT; ++kt) {
      __syncthreads();
      LSTORE(pre, lds)
      __syncthreads();
      if (kt + 1 < KT) { GLOAD(pre, kt + 1) }
      if (INS >= 4) COMPUTE_FLAT(lds) else COMPUTE_PIPE(lds)
    }
  }
#undef GLOAD
#undef LSTORE
#undef COMPUTE_PIPE
#undef COMPUTE_FLAT
}

constexpr float M_INIT = -1e29f;
template <class MaskF>
DI void attn_tile(const int tid, const char* ldsK, const char* ldsV, const bf16x8 (&qr)[4], f32x16 (&o)[2], float& m, float& l, const bool MASKED, MaskF mask) {
  const int lane = tid & 63, l31 = lane & 31, hi = lane >> 5;
  f32x16 p0, p1;
#pragma unroll
  for (int r = 0; r < 16; ++r) { p0[r] = 0.f; p1[r] = 0.f; }
  const char* kp = ldsK + l31 * 144 + hi * 16;
#pragma unroll
  for (int s = 0; s < 4; ++s) {
    const bf16x8 k0 = *(const bf16x8*)(kp + s * 32), k1 = *(const bf16x8*)(kp + 32 * 144 + s * 32);
    p0 = MFMA(k0, qr[s], p0); p1 = MFMA(k1, qr[s], p1);
  }
  if (MASKED) {
#pragma unroll
    for (int r = 0; r < 16; ++r) {
      const int kr = crow(r, hi);
      p0[r] = mask(kr) ? p0[r] : NEGB; p1[r] = mask(kr + 32) ? p1[r] : NEGB;
    }
  }
  const char* vb = ldsV + (4 * hi + ((lane & 15) >> 2)) * 144 + ((lane >> 4) & 1) * 32 + (lane & 3) * 8;
  s16x4 vlo[8], vhi[8];
#pragma unroll
  for (int s4 = 0; s4 < 4; ++s4)
#pragma unroll
    for (int db = 0; db < 2; ++db) { vlo[s4 * 2 + db] = trread(vb + (16 * s4) * 144 + db * 64); vhi[s4 * 2 + db] = trread(vb + (16 * s4 + 8) * 144 + db * 64); }
  __builtin_amdgcn_sched_barrier(0);
  float mx = fmaxf(p0[0], p1[0]);
#pragma unroll
  for (int r = 1; r < 16; ++r) mx = fmaxf(fmaxf(mx, p0[r]), p1[r]);
  { auto rr = __builtin_amdgcn_permlane32_swap(__float_as_uint(mx), __float_as_uint(mx), false, false); mx = fmaxf(__uint_as_float(rr[0]), __uint_as_float(rr[1])); }
  const float mxs = mx * C2;
  if (__any(mxs > m + 8.f)) {
    const float mn = fmaxf(m, mxs), alpha = ex2(m - mn);
    m = mn; l *= alpha;
#pragma unroll
    for (int r = 0; r < 16; ++r) { o[0][r] *= alpha; o[1][r] *= alpha; }
  }
  const float nm = -m;
  float rs = 0.f;
#pragma unroll
  for (int r = 0; r < 16; ++r) { p0[r] = ex2(__builtin_fmaf(p0[r], C2, nm)); p1[r] = ex2(__builtin_fmaf(p1[r], C2, nm)); rs += p0[r] + p1[r]; }
  l += rs;
  bf16x8 pw[4];
  pw[0] = pack8(p0, 0); pw[1] = pack8(p0, 1); pw[2] = pack8(p1, 0); pw[3] = pack8(p1, 1);
#pragma unroll
  for (int s4 = 0; s4 < 4; ++s4) {
#pragma unroll
    for (int db = 0; db < 2; ++db) {
      const s16x4 lo = vlo[s4 * 2 + db], hh = vhi[s4 * 2 + db];
      const bf16x8 vf = {lo[0], lo[1], lo[2], lo[3], hh[0], hh[1], hh[2], hh[3]};
      o[db] = MFMA(vf, pw[s4], o[db]);
    }
  }
}

template <class RowF>
DI void kv_load(const int tid, u32x4 (&pre)[4], RowF rowtok, const u16* proj, int kcol, int vcol) {
#pragma unroll
  for (int i = 0; i < 2; ++i) {
    const int c = tid + 256 * i, row = c >> 3, ch = c & 7;
    const u16* p = proj + (size_t)rowtok(row) * NP + ch * 8;
    pre[i] = *(const u32x4*)(p + kcol); pre[2 + i] = *(const u32x4*)(p + vcol);
  }
}
DI void kv_store(const int tid, const u32x4 (&pre)[4], char* ldsK, char* ldsV) {
#pragma unroll
  for (int i = 0; i < 2; ++i) {
    const int c = tid + 256 * i, row = c >> 3, ch = c & 7;
    *(u32x4*)(ldsK + row * 144 + ch * 16) = pre[i]; *(u32x4*)(ldsV + row * 144 + ch * 16) = pre[2 + i];
  }
}

template <class RowF, class FullF, class MaskF>
DI void attn_stream(const int tid, const u16* proj, const int kcol, const int vcol, const int nt, RowF rowtok, FullF full, MaskF mask,
                    const bf16x8 (&qr)[4], f32x16 (&o)[2], float& m, float& l, char* lds) {
  u32x4 preA[4], preB[4];
  if (nt > 0) kv_load(tid, preA, [&](int row) { return rowtok(0, row); }, proj, kcol, vcol);
  if (nt > 1) kv_load(tid, preB, [&](int row) { return rowtok(1, row); }, proj, kcol, vcol);
  for (int ti = 0; ti < nt; ti += 2) {
    kv_store(tid, preA, lds, lds + 9216);
    __syncthreads();
    if (ti + 2 < nt) kv_load(tid, preA, [&](int row) { return rowtok(ti + 2, row); }, proj, kcol, vcol);
    attn_tile(tid, lds, lds + 9216, qr, o, m, l, !full(ti), [&](int kr) { return mask(ti, kr); });
    if (ti + 1 < nt) {
      kv_store(tid, preB, lds + 18432, lds + 27648);
      __syncthreads();
      if (ti + 3 < nt) kv_load(tid, preB, [&](int row) { return rowtok(ti + 3, row); }, proj, kcol, vcol);
      attn_tile(tid, lds + 18432, lds + 27648, qr, o, m, l, !full(ti + 1), [&](int kr) { return mask(ti + 1, kr); });
    }
  }
}

DI int mapcol(int n, int mode) {
  if (mode == 0) return n;
  if (n < 640) return n;
  if (n < 3200) return n + 12;
  if (n < 3212) return n - 3200 + 640;
  return -1;
}
DI void tr_tile(const float* src, int ldsrc, u16* dst, int ldd, int k0, int n0, const float* g, int mode, char* lds) {
  float* t = (float*)lds;
  const int tid = threadIdx.x;
  float v[16];
#pragma unroll
  for (int i = 0; i < 16; ++i) {
    const int e = tid + 256 * i, kk = e >> 6, nn = e & 63;
    const int sc = mapcol(n0 + nn, mode);
    v[i] = sc >= 0 ? src[(size_t)(k0 + kk) * ldsrc + sc] : 0.f;
  }
  if (g) {
#pragma unroll
    for (int i = 0; i < 16; ++i) v[i] *= g[k0 + ((tid + 256 * i) >> 6)];
  }
#pragma unroll
  for (int i = 0; i < 16; ++i) { const int e = tid + 256 * i, kk = e >> 6, nn = e & 63; t[kk * 65 + nn] = v[i]; }
  __syncthreads();
#pragma unroll
  for (int i = 0; i < 2; ++i) {
    const int e = tid + 256 * i, nn = e >> 3, k8 = (e & 7) * 8;
    u32x4 o;
    o[0] = pk2(t[(k8 + 0) * 65 + nn], t[(k8 + 1) * 65 + nn]); o[1] = pk2(t[(k8 + 2) * 65 + nn], t[(k8 + 3) * 65 + nn]);
    o[2] = pk2(t[(k8 + 4) * 65 + nn], t[(k8 + 5) * 65 + nn]); o[3] = pk2(t[(k8 + 6) * 65 + nn], t[(k8 + 7) * 65 + nn]);
    *(u32x4*)(dst + (size_t)(n0 + nn) * ldd + k0 + k8) = o;
  }
  __syncthreads();
}

template <int NR>
DI void rows_convert(const float* x0, u16* xb0, float* rn0) {
  const int lane = tidx() & 63;
  f32x4 v[NR][4];
#pragma unroll
  for (int r = 0; r < NR; ++r)
#pragma unroll
    for (int i = 0; i < 4; ++i) v[r][i] = *(const f32x4*)(x0 + (size_t)r * 1024 + i * 256 + lane * 4);
#pragma unroll
  for (int r = 0; r < NR; ++r) {
    float ss = 0.f;
#pragma unroll
    for (int i = 0; i < 4; ++i) {
      ss += v[r][i][0] * v[r][i][0] + v[r][i][1] * v[r][i][1] + v[r][i][2] * v[r][i][2] + v[r][i][3] * v[r][i][3];
      u32x2 o; o[0] = pk2(v[r][i][0], v[r][i][1]); o[1] = pk2(v[r][i][2], v[r][i][3]);
      *(u32x2*)(xb0 + (size_t)r * 1024 + i * 256 + lane * 4) = o;
    }
    ss = wave_sum(ss);
    if (lane == 0) rn0[r] = rsqrtf(ss * (1.f / 1024.f) + 1e-6f);
  }
}

template <int NTW>
DI void inproj_tile(const Params& p, int l, int mt, int ntile, char* lds) {
  char* const ws_ = opq(p.ws);
  const u16* W = (const u16*)(ws_ + OFF_WIN) + ((size_t)l * NP + ntile * 64 * NTW) * 1024;
  const u16* X = (const u16*)(ws_ + OFF_XB) + (size_t)mt * 128 * 1024;
  f32x16 acc[NTW][2];
  const int tid = tidx();
  gemm_core<2, NTW, 2, (NTW == 2)>(acc, 16, [&](int i, int r0, int k) -> u32x4 { return *(const u32x4*)((W + i * 32768) + (unsigned)(r0 * 1024 + k)); },
               [&](int i, int r0, int k) -> u32x4 { return *(const u32x4*)((X + i * 32768) + (unsigned)(r0 * 1024 + k)); }, lds, tid);
  const int lane = tid & 63, wid = tid >> 6, l31 = lane & 31, hi = lane >> 5, wn = wid >> 1, wm = wid & 1;
  const float* rn = (const float*)(ws_ + OFF_RN);
  u16* proj = (u16*)(ws_ + OFF_PROJ);
  constexpr int NCOLS = 64 * NTW, RS = NCOLS * 2 + 16;
  __syncthreads();
#pragma unroll
  for (int im = 0; im < 2; ++im) {
    const int tl = wm * 64 + im * 32 + l31;
    const float r = rn[(size_t)mt * 128 + tl];
#pragma unroll
    for (int in = 0; in < NTW; ++in)
#pragma unroll
      for (int g = 0; g < 4; ++g) {
        const int n = wn * 32 * NTW + in * 32 + 8 * g + 4 * hi;
        u32x2 o; o[0] = pk2(acc[in][im][4 * g] * r, acc[in][im][4 * g + 1] * r); o[1] = pk2(acc[in][im][4 * g + 2] * r, acc[in][im][4 * g + 3] * r);
        *(u32x2*)(lds + tl * RS + n * 2) = o;
      }
  }
  __syncthreads();
#pragma unroll 4
  for (int i = 0; i < NCOLS / 16; ++i) {
    const int c = tid + 256 * i, tl = c / (NCOLS / 8), ch = c % (NCOLS / 8);
    const u32x4 v = *(const u32x4*)(lds + tl * RS + ch * 16);
    *(u32x4*)(proj + ((size_t)mt * 128 + tl) * NP + ntile * NCOLS + ch * 8) = v;
  }
}

DI void outproj_item(const Params& p, int l, int it, char* lds) {
  char* const ws_ = opq(p.ws);
  const int mt = (it & 7) * 16 + ((it >> 3) & 15), nt = it >> 7;
  const u16* W = (const u16*)(ws_ + OFF_WOUT) + ((size_t)l * 1024 + nt * 256) * 1024;
  const u16* Y = (const u16*)(ws_ + OFF_XB) + (size_t)mt * 128 * 1024;
  f32x16 acc[4][2];
  const int tid = tidx();
  gemm_core<2, 4, 2, false>(acc, 16, [&](int i, int r0, int k) -> u32x4 { return *(const u32x4*)((W + i * 32768) + (unsigned)(r0 * 1024 + k)); },
               [&](int i, int r0, int k) -> u32x4 { return *(const u32x4*)((Y + i * 32768) + (unsigned)(r0 * 1024 + k)); }, lds, tid);
  const int lane = tid & 63, wid = tid >> 6, l31 = lane & 31, hi = lane >> 5, wn = wid >> 1, wm = wid & 1;
  u16* outb = (u16*)(ws_ + OFF_OUTB);
  float* ssq = (float*)(ws_ + OFF_SSQ);
  constexpr int RS = 256 * 2 + 16;
  __syncthreads();
#pragma unroll
  for (int im = 0; im < 2; ++im) {
    const int tl = wm * 64 + im * 32 + l31;
    float ss = 0.f;
#pragma unroll
    for (int in = 0; in < 4; ++in)
#pragma unroll
      for (int g = 0; g < 4; ++g) {
        const int n = wn * 128 + in * 32 + 8 * g + 4 * hi;
        const float o0 = acc[in][im][4 * g], o1 = acc[in][im][4 * g + 1], o2 = acc[in][im][4 * g + 2], o3 = acc[in][im][4 * g + 3];
        ss += o0 * o0 + o1 * o1 + o2 * o2 + o3 * o3;
        u32x2 v; v[0] = pk2(o0, o1); v[1] = pk2(o2, o3);
        *(u32x2*)(lds + tl * RS + n * 2) = v;
      }
    ss += __shfl_xor(ss, 32, 64);
    if (hi == 0) ssq[((size_t)mt * 128 + tl) * 16 + nt * 2 + wn] = ss;
  }
  __syncthreads();
#pragma unroll 4
  for (int i = 0; i < 16; ++i) {
    const int c = tid + 256 * i, tl = c >> 5, ch = c & 31;
    const u32x4 v = *(const u32x4*)(lds + tl * RS + ch * 16);
    *(u32x4*)(outb + ((size_t)mt * 128 + tl) * 1024 + nt * 256 + ch * 8) = v;
  }
}

template <int NR>
DI void resid_rows(const Params& p, int l, int row0, const float* xin) {
  char* const ws_ = opq(p.ws);
  const int lane = tidx() & 63;
  const u16* outb = (const u16*)(ws_ + OFF_OUTB);
  const float* ssq = (const float*)(ws_ + OFF_SSQ);
  u32x2 ob[NR][4]; f32x4 xv[NR][4]; f32x4 sq[NR][2];
#pragma unroll
  for (int r = 0; r < NR; ++r) {
    const size_t row = (size_t)(row0 + r);
    sq[r][0] = *(const f32x4*)(ssq + row * 16); sq[r][1] = *(const f32x4*)(ssq + row * 16 + 4);
#pragma unroll
    for (int i = 0; i < 4; ++i) { const int idx = i * 256 + lane * 4; ob[r][i] = *(const u32x2*)(outb + row * 1024 + idx); xv[r][i] = *(const f32x4*)(xin + row * 1024 + idx); }
  }
  f32x4 gq[4];
#pragma unroll
  for (int i = 0; i < 4; ++i) gq[i] = *(const f32x4*)(p.g_post + l * 1024 + i * 256 + lane * 4);
  u16* xb = (u16*)(ws_ + OFF_XB);
#pragma unroll
  for (int r = 0; r < NR; ++r) {
    const size_t row = (size_t)(row0 + r);
    const float ss = ((sq[r][0][0] + sq[r][0][1]) + (sq[r][0][2] + sq[r][0][3])) + ((sq[r][1][0] + sq[r][1][1]) + (sq[r][1][2] + sq[r][1][3]));
    const float r2 = rsqrtf(ss * (1.f / 1024.f) + 1e-6f);
    float s2 = 0.f;
#pragma unroll
    for (int i = 0; i < 4; ++i) {
      const int idx = i * 256 + lane * 4;
      const f32x4 o = {lo16(ob[r][i][0]), hi16(ob[r][i][0]), lo16(ob[r][i][1]), hi16(ob[r][i][1])};
      f32x4 xn;
#pragma unroll
      for (int e = 0; e < 4; ++e) { xn[e] = xv[r][i][e] + o[e] * r2 * gq[i][e]; s2 += xn[e] * xn[e]; }
      *(f32x4*)(p.out + row * 1024 + idx) = xn;
      if (l < 3) { u32x2 o2; o2[0] = pk2(xn[0], xn[1]); o2[1] = pk2(xn[2], xn[3]); *(u32x2*)(xb + row * 1024 + idx) = o2; }
    }
    s2 = wave_sum(s2);
    if (lane == 0) ((float*)(ws_ + OFF_RN))[row] = rsqrtf(s2 * (1.f / 1024.f) + 1e-6f);
  }
}

DI void cmp_item(const Params& p, int l, int it, char* lds) {
  char* const ws_ = opq(p.ws);
  const int j = it >> 5, mt = (it & 7) * 4 + ((it >> 3) & 3);
  const u16* proj = (const u16*)(ws_ + OFF_PROJ);
  const u16* W1 = (const u16*)(ws_ + OFF_W1) + (size_t)(l * 2 + j) * 256 * 2048;
  const u16* W2 = (const u16*)(ws_ + OFF_W2) + (size_t)(l * 2 + j) * 64 * 256;
  const float* pe = p.pe_cmp + (size_t)(l * 2 + j) * 32 * 64;
  const int kvcol = C_KCMP + 64 * j;
  f32x16 acc[2][1];
  const int tid = tidx();
  gemm_core<4, 2, 1, false>(acc, 32, [&](int i, int r0, int k) -> u32x4 { return *(const u32x4*)((W1 + i * 65536) + (unsigned)(r0 * 2048 + k)); },
   [&](int i, int row, int k) -> u32x4 {
    const int rr = mt * 32 + row, b = rr >> 7; int n = rr & 127; if (n > 126) n = 126;
    const int l32 = k >> 6, d = k & 63;
    const u32x4 raw = *(const u32x4*)(proj + ((size_t)b * S_ + 16 * n + l32) * NP + kvcol + d);
    const f32x4 e0 = *(const f32x4*)(pe + l32 * 64 + d), e1 = *(const f32x4*)(pe + l32 * 64 + d + 4);
    u32x4 o;
    o[0] = pk2(lo16(raw[0]) + e0[0], hi16(raw[0]) + e0[1]); o[1] = pk2(lo16(raw[1]) + e0[2], hi16(raw[1]) + e0[3]);
    o[2] = pk2(lo16(raw[2]) + e1[0], hi16(raw[2]) + e1[1]); o[3] = pk2(lo16(raw[3]) + e1[2], hi16(raw[3]) + e1[3]);
    return o; }, lds, tid);
  const int lane = tid & 63, wid = tid >> 6, l31 = lane & 31, hi = lane >> 5;
#pragma unroll
  for (int a = 0; a < 2; ++a)
#pragma unroll
    for (int r = 0; r < 16; ++r) {
      const float x = acc[a][0][r]; const float u = 0.7978845608028654f * (x + 0.044715f * x * x * x);
      acc[a][0][r] = x / (1.f + __expf(-2.f * u));
    }
  f32x16 c2[2];
#pragma unroll
  for (int r = 0; r < 16; ++r) { c2[0][r] = 0.f; c2[1][r] = 0.f; }
#pragma unroll
  for (int in = 0; in < 2; ++in)
#pragma unroll
    for (int s2 = 0; s2 < 2; ++s2) {
      const bf16x8 h0 = pack8(acc[in][0], s2);
#pragma unroll
      for (int dt = 0; dt < 2; ++dt) {
        const u16* wp = W2 + (size_t)(dt * 32 + l31) * 256 + wid * 64 + in * 32 + 16 * s2 + 4 * hi;
        const s16x4 lo = *(const s16x4*)wp, hh = *(const s16x4*)(wp + 8);
        const bf16x8 wf = {lo[0], lo[1], lo[2], lo[3], hh[0], hh[1], hh[2], hh[3]};
        c2[dt] = MFMA(wf, h0, c2[dt]);
      }
    }
  float* red = (float*)lds;
  __syncthreads();
  for (int w = 0; w < 4; ++w) {
    if (wid == w) {
#pragma unroll
      for (int dt = 0; dt < 2; ++dt)
#pragma unroll
        for (int r = 0; r < 16; ++r) {
          float* q = red + (dt * 32 + crow(r, hi)) * 32 + l31;
          if (w == 0) *q = c2[dt][r]; else *q += c2[dt][r];
        }
    }
    __syncthreads();
  }
  u16* kc = (u16*)(ws_ + OFF_KC); u16* vct = (u16*)(ws_ + OFF_VCT);
#pragma unroll 4
  for (int i = 0; i < 8; ++i) {
    const int e = tid + 256 * i;
    if (j == 0) { const int tok = e >> 6, d = e & 63; const int rr = mt * 32 + tok; kc[(size_t)rr * 64 + d] = f2bf(red[d * 32 + tok]); }
    else { const int d = e >> 5, tok = e & 31; const int rr = mt * 32 + tok, b = rr >> 7, n = rr & 127; vct[((size_t)b * 64 + d) * 128 + n] = f2bf(red[d * 32 + tok]); }
  }
  __syncthreads();
}

DI void win_item(const Params& p, int it, char* lds) {
  char* const ws_ = opq(p.ws);
  const int b = it & 7, qt = it >> 3, q0 = qt * 32;
  const int tid = tidx(), lane = tid & 63, h = tid >> 6, l31 = lane & 31, hi = lane >> 5;
  const u16* proj = (const u16*)(ws_ + OFF_PROJ);
  const int t = q0 + l31; const size_t tok = (size_t)b * S_ + t;
  bf16x8 qr[4];
#pragma unroll
  for (int s = 0; s < 4; ++s) qr[s] = *(const bf16x8*)(proj + tok * NP + C_AQ + h * 64 + 16 * s + 8 * hi);
  char* ldsK = lds; char* ldsV = lds + 9216;
  f32x16 o[2];
#pragma unroll
  for (int r = 0; r < 16; ++r) { o[0][r] = 0.f; o[1][r] = 0.f; }
  float m = M_INIT, lsum = 0.f;
  const int klo = (q0 - 511 > 0 ? q0 - 511 : 0) >> 6, khi = (q0 + 31) >> 6;
  __syncthreads();
  attn_stream(tid, proj, C_KWIN, C_VWIN, khi - klo + 1,
              [&](int ti, int row) { return b * S_ + (klo + ti) * 64 + row; },
              [&](int ti) { const int k0 = (klo + ti) * 64; return (k0 + 63 <= q0) && (k0 >= q0 + 31 - 511); },
              [&](int ti, int kr) { return (unsigned)(t - ((klo + ti) * 64 + kr)) <= 511u; },
              qr, o, m, lsum, lds);
  lsum += __shfl_xor(lsum, 32, 64);
  const float il = 1.f / lsum;
  u16* ow = (u16*)(ws_ + OFF_OWIN);
#pragma unroll
  for (int db = 0; db < 2; ++db)
#pragma unroll
    for (int g = 0; g < 4; ++g) {
      const int d0 = 32 * db + 8 * g + 4 * hi;
      u32x2 v; v[0] = pk2(o[db][4 * g] * il, o[db][4 * g + 1] * il); v[1] = pk2(o[db][4 * g + 2] * il, o[db][4 * g + 3] * il);
      *(u32x2*)(ow + tok * 256 + h * 64 + d0) = v;
    }
}

DI void dil_item(const Params& p, int it, char* lds) {
  char* const ws_ = opq(p.ws);
  const int di = it >> 9, rem = it & 511, b = rem & 7, h = (rem >> 3) & 3, c = rem >> 5;
  const int sh = 2 * di, dil = 1 << sh;
  const int tpr = 16 >> sh;
  const int r = c / tpr, mt = c % tpr, m0 = mt * 128;
  const int tid = tidx(), lane = tid & 63, wid = tid >> 6, l31 = lane & 31, hi = lane >> 5;
  const u16* proj = (const u16*)(ws_ + OFF_PROJ);
  const int mq = m0 + 32 * wid + l31;
  const size_t tok = (size_t)b * S_ + mq * dil + r;
  bf16x8 qr[4];
#pragma unroll
  for (int s = 0; s < 4; ++s) qr[s] = *(const bf16x8*)(proj + tok * NP + C_BQ + h * 64 + 16 * s + 8 * hi);
  const int tt0 = (m0 == 0) ? 2 : 0;
  {
    u32x4 pre[4][4];
#pragma unroll
    for (int tt = 0; tt < 4; ++tt)
      if (tt >= tt0) kv_load(tid, pre[tt], [&](int row) { return b * S_ + (m0 - 128 + 64 * tt + row) * dil + r; }, proj, C_BK + h * 64, C_BV + h * 64);
    __syncthreads();
#pragma unroll
    for (int tt = 0; tt < 4; ++tt)
      if (tt >= tt0) kv_store(tid, pre[tt], lds + tt * 18432, lds + tt * 18432 + 9216);
    __syncthreads();
  }
  f32x16 o[2];
#pragma unroll
  for (int rr = 0; rr < 16; ++rr) { o[0][rr] = 0.f; o[1][rr] = 0.f; }
  float m = M_INIT, lsum = 0.f;
  const int widu = __builtin_amdgcn_readfirstlane(wid);
  const int wlo = m0 + 32 * widu - 128, whi = m0 + 32 * widu + 31;
  for (int tt = tt0; tt < 4; ++tt) {
    const int tk0 = m0 - 128 + 64 * tt;
    if (tk0 + 63 >= wlo && tk0 <= whi) {
      attn_tile(tid, lds + tt * 18432, lds + tt * 18432 + 9216, qr, o, m, lsum, !(tk0 + 63 <= wlo + 128 && tk0 >= whi - 128), [&](int kr) { return (unsigned)(mq - (tk0 + kr)) <= 128u; });
    }
  }
  lsum += __shfl_xor(lsum, 32, 64);
  const float il = 1.f / lsum;
  u16* od = (u16*)(ws_ + OFF_ODIL) + (size_t)di * T_ * 256;
#pragma unroll
  for (int db = 0; db < 2; ++db)
#pragma unroll
    for (int g = 0; g < 4; ++g) {
      const int d0 = 32 * db + 8 * g + 4 * hi;
      u32x2 v; v[0] = pk2(o[db][4 * g] * il, o[db][4 * g + 1] * il); v[1] = pk2(o[db][4 * g + 2] * il, o[db][4 * g + 3] * il);
      *(u32x2*)(od + tok * 256 + h * 64 + d0) = v;
    }
  if (hi == 0) ((float*)(ws_ + OFF_LSE))[((size_t)di * T_ + tok) * 4 + h] = m * 0.6931471805599453f + __logf(lsum);
}

DI void pool_item(const Params& p, int l, int it, char* lds) {
  char* const ws_ = opq(p.ws);
  const int b = it & 7, qt = it >> 3, q0 = qt * 32;
  const int tid = tidx(), lane = tid & 63, g = tid >> 6, l31 = lane & 31, hi = lane >> 5;
  const u16* proj = (const u16*)(ws_ + OFF_PROJ);
  u16* cin = (u16*)lds;
  char* pl = lds + 48 * 512;
  u32x4 cv[6];
#pragma unroll
  for (int i = 0; i < 6; ++i) {
    const int c = tid + 256 * i, row = c >> 5, ch = c & 31; const int t = q0 - 16 + row;
    cv[i] = u32x4{0u, 0u, 0u, 0u};
    if (t >= 0) cv[i] = *(const u32x4*)(proj + ((size_t)b * S_ + t) * NP + C_CIN + ch * 8);
  }
  const u16* wpt = (const u16*)(ws_ + OFF_WPT) + (size_t)(l * 4 + g) * 4096;
  bf16x8 af[8];
#pragma unroll
  for (int q = 0; q < 8; ++q) af[q] = *(const bf16x8*)(wpt + ((q & 1) * 32 + l31) * 64 + 16 * (q >> 1) + 8 * hi);
  const size_t tok = (size_t)b * S_ + q0 + l31;
  f32x4 psv[8]; u32x2 zv[8];
#pragma unroll
  for (int q = 0; q < 8; ++q) {
    const int col = g * 64 + (q >> 2) * 32 + 8 * (q & 3) + 4 * hi;
    psv[q] = *(const f32x4*)(p.pool_scale + l * 256 + col); zv[q] = *(const u32x2*)(proj + tok * NP + C_CZ + col);
  }
  __syncthreads();
#pragma unroll
  for (int i = 0; i < 6; ++i) { const int c = tid + 256 * i, row = c >> 5, ch = c & 31; *(u32x4*)(cin + row * 256 + ch * 8) = cv[i]; }
  __syncthreads();
  {
    const int ch = tid, w = 2 << g;
    float s = 0.f;
    for (int r = 17 - w; r <= 16; ++r) s += bf2f(cin[r * 256 + ch]);
#pragma unroll 4
    for (int i = 0; i < 32; ++i) {
      const int t = q0 + i; const int cnt = (t + 1 < w) ? t + 1 : w;
      const float self = bf2f(cin[(i + 16) * 256 + ch]);
      *(u16*)(pl + i * 528 + ch * 2) = f2bf(s / (float)cnt - self);
      s += bf2f(cin[(i + 17) * 256 + ch]) - bf2f(cin[(i + 17 - w) * 256 + ch]);
    }
  }
  __syncthreads();
  f32x16 acc[2];
#pragma unroll
  for (int r = 0; r < 16; ++r) { acc[0][r] = 0.f; acc[1][r] = 0.f; }
#pragma unroll
  for (int s4 = 0; s4 < 4; ++s4) {
    const bf16x8 bf = *(const bf16x8*)(pl + l31 * 528 + (g * 64 + 16 * s4 + 8 * hi) * 2);
#pragma unroll
    for (int dt = 0; dt < 2; ++dt) acc[dt] = MFMA(af[s4 * 2 + dt], bf, acc[dt]);
  }
  u16* y = (u16*)(ws_ + OFF_XB);
#pragma unroll
  for (int dt = 0; dt < 2; ++dt)
#pragma unroll
    for (int g4 = 0; g4 < 4; ++g4) {
      const int col = g * 64 + dt * 32 + 8 * g4 + 4 * hi;
      const f32x4 ps = psv[dt * 4 + g4];
      const u32x2 z = zv[dt * 4 + g4];
      u32x2 v;
      v[0] = pk2(acc[dt][4 * g4] * ps[0] * siluf_(lo16(z[0])), acc[dt][4 * g4 + 1] * ps[1] * siluf_(hi16(z[0])));
      v[1] = pk2(acc[dt][4 * g4 + 2] * ps[2] * siluf_(lo16(z[1])), acc[dt][4 * g4 + 3] * ps[3] * siluf_(hi16(z[1])));
      *(u32x2*)(y + tok * 1024 + 512 + col) = v;
    }
}

DI void sgu_item(const Params& p, int l, int it, char* lds) {
  char* const ws_ = opq(p.ws);
  const int b = it & 7, c = (it >> 5) & 15, g = (it >> 3) & 3, t0 = c * 128;
  const int tid = tidx(), lane = tid & 63, l31 = lane & 31, hi = lane >> 5;
  const int wid = __builtin_amdgcn_readfirstlane(tid >> 6);
  const u16* proj = (const u16*)(ws_ + OFF_PROJ);
  char* vn = lds;
  __syncthreads();
  {
    const int j = tid >> 1, half = tid & 1;
    const u16* vp = proj + ((size_t)b * S_ + t0 + j) * NP + C_DV + half * 128;
    u32x4 raw[16];
#pragma unroll
    for (int i = 0; i < 16; ++i) raw[i] = *(const u32x4*)(vp + i * 8);
    float s1 = 0.f;
#pragma unroll
    for (int i = 0; i < 16; ++i)
#pragma unroll
      for (int e = 0; e < 4; ++e) s1 += lo16(raw[i][e]) + hi16(raw[i][e]);
    s1 += __shfl_xor(s1, 1, 64);
    const float mu = s1 * (1.f / 256.f);
    float s2 = 0.f;
#pragma unroll
    for (int i = 0; i < 16; ++i)
#pragma unroll
      for (int e = 0; e < 4; ++e) { const float a = lo16(raw[i][e]) - mu, bb = hi16(raw[i][e]) - mu; s2 += a * a + bb * bb; }
    s2 += __shfl_xor(s2, 1, 64);
    const float rstd = rsqrtf(s2 * (1.f / 256.f) + 1e-5f);
    if (half == (g >> 1)) {
      const float* lg = p.sg_ln_g + l * 256 + g * 64; const float* lb = p.sg_ln_b + l * 256 + g * 64;
      auto emit = [&](const u32x4& r, int i) {
        const f32x4 g0 = *(const f32x4*)(lg + i * 8), g1 = *(const f32x4*)(lg + i * 8 + 4), b0 = *(const f32x4*)(lb + i * 8), b1 = *(const f32x4*)(lb + i * 8 + 4);
        u32x4 o;
        o[0] = pk2((lo16(r[0]) - mu) * rstd * g0[0] + b0[0], (hi16(r[0]) - mu) * rstd * g0[1] + b0[1]);
        o[1] = pk2((lo16(r[1]) - mu) * rstd * g0[2] + b0[2], (hi16(r[1]) - mu) * rstd * g0[3] + b0[3]);
        o[2] = pk2((lo16(r[2]) - mu) * rstd * g1[0] + b1[0], (hi16(r[2]) - mu) * rstd * g1[1] + b1[1]);
        o[3] = pk2((lo16(r[3]) - mu) * rstd * g1[2] + b1[2], (hi16(r[3]) - mu) * rstd * g1[3] + b1[3]);
        *(u32x4*)(vn + j * 144 + i * 16) = o;
      };
      if (g & 1) {
#pragma unroll
        for (int i = 0; i < 8; ++i) emit(raw[8 + i], i);
      } else {
#pragma unroll
        for (int i = 0; i < 8; ++i) emit(raw[i], i);
      }
    }
  }
  __syncthreads();
  const int i = wid * 32 + l31;
  const u16* wsp = (const u16*)(ws_ + OFF_WSP) + ((size_t)(l * 4 + g) * 128 + i) * 128;
  f32x16 acc[2];
#pragma unroll
  for (int r = 0; r < 16; ++r) { acc[0][r] = 0.f; acc[1][r] = 0.f; }
  const int nks = 2 * (wid + 1);
  bf16x8 wfr[8];
#pragma unroll
  for (int s = 0; s < 8; ++s) { if (s < nks) wfr[s] = *(const bf16x8*)(wsp + 16 * s + 8 * hi); else wfr[s] = bf16x8{0, 0, 0, 0, 0, 0, 0, 0}; }
  const char* vb = vn + (8 * hi + ((lane & 15) >> 2)) * 144 + ((lane >> 4) & 1) * 32 + (lane & 3) * 8;
#pragma unroll
  for (int s = 0; s < 8; ++s) {
    if (s < nks) {
#pragma unroll
      for (int ct = 0; ct < 2; ++ct) {
        const s16x4 lo = trread(vb + (16 * s) * 144 + ct * 64), hh = trread(vb + (16 * s + 4) * 144 + ct * 64);
        const bf16x8 af = {lo[0], lo[1], lo[2], lo[3], hh[0], hh[1], hh[2], hh[3]};
        acc[ct] = MFMA(af, wfr[s], acc[ct]);
      }
    }
  }
  const size_t tok = (size_t)b * S_ + t0 + i;
  const float bs = p.b_sp[(l * 4 + g) * 128 + i];
  u16* y = (u16*)(ws_ + OFF_XB);
#pragma unroll
  for (int ct = 0; ct < 2; ++ct)
#pragma unroll
    for (int g4 = 0; g4 < 4; ++g4) {
      const int col = g * 64 + ct * 32 + 8 * g4 + 4 * hi;
      const u32x2 u = *(const u32x2*)(proj + tok * NP + C_DU + col), z = *(const u32x2*)(proj + tok * NP + C_DZ + col);
      u32x2 v;
      v[0] = pk2(lo16(u[0]) * (acc[ct][4 * g4] + bs) * siluf_(lo16(z[0])), hi16(u[0]) * (acc[ct][4 * g4 + 1] + bs) * siluf_(hi16(z[0])));
      v[1] = pk2(lo16(u[1]) * (acc[ct][4 * g4 + 2] + bs) * siluf_(lo16(z[1])), hi16(u[1]) * (acc[ct][4 * g4 + 3] + bs) * siluf_(hi16(z[1])));
      *(u32x2*)(y + tok * 1024 + 768 + col) = v;
    }
}

DI void nsa_item(const Params& p, int it, char* lds) {
  char* const ws_ = opq(p.ws);
  const int b = it & 7, qt = 63 - (it >> 3), q0 = qt * 32;
  const int tid = tidx(), lane = tid & 63, h = tid >> 6, l31 = lane & 31, hi = lane >> 5;
  const u16* proj = (const u16*)(ws_ + OFF_PROJ);
  const int t = q0 + l31; const size_t tok = (size_t)b * S_ + t;
  bf16x8 qr[4];
#pragma unroll
  for (int s = 0; s < 4; ++s) qr[s] = *(const bf16x8*)(proj + tok * NP + C_AQ + h * 64 + 16 * s + 8 * hi);
  char* ldsK = lds; char* ldsV = lds + 9216;
  float* impS = (float*)(lds + 36864);
  float* vals = (float*)(lds + 36864 + 16384);
  unsigned* selm = (unsigned*)(lds + 73728 - 256);
  int* jlist = (int*)(lds + 73728 - 128);
  float* yst = (float*)(lds + 36864);
  __syncthreads();
  if (tid < 32) selm[tid] = 0u;
  const float g0 = sigmoidf_(bf2f(proj[tok * NP + C_AG + 0 + h])), g1 = sigmoidf_(bf2f(proj[tok * NP + C_AG + 4 + h])), g2 = sigmoidf_(bf2f(proj[tok * NP + C_AG + 8 + h]));
  f32x16 ya[2];
  {
    const u16* kc = (const u16*)(ws_ + OFF_KC); const u16* vct = (const u16*)(ws_ + OFF_VCT);
    f32x16 sc[4];
    const int nkb = (((q0 + 31 - 31) >> 4) >> 5) + 1;
#pragma unroll
    for (int kb = 0; kb < 4; ++kb) {
#pragma unroll
      for (int r = 0; r < 16; ++r) sc[kb][r] = 0.f;
      if (kb < nkb) {
#pragma unroll
        for (int s = 0; s < 4; ++s) {
          const bf16x8 kf = *(const bf16x8*)(kc + ((size_t)(b * 128 + kb * 32 + l31)) * 64 + 16 * s + 8 * hi);
          sc[kb] = MFMA(kf, qr[s], sc[kb]);
        }
      }
    }
    s16x4 vcl[16], vch[16];
#pragma unroll
    for (int q = 0; q < 16; ++q) {
      const int kb = q >> 2, s2 = (q >> 1) & 1, db = q & 1;
      const u16* vp = vct + ((size_t)(b * 64 + 32 * db + l31)) * 128 + 32 * kb + 16 * s2 + 4 * hi;
      vcl[q] = s16x4{0, 0, 0, 0}; vch[q] = s16x4{0, 0, 0, 0};
      if (kb < nkb) { vcl[q] = *(const s16x4*)vp; vch[q] = *(const s16x4*)(vp + 8); }
    }
    const int nv = (t >= 31) ? ((t - 31) >> 4) : -1;
    float mx = NEGB;
#pragma unroll
    for (int kb = 0; kb < 4; ++kb)
#pragma unroll
      for (int r = 0; r < 16; ++r) { const int n = 32 * kb + crow(r, hi); const float v = (n <= nv) ? sc[kb][r] * C2 : NEGB; sc[kb][r] = v; mx = fmaxf(mx, v); }
    mx = fmaxf(mx, __shfl_xor(mx, 32, 64));
    float sum = 0.f;
#pragma unroll
    for (int kb = 0; kb < 4; ++kb)
#pragma unroll
      for (int r = 0; r < 16; ++r) { const int n = 32 * kb + crow(r, hi); const float e = (n <= nv) ? ex2(sc[kb][r] - mx) : 0.f; sc[kb][r] = e; sum += e; }
    sum += __shfl_xor(sum, 32, 64);
    const float inv = sum > 0.f ? 1.f / sum : 0.f;
#pragma unroll
    for (int kb = 0; kb < 4; ++kb)
#pragma unroll
      for (int r = 0; r < 16; ++r) sc[kb][r] *= inv;
    float* myimp = impS + (h * 32 + l31) * 32;
#pragma unroll
    for (int kb = 0; kb < 4; ++kb)
#pragma unroll
      for (int g = 0; g < 4; ++g) myimp[8 * kb + 2 * g + hi] = ((sc[kb][4 * g] + sc[kb][4 * g + 1]) + sc[kb][4 * g + 2]) + sc[kb][4 * g + 3];
    __syncthreads();
#pragma unroll
    for (int kb = 0; kb < 4; ++kb)
#pragma unroll
      for (int g = 0; g < 4; ++g) { const int j1 = 8 * kb + 2 * g + hi + 1; if (j1 < 32) myimp[j1] += sc[kb][4 * g + 3]; }
    f32x16 oc[2];
#pragma unroll
    for (int r = 0; r < 16; ++r) { oc[0][r] = 0.f; oc[1][r] = 0.f; }
#pragma unroll
    for (int kb = 0; kb < 4; ++kb)
#pragma unroll
      for (int s2 = 0; s2 < 2; ++s2) {
        if (kb >= nkb) continue;
        const bf16x8 pf = pack8(sc[kb], s2);
#pragma unroll
        for (int db = 0; db < 2; ++db) {
          const s16x4 lo = vcl[(kb * 2 + s2) * 2 + db], hh = vch[(kb * 2 + s2) * 2 + db];
          const bf16x8 vf = {lo[0], lo[1], lo[2], lo[3], hh[0], hh[1], hh[2], hh[3]};
          oc[db] = MFMA(vf, pf, oc[db]);
        }
      }
#pragma unroll
    for (int r = 0; r < 16; ++r) { ya[0][r] = oc[0][r] * g0; ya[1][r] = oc[1][r] * g0; }
  }
  __syncthreads();
  const int cur = q0 >> 6;
  {
    const int q = tid >> 3, sub = tid & 7;
#pragma unroll
    for (int jj = 0; jj < 4; ++jj) {
      const int j = sub * 4 + jj;
      float v = ((impS[(0 * 32 + q) * 32 + j] + impS[(1 * 32 + q) * 32 + j]) + impS[(2 * 32 + q) * 32 + j]) + impS[(3 * 32 + q) * 32 + j];
      const bool forced = (j == 0) || (j == cur) || (j == cur - 1);
      v = forced ? 1e4f : ((j <= cur) ? v : -1e4f);
      vals[q * 32 + j] = v;
    }
    __syncthreads();
    f32x4 vv[8];
#pragma unroll
    for (int i = 0; i < 8; ++i) vv[i] = *(const f32x4*)(vals + q * 32 + i * 4);
    unsigned bits = 0u;
#pragma unroll
    for (int jj = 0; jj < 4; ++jj) {
      const int j = sub * 4 + jj; const float v = vals[q * 32 + j];
      int cnt = 0;
#pragma unroll
      for (int j2 = 0; j2 < 32; ++j2) { const float w = vv[j2 >> 2][j2 & 3]; cnt += ((w > v) || (w == v && j2 < j)) ? 1 : 0; }
      if (cnt < 16 && j <= cur) bits |= 1u << j;
    }
    if (bits) atomicOr(&selm[q], bits);
  }
  __syncthreads();
  const unsigned mymask = selm[l31];
  unsigned anym = mymask, allm = mymask;
#pragma unroll
  for (int o = 16; o >= 1; o >>= 1) { anym |= (unsigned)__shfl_xor((int)anym, o, 64); allm &= (unsigned)__shfl_xor((int)allm, o, 64); }
  anym = __builtin_amdgcn_readfirstlane(anym);
  allm = __builtin_amdgcn_readfirstlane(allm);
  if (tid < 32) { if ((anym >> tid) & 1u) jlist[__builtin_popcount(anym & ((1u << tid) - 1u))] = tid; }
  f32x16 o[2];
#pragma unroll
  for (int r = 0; r < 16; ++r) { o[0][r] = 0.f; o[1][r] = 0.f; }
  float m = M_INIT, lsum = 0.f;
#pragma unroll
  for (int r = 0; r < 16; ++r) { yst[r * 256 + tid] = ya[0][r]; yst[(16 + r) * 256 + tid] = ya[1][r]; }
  __syncthreads();
  attn_stream(tid, proj, C_KSLC, C_VSLC, __builtin_popcount(anym),
              [&](int ti, int row) { return b * S_ + jlist[ti] * 64 + row; },
              [&](int ti) { const int jb = jlist[ti]; return (jb < cur) && ((allm >> jb) & 1u); },
              [&](int ti, int kr) { const int jb = jlist[ti]; return ((mymask >> jb) & 1u) && (jb * 64 + kr <= t); },
              qr, o, m, lsum, lds);
#pragma unroll
  for (int r = 0; r < 16; ++r) { ya[0][r] = yst[r * 256 + tid]; ya[1][r] = yst[(16 + r) * 256 + tid]; }
  lsum += __shfl_xor(lsum, 32, 64);
  const float il = g1 / lsum;
  const u16* ow = (const u16*)(ws_ + OFF_OWIN);
  u16* y = (u16*)(ws_ + OFF_XB);
#pragma unroll
  for (int db = 0; db < 2; ++db)
#pragma unroll
    for (int g = 0; g < 4; ++g) {
      const int col = h * 64 + 32 * db + 8 * g + 4 * hi;
      const u32x2 w = *(const u32x2*)(ow + tok * 256 + col), az = *(const u32x2*)(proj + tok * NP + C_AZ + col);
      const float v0 = (ya[db][4 * g] + o[db][4 * g] * il + g2 * lo16(w[0])) * siluf_(lo16(az[0]));
      const float v1 = (ya[db][4 * g + 1] + o[db][4 * g + 1] * il + g2 * hi16(w[0])) * siluf_(hi16(az[0]));
      const float v2 = (ya[db][4 * g + 2] + o[db][4 * g + 2] * il + g2 * lo16(w[1])) * siluf_(lo16(az[1]));
      const float v3 = (ya[db][4 * g + 3] + o[db][4 * g + 3] * il + g2 * hi16(w[1])) * siluf_(hi16(az[1]));
      u32x2 v; v[0] = pk2(v0, v1); v[1] = pk2(v2, v3);
      *(u32x2*)(y + tok * 1024 + col) = v;
    }
}

DI void dilcomb_item(const Params& p, int it) {
  char* const ws_ = opq(p.ws);
  const u16* proj = (const u16*)(ws_ + OFF_PROJ);
  const u16* od = (const u16*)(ws_ + OFF_ODIL);
  const float* lse = (const float*)(ws_ + OFF_LSE);
  u16* y = (u16*)(ws_ + OFF_XB);
#pragma unroll
  for (int i = 0; i < 4; ++i) {
    const int idx = it * 1024 + i * 256 + threadIdx.x;
    const size_t tok = idx >> 5; const int c8 = idx & 31, h = c8 >> 3;
    const float l0 = lse[((size_t)0 * T_ + tok) * 4 + h], l1 = lse[((size_t)1 * T_ + tok) * 4 + h], l2 = lse[((size_t)2 * T_ + tok) * 4 + h];
    const float mx = fmaxf(l0, fmaxf(l1, l2));
    float w0 = __expf(l0 - mx), w1 = __expf(l1 - mx), w2 = __expf(l2 - mx);
    const float iw = 1.f / (w0 + w1 + w2); w0 *= iw; w1 *= iw; w2 *= iw;
    const u32x4 a = *(const u32x4*)(od + ((size_t)0 * T_ + tok) * 256 + c8 * 8), bq = *(const u32x4*)(od + ((size_t)1 * T_ + tok) * 256 + c8 * 8), cq = *(const u32x4*)(od + ((size_t)2 * T_ + tok) * 256 + c8 * 8);
    const u32x4 z = *(const u32x4*)(proj + tok * NP + C_BZ + c8 * 8);
    u32x4 r;
#pragma unroll
    for (int e = 0; e < 4; ++e) {
      const float v0 = (w0 * lo16(a[e]) + w1 * lo16(bq[e]) + w2 * lo16(cq[e])) * siluf_(lo16(z[e]));
      const float v1 = (w0 * hi16(a[e]) + w1 * hi16(bq[e]) + w2 * hi16(cq[e])) * siluf_(hi16(z[e]));
      r[e] = pk2(v0, v1);
    }
    *(u32x4*)(y + tok * 1024 + 256 + c8 * 8) = r;
  }
}

__global__ void __launch_bounds__(256, 2) hybrid_megakernel(Params p) {
  __shared__ __attribute__((aligned(16))) char lds[73728];
  __shared__ uint4 xb_words;
  __shared__ uint4 xg_words;
  cg::grid_group grid = cg::this_grid();
  char* const ws_ = p.ws;
  if (p.ws == nullptr) grid.sync();
  if (threadIdx.x == 0) { xb_words = make_uint4(0u, 0u, 0u, 0u); xg_words = make_uint4(0u, 0u, 0u, 0u); }
  __syncthreads();
  const XcdBarrier xb = xcd_barrier_post((unsigned*)(ws_ + OFF_BAR), (volatile LAS unsigned*)&xb_words, gridDim.x);
  const bool grp = (gridDim.x % 8u) == 0u;
  const XcdBarrier xg = grp ? xcd_barrier_post((unsigned*)(ws_ + OFF_BAR) + (1 + (blockIdx.x & 7)) * 4096, (volatile LAS unsigned*)&xg_words, gridDim.x / 8u) : xb;
  const int nb = gridDim.x, bid = blockIdx.x;
  const int wid = threadIdx.x >> 6;
  for (int it = bid; it < 3328 + 1024 + 1024 + 32 + 16 + 64; it += nb) {
    if (it < 3328) { const int l = it / 832, r = it % 832, ntile = r >> 4, ktile = r & 15;
      tr_tile(p.w_in + (size_t)l * 1024 * 3212, 3212, (u16*)(ws_ + OFF_WIN) + (size_t)l * NP * 1024, 1024, ktile * 64, ntile * 64, p.g_pre + l * 1024, 1, lds); }
    else if (it < 4352) { const int i2 = it - 3328, l = i2 >> 8, r = i2 & 255, ntile = r >> 4, ktile = r & 15;
      tr_tile(p.w_out + (size_t)l * 1024 * 1024, 1024, (u16*)(ws_ + OFF_WOUT) + (size_t)l * 1024 * 1024, 1024, ktile * 64, ntile * 64, nullptr, 0, lds); }
    else if (it < 5376) { const int i2 = it - 4352, mtx = i2 >> 7, r = i2 & 127, ntile = r >> 5, ktile = r & 31;
      tr_tile(p.w_cmp1 + (size_t)mtx * 2048 * 256, 256, (u16*)(ws_ + OFF_W1) + (size_t)mtx * 256 * 2048, 2048, ktile * 64, ntile * 64, nullptr, 0, lds); }
    else if (it < 5408) { const int i2 = it - 5376, mtx = i2 >> 2, ktile = i2 & 3;
      tr_tile(p.w_cmp2 + (size_t)mtx * 256 * 64, 64, (u16*)(ws_ + OFF_W2) + (size_t)mtx * 64 * 256, 256, ktile * 64, 0, nullptr, 0, lds); }
    else if (it < 5424) { const int mtx = it - 5408;
      tr_tile(p.w_pool + (size_t)mtx * 4096, 64, (u16*)(ws_ + OFF_WPT) + (size_t)mtx * 4096, 64, 0, 0, nullptr, 0, lds); }
    else { const int i2 = it - 5424, mtx = i2 >> 2, qd = i2 & 3;
      const float* src = p.w_sp + (size_t)mtx * 16384 + qd * 4096; u16* dst = (u16*)(ws_ + OFF_WSP) + (size_t)mtx * 16384 + qd * 4096;
      f32x4 v[4];
#pragma unroll
      for (int k = 0; k < 4; ++k) v[k] = *(const f32x4*)(src + (threadIdx.x + 256 * k) * 4);
#pragma unroll
      for (int k = 0; k < 4; ++k) {
        const int e = qd * 4096 + (threadIdx.x + 256 * k) * 4, i = e >> 7, j = e & 127;
        u32x2 o; o[0] = pk2(j <= i ? v[k][0] : 0.f, j + 1 <= i ? v[k][1] : 0.f); o[1] = pk2(j + 2 <= i ? v[k][2] : 0.f, j + 3 <= i ? v[k][3] : 0.f);
        *(u32x2*)(dst + (threadIdx.x + 256 * k) * 4) = o;
      } }
  }
  for (int it = bid; it < T_ / 32; it += nb) {
    const int row = it * 32 + wid * 8;
    rows_convert<8>(p.x + (size_t)row * 1024, (u16*)(ws_ + OFF_XB) + (size_t)row * 1024, (float*)(ws_ + OFF_RN) + row);
  }
  xcd_barrier(xb);
  for (int l = 0; l < 4; ++l) {
    for (int it = bid; it < 1024; it += nb) { const int q = it >> 3; inproj_tile<4>(p, l, (it & 7) * 16 + (q & 15), q >> 4, lds); }
    xcd_barrier(xg);
    for (int vb = bid; vb < 512; vb += nb) {
      { const int q2 = vb >> 3; inproj_tile<4>(p, l, (vb & 7) * 16 + (q2 & 15), 8 + (q2 >> 4), lds); }
      if (vb < 64) cmp_item(p, l, vb, lds);
      else {
        const int j = vb - 64;
        if (vb >= 256) { const int i2 = (vb - 256) >> 3; inproj_tile<2>(p, l, (vb & 7) * 16 + (i2 & 15), 24 + (i2 >> 4), lds); }
        win_item(p, j, lds);
        if (j + 448 < 512) win_item(p, j + 448, lds);
        for (int it = j; it < 1536; it += 448) dil_item(p, it, lds);
      }
    }
    xcd_barrier(xg);
    for (int vb = bid; vb < 512; vb += nb) {
      nsa_item(p, vb, lds);
      const int gi = vb >> 4;
      int start = 0, mine = 0;
      for (int g2 = 0; g2 <= gi; ++g2) {
        const int n = 32 - g2;
        const int d = (n <= 10) ? 2 : (n <= 22) ? 1 : 0;
        if (g2 < gi) start += 2 * d; else mine = d;
      }
      start += ((vb >> 3) & 1) * mine;
      const int x = vb & 7;
      for (int k = 0; k < mine; ++k) { const int slot = start + k; sgu_item(p, l, slot * 8 + x, lds); pool_item(p, l, slot * 8 + x, lds); dilcomb_item(p, x * 64 + slot); }
    }
    xcd_barrier(xg);
    for (int it = bid; it < 512; it += nb) outproj_item(p, l, it, lds);
    xcd_barrier(xg);
    const float* xin = (l == 0) ? p.x : p.out;
    for (int vb = bid; vb < 512; vb += nb)
      for (int j = vb >> 3; j < 128; j += 64) resid_rows<4>(p, l, (vb & 7) * 2048 + j * 16 + wid * 4, xin);
    if (l < 3) xcd_barrier(xg);
  }
}

extern "C" void kernel_launch(void* const* d_in, const int* in_sizes, int n_in, void* d_out, int out_size, void* d_ws, size_t ws_size, hipStream_t stream) {
  static int grid_blocks = 0;
  if (!grid_blocks) {
    int dev = 0, cus = 0, per_cu = 0;
    hipGetDevice(&dev);
    hipDeviceGetAttribute(&cus, hipDeviceAttributeMultiprocessorCount, dev);
    hipOccupancyMaxActiveBlocksPerMultiprocessor(&per_cu, hybrid_megakernel, 256, 0);
    if (per_cu > 2) per_cu = 2;
    if (per_cu < 1) per_cu = 1;
    grid_blocks = cus * per_cu;
  }
  if (ws_size < WS_TOTAL) { fprintf(stderr, "workspace too small: %zu < %zu\n", ws_size, (size_t)WS_TOTAL); return; }
  Params p{};
  p.x = (const float*)d_in[0]; p.g_pre = (const float*)d_in[1]; p.w_in = (const float*)d_in[2]; p.pe_cmp = (const float*)d_in[3];
  p.w_cmp1 = (const float*)d_in[4]; p.w_cmp2 = (const float*)d_in[5]; p.w_pool = (const float*)d_in[6]; p.pool_scale = (const float*)d_in[7];
  p.sg_ln_g = (const float*)d_in[8]; p.sg_ln_b = (const float*)d_in[9]; p.w_sp = (const float*)d_in[10]; p.b_sp = (const float*)d_in[11];
  p.w_out = (const float*)d_in[12]; p.g_post = (const float*)d_in[13];
  p.out = (float*)d_out; p.ws = (char*)d_ws;
  hipMemsetAsync((char*)d_ws + OFF_BAR, 0, 9 * 16384, stream);
  void* args[] = {&p};
  hipError_t e = hipLaunchCooperativeKernel((void*)hybrid_megakernel, dim3(grid_blocks), dim3(256), args, 0, stream);
  if (e != hipSuccess) fprintf(stderr, "cooperative launch failed: %s (grid %d)\n", hipGetErrorString(e), grid_blocks);
}
```

```cpp
#include <hip/hip_runtime.h>
#include <hip/hip_cooperative_groups.h>
#include <cstdio>
namespace cg = cooperative_groups;

typedef unsigned short u16;
using bf16x8 = __attribute__((ext_vector_type(8))) short;
using s16x4 = __attribute__((ext_vector_type(4))) short;
using f32x16 = __attribute__((ext_vector_type(16))) float;
using f32x4 = __attribute__((ext_vector_type(4))) float;
using u32x4 = __attribute__((ext_vector_type(4))) unsigned;
using u32x2 = __attribute__((ext_vector_type(2))) unsigned;
typedef short v4i16_t __attribute__((ext_vector_type(4)));
#define DI __device__ __forceinline__
#define MFMA(a, b, c) __builtin_amdgcn_mfma_f32_32x32x16_bf16((a), (b), (c), 0, 0, 0)

constexpr int T_ = 16384, S_ = 2048, NP = 3328;
constexpr float C2 = 0.125f * 1.4426950408889634f;
constexpr float NEGB = -1e30f;

constexpr int C_AQ = 0, C_KCMP = 256, C_KSLC = 384, C_VSLC = 448, C_KWIN = 512, C_VWIN = 576, C_AZ = 640;
constexpr int C_BQ = 896, C_BK = 1152, C_BV = 1408, C_BZ = 1664, C_CIN = 1920, C_CZ = 2176, C_DU = 2432, C_DV = 2688, C_DZ = 2944, C_AG = 3200;

constexpr size_t al(size_t x) { return (x + 255) & ~(size_t)255; }
constexpr size_t OFF_WIN = 0;
constexpr size_t OFF_WOUT = OFF_WIN + al((size_t)4 * NP * 1024 * 2);
constexpr size_t OFF_W1 = OFF_WOUT + al((size_t)4 * 1024 * 1024 * 2);
constexpr size_t OFF_W2 = OFF_W1 + al((size_t)4 * 2 * 256 * 2048 * 2);
constexpr size_t OFF_XB = OFF_W2 + al((size_t)4 * 2 * 64 * 256 * 2);
constexpr size_t OFF_RN = OFF_XB + al((size_t)T_ * 1024 * 2);
constexpr size_t OFF_PROJ = OFF_RN + al((size_t)T_ * 4);
constexpr size_t OFF_SSQ = OFF_PROJ + al((size_t)T_ * NP * 2);
constexpr size_t OFF_KC = OFF_SSQ + al((size_t)T_ * 16 * 4);
constexpr size_t OFF_VCT = OFF_KC + al((size_t)8 * 128 * 64 * 2);
constexpr size_t OFF_OWIN = OFF_VCT + al((size_t)8 * 128 * 64 * 2);
constexpr size_t OFF_ODIL = OFF_OWIN + al((size_t)T_ * 256 * 2);
constexpr size_t OFF_LSE = OFF_ODIL + al((size_t)3 * T_ * 256 * 2);
constexpr size_t OFF_WPT = OFF_LSE + al((size_t)3 * T_ * 4 * 4);
constexpr size_t OFF_WSP = OFF_WPT + al((size_t)16 * 64 * 64 * 2);
constexpr size_t OFF_OUTB = OFF_WSP + al((size_t)16 * 128 * 128 * 2);
constexpr size_t OFF_BAR = OFF_OUTB + al((size_t)T_ * 1024 * 2);
constexpr size_t WS_TOTAL = OFF_BAR + 9 * 16384;
static_assert(WS_TOTAL <= (size_t)256 * 1024 * 1024, "workspace layout exceeds the guaranteed 256 MiB");

struct Params {
  const float *x, *g_pre, *w_in, *pe_cmp, *w_cmp1, *w_cmp2, *w_pool, *pool_scale, *sg_ln_g, *sg_ln_b, *w_sp, *b_sp, *w_out, *g_post;
  float* out;
  char* ws;
};

DI char* opq(char* q) { size_t z = 0; asm volatile("" : "+s"(z)); return q + z; }
DI int tidx() { int t = threadIdx.x; asm volatile("" : "+v"(t)); return t; }
DI float bf2f(u16 v) { return __uint_as_float((unsigned)v << 16); }
DI unsigned pk2(float a, float b) {
  typedef __bf16 bf2 __attribute__((ext_vector_type(2)));
  typedef float f2 __attribute__((ext_vector_type(2)));
  f2 v = {a, b};
  bf2 r = __builtin_convertvector(v, bf2);
  return __builtin_bit_cast(unsigned, r);
}
DI u16 f2bf(float x) { return (u16)(pk2(x, 0.f) & 0xffffu); }
DI float lo16(unsigned w) { return __uint_as_float(w << 16); }
DI float hi16(unsigned w) { return __uint_as_float(w & 0xffff0000u); }
DI int crow(int r, int hi) { return (r & 3) + 8 * (r >> 2) + 4 * hi; }
DI float ex2(float x) { return __builtin_amdgcn_exp2f(x); }
DI float sigmoidf_(float x) { return 1.f / (1.f + __expf(-x)); }
DI float siluf_(float x) { return x / (1.f + __expf(-x)); }
DI float wave_sum(float v) {
#pragma unroll
  for (int o = 32; o >= 1; o >>= 1) v += __shfl_xor(v, o, 64);
  return v;
}
DI bf16x8 pack8(const f32x16& x, int s8) {
  u32x4 p;
  p[0] = pk2(x[8 * s8 + 0], x[8 * s8 + 1]); p[1] = pk2(x[8 * s8 + 2], x[8 * s8 + 3]);
  p[2] = pk2(x[8 * s8 + 4], x[8 * s8 + 5]); p[3] = pk2(x[8 * s8 + 6], x[8 * s8 + 7]);
  return __builtin_bit_cast(bf16x8, p);
}
DI s16x4 trread(const char* p) {
  return __builtin_bit_cast(s16x4, __builtin_amdgcn_ds_read_tr16_b64_v4i16((__attribute__((address_space(3))) v4i16_t*)p));
}


#define XB_TMO      128
#define XB_XCNT(j)  (256  + 64 * (j))
#define XB_XSUB(j)  (1280 + 64 * (j))
#define XB_XGEN(j)  (2304 + 64 * (j))
#define XB_TOP      3328
#define XB_TOPGEN   3392
#define XCD_BAR_WORDS 3456
#define XB_SPIN_CAP (1u << 22)
#define LAS __attribute__((address_space(3)))
DI unsigned xb_ld(unsigned* p)              { return __hip_atomic_load(p, __ATOMIC_RELAXED, __HIP_MEMORY_SCOPE_AGENT); }
DI unsigned xb_add(unsigned* p, unsigned v) { return __hip_atomic_fetch_add(p, v, __ATOMIC_RELAXED, __HIP_MEMORY_SCOPE_AGENT); }
DI unsigned xb_xcc_id() { return (unsigned)__builtin_amdgcn_s_getreg((3 << 11) | 20) & 0xFu; }
#define XB_SPIN(cond, bar) do { unsigned _sp = 0; while (cond) { __builtin_amdgcn_s_sleep(1); \
    if ((++_sp & 255u) == 0u) { if (xb_ld(&(bar)[XB_TMO])) break; if (_sp > XB_SPIN_CAP) { atomicAdd(&(bar)[XB_TMO], 1u); break; } } } } while (0)
struct XcdBarrier { unsigned* bar; unsigned x; volatile LAS unsigned* st; unsigned G; };
DI XcdBarrier xcd_barrier_post(unsigned* bar, volatile LAS unsigned* st, unsigned G) {
    XcdBarrier b; b.bar = bar; b.x = xb_xcc_id(); b.st = st; b.G = G;
    if (threadIdx.x == 0) (void)xb_add(&bar[XB_XCNT(b.x)], 1u);
    return b;
}
DI void xcd_barrier_complete(unsigned* bar, unsigned x, unsigned G, unsigned& nloc, unsigned& nx) {
    unsigned sum, cnt, mine, sp = 0u;
    for (;;) {
        sum = 0u; cnt = 0u; mine = 0u;
#pragma unroll
        for (unsigned j = 0; j < 16; ++j) { const unsigned c = xb_ld(&bar[XB_XCNT(j)]); sum += c; cnt += (c > 0u) ? 1u : 0u; mine = (j == x) ? c : mine; }
        if (sum == G) break;
        __builtin_amdgcn_s_sleep(1);
        if ((++sp & 255u) == 0u) { if (xb_ld(&bar[XB_TMO])) break; if (sp > XB_SPIN_CAP) { atomicAdd(&bar[XB_TMO], 1u); break; } }
    }
    nloc = mine > 0u ? mine : 1u; nx = cnt > 0u ? cnt : 1u;
}
DI void xcd_barrier(const XcdBarrier& b) {
    asm volatile("s_waitcnt vmcnt(0)" ::: "memory");
    __syncthreads();
    if (threadIdx.x == 0) {
        unsigned* bar = b.bar;
        __builtin_amdgcn_s_waitcnt(0);
        unsigned nloc = b.st[0], nx = b.st[1];
        if (nloc == 0u) { xcd_barrier_complete(bar, b.x, b.G, nloc, nx); b.st[0] = nloc; b.st[1] = nx; }
        const unsigned old = xb_add(&bar[XB_XSUB(b.x)], 1u);
        const unsigned gen = old / nloc;
        if (old + 1u == (gen + 1u) * nloc) {
            if (nx > 1u) {
              __builtin_amdgcn_fence(__ATOMIC_RELEASE, "agent");
              asm volatile("s_waitcnt vmcnt(0)" ::: "memory");
              const unsigned og = xb_add(&bar[XB_TOP], 1u);
              const unsigned tg = og / nx;
              if (og + 1u == (tg + 1u) * nx) xb_add(&bar[XB_TOPGEN], 1u);
              else XB_SPIN(xb_ld(&bar[XB_TOPGEN]) == tg, bar);
            }
            if (nx > 1u) {
              __builtin_amdgcn_fence(__ATOMIC_ACQUIRE, "agent");
              xb_add(&bar[XB_XGEN(b.x)], 1u);
            } else {
              xb_add(&bar[XB_XGEN(b.x)], 1u);
              __builtin_amdgcn_fence(__ATOMIC_ACQUIRE, "agent");
            }
            asm volatile("s_waitcnt vmcnt(0)" ::: "memory");
        } else {
            XB_SPIN(xb_ld(&bar[XB_XGEN(b.x)]) == gen, bar);
            __builtin_amdgcn_fence(__ATOMIC_ACQUIRE, "agent");
            asm volatile("s_waitcnt vmcnt(0)" ::: "memory");
        }
    }
    __syncthreads();
}

template <int WGN, int INS, int IMS, bool DB, class LdW, class LdX>
DI void gemm_core(f32x16 (&acc)[INS][IMS], const int KT, LdW ldw, LdX ldx, char* lds, const int tid) {
  constexpr int WGM = 4 / WGN;
  constexpr int WROWS = WGN * 32 * INS, XROWS = WGM * 32 * IMS, NROWS = WROWS + XROWS, NCH = NROWS / 32, NCHW = WROWS / 32, BUFB = NROWS * 144;
  const int lane = tid & 63, wid = tid >> 6, l31 = lane & 31, hi = lane >> 5;
  const int wn = (WGN == 2) ? (wid >> 1) : wid, wm = (WGN == 2) ? (wid & 1) : 0;
  const int offa = (wn * 32 * INS + l31) * 144 + hi * 16;
  const int offb = (WROWS + wm * 32 * IMS + l31) * 144 + hi * 16;
#pragma unroll
  for (int a = 0; a < INS; ++a)
#pragma unroll
    for (int b = 0; b < IMS; ++b)
#pragma unroll
      for (int r = 0; r < 16; ++r) acc[a][b][r] = 0.f;
#define GLOAD(dst, kt_) _Pragma("unroll") for (int i = 0; i < NCH; ++i) { dst[i] = (i < NCHW) ? ldw(i, tid >> 3, (kt_) * 64 + (tid & 7) * 8) : ldx(i - NCHW, tid >> 3, (kt_) * 64 + (tid & 7) * 8); }
#define LSTORE(src, base) _Pragma("unroll") for (int i = 0; i < NCH; ++i) { const int c = tid + 256 * i; *(u32x4*)((base) + (c >> 3) * 144 + (c & 7) * 16) = src[i]; }
#define COMPUTE_PIPE(buf) { const char* pa = (buf) + offa; const char* pb = (buf) + offb; \
    bf16x8 fa[2][INS], fb[2][IMS]; \
    _Pragma("unroll") for (int in = 0; in < INS; ++in) fa[0][in] = *(const bf16x8*)(pa + in * 32 * 144); \
    _Pragma("unroll") for (int im = 0; im < IMS; ++im) fb[0][im] = *(const bf16x8*)(pb + im * 32 * 144); \
    _Pragma("unroll") for (int s = 0; s < 4; ++s) { \
      if (s < 3) { _Pragma("unroll") for (int in = 0; in < INS; ++in) fa[(s + 1) & 1][in] = *(const bf16x8*)(pa + in * 32 * 144 + (s + 1) * 32); \
        _Pragma("unroll") for (int im = 0; im < IMS; ++im) fb[(s + 1) & 1][im] = *(const bf16x8*)(pb + im * 32 * 144 + (s + 1) * 32); } \
      _Pragma("unroll") for (int im = 0; im < IMS; ++im) _Pragma("unroll") for (int in = 0; in < INS; ++in) \
        acc[in][im] = MFMA(fa[s & 1][in], fb[s & 1][im], acc[in][im]); } }
#define COMPUTE_FLAT(buf) { const char* pa = (buf) + offa; const char* pb = (buf) + offb; \
    _Pragma("unroll") for (int s = 0; s < 4; ++s) { \
      bf16x8 fa[INS], fb[IMS]; \
      _Pragma("unroll") for (int in = 0; in < INS; ++in) fa[in] = *(const bf16x8*)(pa + in * 32 * 144 + s * 32); \
      _Pragma("unroll") for (int im = 0; im < IMS; ++im) fb[im] = *(const bf16x8*)(pb + im * 32 * 144 + s * 32); \
      _Pragma("unroll") for (int im = 0; im < IMS; ++im) _Pragma("unroll") for (int in = 0; in < INS; ++in) \
        acc[in][im] = MFMA(fa[in], fb[im], acc[in][im]); } }
  if (DB) {
    u32x4 preA[NCH], preB[NCH];
    GLOAD(preA, 0)
    GLOAD(preB, 1)
    __syncthreads();
    LSTORE(preA, lds)
    __syncthreads();
    for (int kt = 0; kt < KT; kt += 2) {
      if (kt + 2 < KT) { GLOAD(preA, kt + 2) }
      COMPUTE_PIPE(lds)
      LSTORE(preB, lds + BUFB)
      __syncthreads();
      if (kt + 3 < KT) { GLOAD(preB, kt + 3) }
      COMPUTE_PIPE(lds + BUFB)
      if (kt + 2 < KT) { LSTORE(preA, lds) }
      __syncthreads();
    }
  } else {
    u32x4 pre[NCH];
    GLOAD(pre, 0)
    for (int kt = 0; kt < KT; ++kt) {
      __syncthreads();
      LSTORE(pre, lds)
      __syncthreads();
      if (kt + 1 < KT) { GLOAD(pre, kt + 1) }
      if (INS >= 4) COMPUTE_FLAT(lds) else COMPUTE_PIPE(lds)
    }
  }
#undef GLOAD
#undef LSTORE
#undef COMPUTE_PIPE
#undef COMPUTE_FLAT
}

constexpr float M_INIT = -1e29f;
template <class MaskF>
DI void attn_tile(const int tid, const char* ldsK, const char* ldsV, const bf16x8 (&qr)[4], f32x16 (&o)[2], float& m, float& l, const bool MASKED, MaskF mask) {
  const int lane = tid & 63, l31 = lane & 31, hi = lane >> 5;
  f32x16 p0, p1;
#pragma unroll
  for (int r = 0; r < 16; ++r) { p0[r] = 0.f; p1[r] = 0.f; }
  const char* kp = ldsK + l31 * 144 + hi * 16;
#pragma unroll
  for (int s = 0; s < 4; ++s) {
    const bf16x8 k0 = *(const bf16x8*)(kp + s * 32), k1 = *(const bf16x8*)(kp + 32 * 144 + s * 32);
    p0 = MFMA(k0, qr[s], p0); p1 = MFMA(k1, qr[s], p1);
  }
  if (MASKED) {
#pragma unroll
    for (int r = 0; r < 16; ++r) {
      const int kr = crow(r, hi);
      p0[r] = mask(kr) ? p0[r] : NEGB; p1[r] = mask(kr + 32) ? p1[r] : NEGB;
    }
  }
  const char* vb = ldsV + (4 * hi + ((lane & 15) >> 2)) * 144 + ((lane >> 4) & 1) * 32 + (lane & 3) * 8;
  s16x4 vlo[8], vhi[8];
#pragma unroll
  for (int s4 = 0; s4 < 4; ++s4)
#pragma unroll
    for (int db = 0; db < 2; ++db) { vlo[s4 * 2 + db] = trread(vb + (16 * s4) * 144 + db * 64); vhi[s4 * 2 + db] = trread(vb + (16 * s4 + 8) * 144 + db * 64); }
  __builtin_amdgcn_sched_barrier(0);
  float mx = fmaxf(p0[0], p1[0]);
#pragma unroll
  for (int r = 1; r < 16; ++r) mx = fmaxf(fmaxf(mx, p0[r]), p1[r]);
  { auto rr = __builtin_amdgcn_permlane32_swap(__float_as_uint(mx), __float_as_uint(mx), false, false); mx = fmaxf(__uint_as_float(rr[0]), __uint_as_float(rr[1])); }
  const float mxs = mx * C2;
  if (__any(mxs > m + 8.f)) {
    const float mn = fmaxf(m, mxs), alpha = ex2(m - mn);
    m = mn; l *= alpha;
#pragma unroll
    for (int r = 0; r < 16; ++r) { o[0][r] *= alpha; o[1][r] *= alpha; }
  }
  const float nm = -m;
  float rs = 0.f;
#pragma unroll
  for (int r = 0; r < 16; ++r) { p0[r] = ex2(__builtin_fmaf(p0[r], C2, nm)); p1[r] = ex2(__builtin_fmaf(p1[r], C2, nm)); rs += p0[r] + p1[r]; }
  l += rs;
  bf16x8 pw[4];
  pw[0] = pack8(p0, 0); pw[1] = pack8(p0, 1); pw[2] = pack8(p1, 0); pw[3] = pack8(p1, 1);
#pragma unroll
  for (int s4 = 0; s4 < 4; ++s4) {
#pragma unroll
    for (int db = 0; db < 2; ++db) {
      const s16x4 lo = vlo[s4 * 2 + db], hh = vhi[s4 * 2 + db];
      const bf16x8 vf = {lo[0], lo[1], lo[2], lo[3], hh[0], hh[1], hh[2], hh[3]};
      o[db] = MFMA(vf, pw[s4], o[db]);
    }
  }
}

template <class RowF>
DI void kv_load(const int tid, u32x4 (&pre)[4], RowF rowtok, const u16* proj, int kcol, int vcol) {
#pragma unroll
  for (int i = 0; i < 2; ++i) {
    const int c = tid + 256 * i, row = c >> 3, ch = c & 7;
    const u16* p = proj + (size_t)rowtok(row) * NP + ch * 8;
    pre[i] = *(const u32x4*)(p + kcol); pre[2 + i] = *(const u32x4*)(p + vcol);
  }
}
DI void kv_store(const int tid, const u32x4 (&pre)[4], char* ldsK, char* ldsV) {
#pragma unroll
  for (int i = 0; i < 2; ++i) {
    const int c = tid + 256 * i, row = c >> 3, ch = c & 7;
    *(u32x4*)(ldsK + row * 144 + ch * 16) = pre[i]; *(u32x4*)(ldsV + row * 144 + ch * 16) = pre[2 + i];
  }
}

template <class RowF, class FullF, class MaskF>
DI void attn_stream(const int tid, const u16* proj, const int kcol, const int vcol, const int nt, RowF rowtok, FullF full, MaskF mask,
                    const bf16x8 (&qr)[4], f32x16 (&o)[2], float& m, float& l, char* lds) {
  u32x4 preA[4], preB[4];
  if (nt > 0) kv_load(tid, preA, [&](int row) { return rowtok(0, row); }, proj, kcol, vcol);
  if (nt > 1) kv_load(tid, preB, [&](int row) { return rowtok(1, row); }, proj, kcol, vcol);
  for (int ti = 0; ti < nt; ti += 2) {
    kv_store(tid, preA, lds, lds + 9216);
    __syncthreads();
    if (ti + 2 < nt) kv_load(tid, preA, [&](int row) { return rowtok(ti + 2, row); }, proj, kcol, vcol);
    attn_tile(tid, lds, lds + 9216, qr, o, m, l, !full(ti), [&](int kr) { return mask(ti, kr); });
    if (ti + 1 < nt) {
      kv_store(tid, preB, lds + 18432, lds + 27648);
      __syncthreads();
      if (ti + 3 < nt) kv_load(tid, preB, [&](int row) { return rowtok(ti + 3, row); }, proj, kcol, vcol);
      attn_tile(tid, lds + 18432, lds + 27648, qr, o, m, l, !full(ti + 1), [&](int kr) { return mask(ti + 1, kr); });
    }
  }
}

DI int mapcol(int n, int mode) {
  if (mode == 0) return n;
  if (n < 640) return n;
  if (n < 3200) return n + 12;
  if (n < 3212) return n - 3200 + 640;
  return -1;
}
DI void tr_tile(const float* src, int ldsrc, u16* dst, int ldd, int k0, int n0, const float* g, int mode, char* lds) {
  float* t = (float*)lds;
  const int tid = threadIdx.x;
  float v[16];
#pragma unroll
  for (int i = 0; i < 16; ++i) {
    const int e = tid + 256 * i, kk = e >> 6, nn = e & 63;
    const int sc = mapcol(n0 + nn, mode);
    v[i] = sc >= 0 ? src[(size_t)(k0 + kk) * ldsrc + sc] : 0.f;
  }
  if (g) {
#pragma unroll
    for (int i = 0; i < 16; ++i) v[i] *= g[k0 + ((tid + 256 * i) >> 6)];
  }
#pragma unroll
  for (int i = 0; i < 16; ++i) { const int e = tid + 256 * i, kk = e >> 6, nn = e & 63; t[kk * 65 + nn] = v[i]; }
  __syncthreads();
#pragma unroll
  for (int i = 0; i < 2; ++i) {
    const int e = tid + 256 * i, nn = e >> 3, k8 = (e & 7) * 8;
    u32x4 o;
    o[0] = pk2(t[(k8 + 0) * 65 + nn], t[(k8 + 1) * 65 + nn]); o[1] = pk2(t[(k8 + 2) * 65 + nn], t[(k8 + 3) * 65 + nn]);
    o[2] = pk2(t[(k8 + 4) * 65 + nn], t[(k8 + 5) * 65 + nn]); o[3] = pk2(t[(k8 + 6) * 65 + nn], t[(k8 + 7) * 65 + nn]);
    *(u32x4*)(dst + (size_t)(n0 + nn) * ldd + k0 + k8) = o;
  }
  __syncthreads();
}

template <int NR>
DI void rows_convert(const float* x0, u16* xb0, float* rn0) {
  const int lane = tidx() & 63;
  f32x4 v[NR][4];
#pragma unroll
  for (int r = 0; r < NR; ++r)
#pragma unroll
    for (int i = 0; i < 4; ++i) v[r][i] = *(const f32x4*)(x0 + (size_t)r * 1024 + i * 256 + lane * 4);
#pragma unroll
  for (int r = 0; r < NR; ++r) {
    float ss = 0.f;
#pragma unroll
    for (int i = 0; i < 4; ++i) {
      ss += v[r][i][0] * v[r][i][0] + v[r][i][1] * v[r][i][1] + v[r][i][2] * v[r][i][2] + v[r][i][3] * v[r][i][3];
      u32x2 o; o[0] = pk2(v[r][i][0], v[r][i][1]); o[1] = pk2(v[r][i][2], v[r][i][3]);
      *(u32x2*)(xb0 + (size_t)r * 1024 + i * 256 + lane * 4) = o;
    }
    ss = wave_sum(ss);
    if (lane == 0) rn0[r] = rsqrtf(ss * (1.f / 1024.f) + 1e-6f);
  }
}

template <int NTW>
DI void inproj_tile(const Params& p, int l, int mt, int ntile, char* lds) {
  char* const ws_ = opq(p.ws);
  const u16* W = (const u16*)(ws_ + OFF_WIN) + ((size_t)l * NP + ntile * 64 * NTW) * 1024;
  const u16* X = (const u16*)(ws_ + OFF_XB) + (size_t)mt * 128 * 1024;
  f32x16 acc[NTW][2];
  const int tid = tidx();
  gemm_core<2, NTW, 2, (NTW == 2)>(acc, 16, [&](int i, int r0, int k) -> u32x4 { return *(const u32x4*)((W + i * 32768) + (unsigned)(r0 * 1024 + k)); },
               [&](int i, int r0, int k) -> u32x4 { return *(const u32x4*)((X + i * 32768) + (unsigned)(r0 * 1024 + k)); }, lds, tid);
  const int lane = tid & 63, wid = tid >> 6, l31 = lane & 31, hi = lane >> 5, wn = wid >> 1, wm = wid & 1;
  const float* rn = (const float*)(ws_ + OFF_RN);
  u16* proj = (u16*)(ws_ + OFF_PROJ);
  constexpr int NCOLS = 64 * NTW, RS = NCOLS * 2 + 16;
  __syncthreads();
#pragma unroll
  for (int im = 0; im < 2; ++im) {
    const int tl = wm * 64 + im * 32 + l31;
    const float r = rn[(size_t)mt * 128 + tl];
#pragma unroll
    for (int in = 0; in < NTW; ++in)
#pragma unroll
      for (int g = 0; g < 4; ++g) {
        const int n = wn * 32 * NTW + in * 32 + 8 * g + 4 * hi;
        u32x2 o; o[0] = pk2(acc[in][im][4 * g] * r, acc[in][im][4 * g + 1] * r); o[1] = pk2(acc[in][im][4 * g + 2] * r, acc[in][im][4 * g + 3] * r);
        *(u32x2*)(lds + tl * RS + n * 2) = o;
      }
  }
  __syncthreads();
#pragma unroll 4
  for (int i = 0; i < NCOLS / 16; ++i) {
    const int c = tid + 256 * i, tl = c / (NCOLS / 8), ch = c % (NCOLS / 8);
    const u32x4 v = *(const u32x4*)(lds + tl * RS + ch * 16);
    *(u32x4*)(proj + ((size_t)mt * 128 + tl) * NP + ntile * NCOLS + ch * 8) = v;
  }
}

DI void outproj_item(const Params& p, int l, int it, char* lds) {
  char* const ws_ = opq(p.ws);
  const int mt = (it & 7) * 16 + ((it >> 3) & 15), nt = it >> 7;
  const u16* W = (const u16*)(ws_ + OFF_WOUT) + ((size_t)l * 1024 + nt * 256) * 1024;
  const u16* Y = (const u16*)(ws_ + OFF_XB) + (size_t)mt * 128 * 1024;
  f32x16 acc[4][2];
  const int tid = tidx();
  gemm_core<2, 4, 2, false>(acc, 16, [&](int i, int r0, int k) -> u32x4 { return *(const u32x4*)((W + i * 32768) + (unsigned)(r0 * 1024 + k)); },
               [&](int i, int r0, int k) -> u32x4 { return *(const u32x4*)((Y + i * 32768) + (unsigned)(r0 * 1024 + k)); }, lds, tid);
  const int lane = tid & 63, wid = tid >> 6, l31 = lane & 31, hi = lane >> 5, wn = wid >> 1, wm = wid & 1;
  u16* outb = (u16*)(ws_ + OFF_OUTB);
  float* ssq = (float*)(ws_ + OFF_SSQ);
  constexpr int RS = 256 * 2 + 16;
  __syncthreads();
#pragma unroll
  for (int im = 0; im < 2; ++im) {
    const int tl = wm * 64 + im * 32 + l31;
    float ss = 0.f;
#pragma unroll
    for (int in = 0; in < 4; ++in)
#pragma unroll
      for (int g = 0; g < 4; ++g) {
        const int n = wn * 128 + in * 32 + 8 * g + 4 * hi;
        const float o0 = acc[in][im][4 * g], o1 = acc[in][im][4 * g + 1], o2 = acc[in][im][4 * g + 2], o3 = acc[in][im][4 * g + 3];
        ss += o0 * o0 + o1 * o1 + o2 * o2 + o3 * o3;
        u32x2 v; v[0] = pk2(o0, o1); v[1] = pk2(o2, o3);
        *(u32x2*)(lds + tl * RS + n * 2) = v;
      }
    ss += __shfl_xor(ss, 32, 64);
    if (hi == 0) ssq[((size_t)mt * 128 + tl) * 16 + nt * 2 + wn] = ss;
  }
  __syncthreads();
#pragma unroll 4
  for (int i = 0; i < 16; ++i) {
    const int c = tid + 256 * i, tl = c >> 5, ch = c & 31;
    const u32x4 v = *(const u32x4*)(lds + tl * RS + ch * 16);
    *(u32x4*)(outb + ((size_t)mt * 128 + tl) * 1024 + nt * 256 + ch * 8) = v;
  }
}

template <int NR>
DI void resid_rows(const Params& p, int l, int row0, const float* xin) {
  char* const ws_ = opq(p.ws);
  const int lane = tidx() & 63;
  const u16* outb = (const u16*)(ws_ + OFF_OUTB);
  const float* ssq = (const float*)(ws_ + OFF_SSQ);
  u32x2 ob[NR][4]; f32x4 xv[NR][4]; f32x4 sq[NR][2];
#pragma unroll
  for (int r = 0; r < NR; ++r) {
    const size_t row = (size_t)(row0 + r);
    sq[r][0] = *(const f32x4*)(ssq + row * 16); sq[r][1] = *(const f32x4*)(ssq + row * 16 + 4);
#pragma unroll
    for (int i = 0; i < 4; ++i) { const int idx = i * 256 + lane * 4; ob[r][i] = *(const u32x2*)(outb + row * 1024 + idx); xv[r][i] = *(const f32x4*)(xin + row * 1024 + idx); }
  }
  f32x4 gq[4];
#pragma unroll
  for (int i = 0; i < 4; ++i) gq[i] = *(const f32x4*)(p.g_post + l * 1024 + i * 256 + lane * 4);
  u16* xb = (u16*)(ws_ + OFF_XB);
#pragma unroll
  for (int r = 0; r < NR; ++r) {
    const size_t row = (size_t)(row0 + r);
    const float ss = ((sq[r][0][0] + sq[r][0][1]) + (sq[r][0][2] + sq[r][0][3])) + ((sq[r][1][0] + sq[r][1][1]) + (sq[r][1][2] + sq[r][1][3]));
    const float r2 = rsqrtf(ss * (1.f / 1024.f) + 1e-6f);
    float s2 = 0.f;
#pragma unroll
    for (int i = 0; i < 4; ++i) {
      const int idx = i * 256 + lane * 4;
      const f32x4 o = {lo16(ob[r][i][0]), hi16(ob[r][i][0]), lo16(ob[r][i][1]), hi16(ob[r][i][1])};
      f32x4 xn;
#pragma unroll
      for (int e = 0; e < 4; ++e) { xn[e] = xv[r][i][e] + o[e] * r2 * gq[i][e]; s2 += xn[e] * xn[e]; }
      *(f32x4*)(p.out + row * 1024 + idx) = xn;
      if (l < 3) { u32x2 o2; o2[0] = pk2(xn[0], xn[1]); o2[1] = pk2(xn[2], xn[3]); *(u32x2*)(xb + row * 1024 + idx) = o2; }
    }
    s2 = wave_sum(s2);
    if (lane == 0) ((float*)(ws_ + OFF_RN))[row] = rsqrtf(s2 * (1.f / 1024.f) + 1e-6f);
  }
}

DI void cmp_item(const Params& p, int l, int it, char* lds) {
  char* const ws_ = opq(p.ws);
  const int j = it >> 5, mt = (it & 7) * 4 + ((it >> 3) & 3);
  const u16* proj = (const u16*)(ws_ + OFF_PROJ);
  const u16* W1 = (const u16*)(ws_ + OFF_W1) + (size_t)(l * 2 + j) * 256 * 2048;
  const u16* W2 = (const u16*)(ws_ + OFF_W2) + (size_t)(l * 2 + j) * 64 * 256;
  const float* pe = p.pe_cmp + (size_t)(l * 2 + j) * 32 * 64;
  const int kvcol = C_KCMP + 64 * j;
  f32x16 acc[2][1];
  const int tid = tidx();
  gemm_core<4, 2, 1, false>(acc, 32, [&](int i, int r0, int k) -> u32x4 { return *(const u32x4*)((W1 + i * 65536) + (unsigned)(r0 * 2048 + k)); },
   [&](int i, int row, int k) -> u32x4 {
    const int rr = mt * 32 + row, b = rr >> 7; int n = rr & 127; if (n > 126) n = 126;
    const int l32 = k >> 6, d = k & 63;
    const u32x4 raw = *(const u32x4*)(proj + ((size_t)b * S_ + 16 * n + l32) * NP + kvcol + d);
    const f32x4 e0 = *(const f32x4*)(pe + l32 * 64 + d), e1 = *(const f32x4*)(pe + l32 * 64 + d + 4);
    u32x4 o;
    o[0] = pk2(lo16(raw[0]) + e0[0], hi16(raw[0]) + e0[1]); o[1] = pk2(lo16(raw[1]) + e0[2], hi16(raw[1]) + e0[3]);
    o[2] = pk2(lo16(raw[2]) + e1[0], hi16(raw[2]) + e1[1]); o[3] = pk2(lo16(raw[3]) + e1[2], hi16(raw[3]) + e1[3]);
    return o; }, lds, tid);
  const int lane = tid & 63, wid = tid >> 6, l31 = lane & 31, hi = lane >> 5;
#pragma unroll
  for (int a = 0; a < 2; ++a)
#pragma unroll
    for (int r = 0; r < 16; ++r) {
      const float x = acc[a][0][r]; const float u = 0.7978845608028654f * (x + 0.044715f * x * x * x);
      acc[a][0][r] = x / (1.f + __expf(-2.f * u));
    }
  f32x16 c2[2];
#pragma unroll
  for (int r = 0; r < 16; ++r) { c2[0][r] = 0.f; c2[1][r] = 0.f; }
#pragma unroll
  for (int in = 0; in < 2; ++in)
#pragma unroll
    for (int s2 = 0; s2 < 2; ++s2) {
      const bf16x8 h0 = pack8(acc[in][0], s2);
#pragma unroll
      for (int dt = 0; dt < 2; ++dt) {
        const u16* wp = W2 + (size_t)(dt * 32 + l31) * 256 + wid * 64 + in * 32 + 16 * s2 + 4 * hi;
        const s16x4 lo = *(const s16x4*)wp, hh = *(const s16x4*)(wp + 8);
        const bf16x8 wf = {lo[0], lo[1], lo[2], lo[3], hh[0], hh[1], hh[2], hh[3]};
        c2[dt] = MFMA(wf, h0, c2[dt]);
      }
    }
  float* red = (float*)lds;
  __syncthreads();
  for (int w = 0; w < 4; ++w) {
    if (wid == w) {
#pragma unroll
      for (int dt = 0; dt < 2; ++dt)
#pragma unroll
        for (int r = 0; r < 16; ++r) {
          float* q = red + (dt * 32 + crow(r, hi)) * 32 + l31;
          if (w == 0) *q = c2[dt][r]; else *q += c2[dt][r];
        }
    }
    __syncthreads();
  }
  u16* kc = (u16*)(ws_ + OFF_KC); u16* vct = (u16*)(ws_ + OFF_VCT);
#pragma unroll 4
  for (int i = 0; i < 8; ++i) {
    const int e = tid + 256 * i;
    if (j == 0) { const int tok = e >> 6, d = e & 63; const int rr = mt * 32 + tok; kc[(size_t)rr * 64 + d] = f2bf(red[d * 32 + tok]); }
    else { const int d = e >> 5, tok = e & 31; const int rr = mt * 32 + tok, b = rr >> 7, n = rr & 127; vct[((size_t)b * 64 + d) * 128 + n] = f2bf(red[d * 32 + tok]); }
  }
  __syncthreads();
}

DI void win_item(const Params& p, int it, char* lds) {
  char* const ws_ = opq(p.ws);
  const int b = it & 7, qt = it >> 3, q0 = qt * 32;
  const int tid = tidx(), lane = tid & 63, h = tid >> 6, l31 = lane & 31, hi = lane >> 5;
  const u16* proj = (const u16*)(ws_ + OFF_PROJ);
  const int t = q0 + l31; const size_t tok = (size_t)b * S_ + t;
  bf16x8 qr[4];
#pragma unroll
  for (int s = 0; s < 4; ++s) qr[s] = *(const bf16x8*)(proj + tok * NP + C_AQ + h * 64 + 16 * s + 8 * hi);
  char* ldsK = lds; char* ldsV = lds + 9216;
  f32x16 o[2];
#pragma unroll
  for (int r = 0; r < 16; ++r) { o[0][r] = 0.f; o[1][r] = 0.f; }
  float m = M_INIT, lsum = 0.f;
  const int klo = (q0 - 511 > 0 ? q0 - 511 : 0) >> 6, khi = (q0 + 31) >> 6;
  __syncthreads();
  attn_stream(tid, proj, C_KWIN, C_VWIN, khi - klo + 1,
              [&](int ti, int row) { return b * S_ + (klo + ti) * 64 + row; },
              [&](int ti) { const int k0 = (klo + ti) * 64; return (k0 + 63 <= q0) && (k0 >= q0 + 31 - 511); },
              [&](int ti, int kr) { return (unsigned)(t - ((klo + ti) * 64 + kr)) <= 511u; },
              qr, o, m, lsum, lds);
  lsum += __shfl_xor(lsum, 32, 64);
  const float il = 1.f / lsum;
  u16* ow = (u16*)(ws_ + OFF_OWIN);
#pragma unroll
  for (int db = 0; db < 2; ++db)
#pragma unroll
    for (int g = 0; g < 4; ++g) {
      const int d0 = 32 * db + 8 * g + 4 * hi;
      u32x2 v; v[0] = pk2(o[db][4 * g] * il, o[db][4 * g + 1] * il); v[1] = pk2(o[db][4 * g + 2] * il, o[db][4 * g + 3] * il);
      *(u32x2*)(ow + tok * 256 + h * 64 + d0) = v;
    }
}

DI void dil_item(const Params& p, int it, char* lds) {
  char* const ws_ = opq(p.ws);
  const int di = it >> 9, rem = it & 511, b = rem & 7, h = (rem >> 3) & 3, c = rem >> 5;
  const int sh = 2 * di, dil = 1 << sh;
  const int tpr = 16 >> sh;
  const int r = c / tpr, mt = c % tpr, m0 = mt * 128;
  const int tid = tidx(), lane = tid & 63, wid = tid >> 6, l31 = lane & 31, hi = lane >> 5;
  const u16* proj = (const u16*)(ws_ + OFF_PROJ);
  const int mq = m0 + 32 * wid + l31;
  const size_t tok = (size_t)b * S_ + mq * dil + r;
  bf16x8 qr[4];
#pragma unroll
  for (int s = 0; s < 4; ++s) qr[s] = *(const bf16x8*)(proj + tok * NP + C_BQ + h * 64 + 16 * s + 8 * hi);
  const int tt0 = (m0 == 0) ? 2 : 0;
  {
    u32x4 pre[4][4];
#pragma unroll
    for (int tt = 0; tt < 4; ++tt)
      if (tt >= tt0) kv_load(tid, pre[tt], [&](int row) { return b * S_ + (m0 - 128 + 64 * tt + row) * dil + r; }, proj, C_BK + h * 64, C_BV + h * 64);
    __syncthreads();
#pragma unroll
    for (int tt = 0; tt < 4; ++tt)
      if (tt >= tt0) kv_store(tid, pre[tt], lds + tt * 18432, lds + tt * 18432 + 9216);
    __syncthreads();
  }
  f32x16 o[2];
#pragma unroll
  for (int rr = 0; rr < 16; ++rr) { o[0][rr] = 0.f; o[1][rr] = 0.f; }
  float m = M_INIT, lsum = 0.f;
  const int widu = __builtin_amdgcn_readfirstlane(wid);
  const int wlo = m0 + 32 * widu - 128, whi = m0 + 32 * widu + 31;
  for (int tt = tt0; tt < 4; ++tt) {
    const int tk0 = m0 - 128 + 64 * tt;
    if (tk0 + 63 >= wlo && tk0 <= whi) {
      attn_tile(tid, lds + tt * 18432, lds + tt * 18432 + 9216, qr, o, m, lsum, !(tk0 + 63 <= wlo + 128 && tk0 >= whi - 128), [&](int kr) { return (unsigned)(mq - (tk0 + kr)) <= 128u; });
    }
  }
  lsum += __shfl_xor(lsum, 32, 64);
  const float il = 1.f / lsum;
  u16* od = (u16*)(ws_ + OFF_ODIL) + (size_t)di * T_ * 256;
#pragma unroll
  for (int db = 0; db < 2; ++db)
#pragma unroll
    for (int g = 0; g < 4; ++g) {
      const int d0 = 32 * db + 8 * g + 4 * hi;
      u32x2 v; v[0] = pk2(o[db][4 * g] * il, o[db][4 * g + 1] * il); v[1] = pk2(o[db][4 * g + 2] * il, o[db][4 * g + 3] * il);
      *(u32x2*)(od + tok * 256 + h * 64 + d0) = v;
    }
  if (hi == 0) ((float*)(ws_ + OFF_LSE))[((size_t)di * T_ + tok) * 4 + h] = m * 0.6931471805599453f + __logf(lsum);
}

DI void pool_item(const Params& p, int l, int it, char* lds) {
  char* const ws_ = opq(p.ws);
  const int b = it & 7, qt = it >> 3, q0 = qt * 32;
  const int tid = tidx(), lane = tid & 63, g = tid >> 6, l31 = lane & 31, hi = lane >> 5;
  const u16* proj = (const u16*)(ws_ + OFF_PROJ);
  u16* cin = (u16*)lds;
  char* pl = lds + 48 * 512;
  u32x4 cv[6];
#pragma unroll
  for (int i = 0; i < 6; ++i) {
    const int c = tid + 256 * i, row = c >> 5, ch = c & 31; const int t = q0 - 16 + row;
    cv[i] = u32x4{0u, 0u, 0u, 0u};
    if (t >= 0) cv[i] = *(const u32x4*)(proj + ((size_t)b * S_ + t) * NP + C_CIN + ch * 8);
  }
  const u16* wpt = (const u16*)(ws_ + OFF_WPT) + (size_t)(l * 4 + g) * 4096;
  bf16x8 af[8];
#pragma unroll
  for (int q = 0; q < 8; ++q) af[q] = *(const bf16x8*)(wpt + ((q & 1) * 32 + l31) * 64 + 16 * (q >> 1) + 8 * hi);
  const size_t tok = (size_t)b * S_ + q0 + l31;
  f32x4 psv[8]; u32x2 zv[8];
#pragma unroll
  for (int q = 0; q < 8; ++q) {
    const int col = g * 64 + (q >> 2) * 32 + 8 * (q & 3) + 4 * hi;
    psv[q] = *(const f32x4*)(p.pool_scale + l * 256 + col); zv[q] = *(const u32x2*)(proj + tok * NP + C_CZ + col);
  }
  __syncthreads();
#pragma unroll
  for (int i = 0; i < 6; ++i) { const int c = tid + 256 * i, row = c >> 5, ch = c & 31; *(u32x4*)(cin + row * 256 + ch * 8) = cv[i]; }
  __syncthreads();
  {
    const int ch = tid, w = 2 << g;
    float s = 0.f;
    for (int r = 17 - w; r <= 16; ++r) s += bf2f(cin[r * 256 + ch]);
#pragma unroll 4
    for (int i = 0; i < 32; ++i) {
      const int t = q0 + i; const int cnt = (t + 1 < w) ? t + 1 : w;
      const float self = bf2f(cin[(i + 16) * 256 + ch]);
      *(u16*)(pl + i * 528 + ch * 2) = f2bf(s / (float)cnt - self);
      s += bf2f(cin[(i + 17) * 256 + ch]) - bf2f(cin[(i + 17 - w) * 256 + ch]);
    }
  }
  __syncthreads();
  f32x16 acc[2];
#pragma unroll
  for (int r = 0; r < 16; ++r) { acc[0][r] = 0.f; acc[1][r] = 0.f; }
#pragma unroll
  for (int s4 = 0; s4 < 4; ++s4) {
    const bf16x8 bf = *(const bf16x8*)(pl + l31 * 528 + (g * 64 + 16 * s4 + 8 * hi) * 2);
#pragma unroll
    for (int dt = 0; dt < 2; ++dt) acc[dt] = MFMA(af[s4 * 2 + dt], bf, acc[dt]);
  }
  u16* y = (u16*)(ws_ + OFF_XB);
#pragma unroll
  for (int dt = 0; dt < 2; ++dt)
#pragma unroll
    for (int g4 = 0; g4 < 4; ++g4) {
      const int col = g * 64 + dt * 32 + 8 * g4 + 4 * hi;
      const f32x4 ps = psv[dt * 4 + g4];
      const u32x2 z = zv[dt * 4 + g4];
      u32x2 v;
      v[0] = pk2(acc[dt][4 * g4] * ps[0] * siluf_(lo16(z[0])), acc[dt][4 * g4 + 1] * ps[1] * siluf_(hi16(z[0])));
      v[1] = pk2(acc[dt][4 * g4 + 2] * ps[2] * siluf_(lo16(z[1])), acc[dt][4 * g4 + 3] * ps[3] * siluf_(hi16(z[1])));
      *(u32x2*)(y + tok * 1024 + 512 + col) = v;
    }
}

DI void sgu_item(const Params& p, int l, int it, char* lds) {
  char* const ws_ = opq(p.ws);
  const int b = it & 7, c = (it >> 5) & 15, g = (it >> 3) & 3, t0 = c * 128;
  const int tid = tidx(), lane = tid & 63, l31 = lane & 31, hi = lane >> 5;
  const int wid = __builtin_amdgcn_readfirstlane(tid >> 6);
  const u16* proj = (const u16*)(ws_ + OFF_PROJ);
  char* vn = lds;
  __syncthreads();
  {
    const int j = tid >> 1, half = tid & 1;
    const u16* vp = proj + ((size_t)b * S_ + t0 + j) * NP + C_DV + half * 128;
    u32x4 raw[16];
#pragma unroll
    for (int i = 0; i < 16; ++i) raw[i] = *(const u32x4*)(vp + i * 8);
    float s1 = 0.f;
#pragma unroll
    for (int i = 0; i < 16; ++i)
#pragma unroll
      for (int e = 0; e < 4; ++e) s1 += lo16(raw[i][e]) + hi16(raw[i][e]);
    s1 += __shfl_xor(s1, 1, 64);
    const float mu = s1 * (1.f / 256.f);
    float s2 = 0.f;
#pragma unroll
    for (int i = 0; i < 16; ++i)
#pragma unroll
      for (int e = 0; e < 4; ++e) { const float a = lo16(raw[i][e]) - mu, bb = hi16(raw[i][e]) - mu; s2 += a * a + bb * bb; }
    s2 += __shfl_xor(s2, 1, 64);
    const float rstd = rsqrtf(s2 * (1.f / 256.f) + 1e-5f);
    if (half == (g >> 1)) {
      const float* lg = p.sg_ln_g + l * 256 + g * 64; const float* lb = p.sg_ln_b + l * 256 + g * 64;
      auto emit = [&](const u32x4& r, int i) {
        const f32x4 g0 = *(const f32x4*)(lg + i * 8), g1 = *(const f32x4*)(lg + i * 8 + 4), b0 = *(const f32x4*)(lb + i * 8), b1 = *(const f32x4*)(lb + i * 8 + 4);
        u32x4 o;
        o[0] = pk2((lo16(r[0]) - mu) * rstd * g0[0] + b0[0], (hi16(r[0]) - mu) * rstd * g0[1] + b0[1]);
        o[1] = pk2((lo16(r[1]) - mu) * rstd * g0[2] + b0[2], (hi16(r[1]) - mu) * rstd * g0[3] + b0[3]);
        o[2] = pk2((lo16(r[2]) - mu) * rstd * g1[0] + b1[0], (hi16(r[2]) - mu) * rstd * g1[1] + b1[1]);
        o[3] = pk2((lo16(r[3]) - mu) * rstd * g1[2] + b1[2], (hi16(r[3]) - mu) * rstd * g1[3] + b1[3]);
        *(u32x4*)(vn + j * 144 + i * 16) = o;
      };
      if (g & 1) {
#pragma unroll
        for (int i = 0; i < 8; ++i) emit(raw[8 + i], i);
      } else {
#pragma unroll
        for (int i = 0; i < 8; ++i) emit(raw[i], i);
      }
    }
  }
  __syncthreads();
  const int i = wid * 32 + l31;
  const u16* wsp = (const u16*)(ws_ + OFF_WSP) + ((size_t)(l * 4 + g) * 128 + i) * 128;
  f32x16 acc[2];
#pragma unroll
  for (int r = 0; r < 16; ++r) { acc[0][r] = 0.f; acc[1][r] = 0.f; }
  const int nks = 2 * (wid + 1);
  bf16x8 wfr[8];
#pragma unroll
  for (int s = 0; s < 8; ++s) { if (s < nks) wfr[s] = *(const bf16x8*)(wsp + 16 * s + 8 * hi); else wfr[s] = bf16x8{0, 0, 0, 0, 0, 0, 0, 0}; }
  const char* vb = vn + (8 * hi + ((lane & 15) >> 2)) * 144 + ((lane >> 4) & 1) * 32 + (lane & 3) * 8;
#pragma unroll
  for (int s = 0; s < 8; ++s) {
    if (s < nks) {
#pragma unroll
      for (int ct = 0; ct < 2; ++ct) {
        const s16x4 lo = trread(vb + (16 * s) * 144 + ct * 64), hh = trread(vb + (16 * s + 4) * 144 + ct * 64);
        const bf16x8 af = {lo[0], lo[1], lo[2], lo[3], hh[0], hh[1], hh[2], hh[3]};
        acc[ct] = MFMA(af, wfr[s], acc[ct]);
      }
    }
  }
  const size_t tok = (size_t)b * S_ + t0 + i;
  const float bs = p.b_sp[(l * 4 + g) * 128 + i];
  u16* y = (u16*)(ws_ + OFF_XB);
#pragma unroll
  for (int ct = 0; ct < 2; ++ct)
#pragma unroll
    for (int g4 = 0; g4 < 4; ++g4) {
      const int col = g * 64 + ct * 32 + 8 * g4 + 4 * hi;
      const u32x2 u = *(const u32x2*)(proj + tok * NP + C_DU + col), z = *(const u32x2*)(proj + tok * NP + C_DZ + col);
      u32x2 v;
      v[0] = pk2(lo16(u[0]) * (acc[ct][4 * g4] + bs) * siluf_(lo16(z[0])), hi16(u[0]) * (acc[ct][4 * g4 + 1] + bs) * siluf_(hi16(z[0])));
      v[1] = pk2(lo16(u[1]) * (acc[ct][4 * g4 + 2] + bs) * siluf_(lo16(z[1])), hi16(u[1]) * (acc[ct][4 * g4 + 3] + bs) * siluf_(hi16(z[1])));
      *(u32x2*)(y + tok * 1024 + 768 + col) = v;
    }
}

DI void nsa_item(const Params& p, int it, char* lds) {
  char* const ws_ = opq(p.ws);
  const int b = it & 7, qt = 63 - (it >> 3), q0 = qt * 32;
  const int tid = tidx(), lane = tid & 63, h = tid >> 6, l31 = lane & 31, hi = lane >> 5;
  const u16* proj = (const u16*)(ws_ + OFF_PROJ);
  const int t = q0 + l31; const size_t tok = (size_t)b * S_ + t;
  bf16x8 qr[4];
#pragma unroll
  for (int s = 0; s < 4; ++s) qr[s] = *(const bf16x8*)(proj + tok * NP + C_AQ + h * 64 + 16 * s + 8 * hi);
  char* ldsK = lds; char* ldsV = lds + 9216;
  float* impS = (float*)(lds + 36864);
  float* vals = (float*)(lds + 36864 + 16384);
  unsigned* selm = (unsigned*)(lds + 73728 - 256);
  int* jlist = (int*)(lds + 73728 - 128);
  float* yst = (float*)(lds + 36864);
  __syncthreads();
  if (tid < 32) selm[tid] = 0u;
  const float g0 = sigmoidf_(bf2f(proj[tok * NP + C_AG + 0 + h])), g1 = sigmoidf_(bf2f(proj[tok * NP + C_AG + 4 + h])), g2 = sigmoidf_(bf2f(proj[tok * NP + C_AG + 8 + h]));
  f32x16 ya[2];
  {
    const u16* kc = (const u16*)(ws_ + OFF_KC); const u16* vct = (const u16*)(ws_ + OFF_VCT);
    f32x16 sc[4];
    const int nkb = (((q0 + 31 - 31) >> 4) >> 5) + 1;
#pragma unroll
    for (int kb = 0; kb < 4; ++kb) {
#pragma unroll
      for (int r = 0; r < 16; ++r) sc[kb][r] = 0.f;
      if (kb < nkb) {
#pragma unroll
        for (int s = 0; s < 4; ++s) {
          const bf16x8 kf = *(const bf16x8*)(kc + ((size_t)(b * 128 + kb * 32 + l31)) * 64 + 16 * s + 8 * hi);
          sc[kb] = MFMA(kf, qr[s], sc[kb]);
        }
      }
    }
    s16x4 vcl[16], vch[16];
#pragma unroll
    for (int q = 0; q < 16; ++q) {
      const int kb = q >> 2, s2 = (q >> 1) & 1, db = q & 1;
      const u16* vp = vct + ((size_t)(b * 64 + 32 * db + l31)) * 128 + 32 * kb + 16 * s2 + 4 * hi;
      vcl[q] = s16x4{0, 0, 0, 0}; vch[q] = s16x4{0, 0, 0, 0};
      if (kb < nkb) { vcl[q] = *(const s16x4*)vp; vch[q] = *(const s16x4*)(vp + 8); }
    }
    const int nv = (t >= 31) ? ((t - 31) >> 4) : -1;
    float mx = NEGB;
#pragma unroll
    for (int kb = 0; kb < 4; ++kb)
#pragma unroll
      for (int r = 0; r < 16; ++r) { const int n = 32 * kb + crow(r, hi); const float v = (n <= nv) ? sc[kb][r] * C2 : NEGB; sc[kb][r] = v; mx = fmaxf(mx, v); }
    mx = fmaxf(mx, __shfl_xor(mx, 32, 64));
    float sum = 0.f;
#pragma unroll
    for (int kb = 0; kb < 4; ++kb)
#pragma unroll
      for (int r = 0; r < 16; ++r) { const int n = 32 * kb + crow(r, hi); const float e = (n <= nv) ? ex2(sc[kb][r] - mx) : 0.f; sc[kb][r] = e; sum += e; }
    sum += __shfl_xor(sum, 32, 64);
    const float inv = sum > 0.f ? 1.f / sum : 0.f;
#pragma unroll
    for (int kb = 0; kb < 4; ++kb)
#pragma unroll
      for (int r = 0; r < 16; ++r) sc[kb][r] *= inv;
    float* myimp = impS + (h * 32 + l31) * 32;
#pragma unroll
    for (int kb = 0; kb < 4; ++kb)
#pragma unroll
      for (int g = 0; g < 4; ++g) myimp[8 * kb + 2 * g + hi] = ((sc[kb][4 * g] + sc[kb][4 * g + 1]) + sc[kb][4 * g + 2]) + sc[kb][4 * g + 3];
    __syncthreads();
#pragma unroll
    for (int kb = 0; kb < 4; ++kb)
#pragma unroll
      for (int g = 0; g < 4; ++g) { const int j1 = 8 * kb + 2 * g + hi + 1; if (j1 < 32) myimp[j1] += sc[kb][4 * g + 3]; }
    f32x16 oc[2];
#pragma unroll
    for (int r = 0; r < 16; ++r) { oc[0][r] = 0.f; oc[1][r] = 0.f; }
#pragma unroll
    for (int kb = 0; kb < 4; ++kb)
#pragma unroll
      for (int s2 = 0; s2 < 2; ++s2) {
        if (kb >= nkb) continue;
        const bf16x8 pf = pack8(sc[kb], s2);
#pragma unroll
        for (int db = 0; db < 2; ++db) {
          const s16x4 lo = vcl[(kb * 2 + s2) * 2 + db], hh = vch[(kb * 2 + s2) * 2 + db];
          const bf16x8 vf = {lo[0], lo[1], lo[2], lo[3], hh[0], hh[1], hh[2], hh[3]};
          oc[db] = MFMA(vf, pf, oc[db]);
        }
      }
#pragma unroll
    for (int r = 0; r < 16; ++r) { ya[0][r] = oc[0][r] * g0; ya[1][r] = oc[1][r] * g0; }
  }
  __syncthreads();
  const int cur = q0 >> 6;
  {
    const int q = tid >> 3, sub = tid & 7;
#pragma unroll
    for (int jj = 0; jj < 4; ++jj) {
      const int j = sub * 4 + jj;
      float v = ((impS[(0 * 32 + q) * 32 + j] + impS[(1 * 32 + q) * 32 + j]) + impS[(2 * 32 + q) * 32 + j]) + impS[(3 * 32 + q) * 32 + j];
      const bool forced = (j == 0) || (j == cur) || (j == cur - 1);
      v = forced ? 1e4f : ((j <= cur) ? v : -1e4f);
      vals[q * 32 + j] = v;
    }
    __syncthreads();
    f32x4 vv[8];
#pragma unroll
    for (int i = 0; i < 8; ++i) vv[i] = *(const f32x4*)(vals + q * 32 + i * 4);
    unsigned bits = 0u;
#pragma unroll
    for (int jj = 0; jj < 4; ++jj) {
      const int j = sub * 4 + jj; const float v = vals[q * 32 + j];
      int cnt = 0;
#pragma unroll
      for (int j2 = 0; j2 < 32; ++j2) { const float w = vv[j2 >> 2][j2 & 3]; cnt += ((w > v) || (w == v && j2 < j)) ? 1 : 0; }
      if (cnt < 16 && j <= cur) bits |= 1u << j;
    }
    if (bits) atomicOr(&selm[q], bits);
  }
  __syncthreads();
  const unsigned mymask = selm[l31];
  unsigned anym = mymask, allm = mymask;
#pragma unroll
  for (int o = 16; o >= 1; o >>= 1) { anym |= (unsigned)__shfl_xor((int)anym, o, 64); allm &= (unsigned)__shfl_xor((int)allm, o, 64); }
  anym = __builtin_amdgcn_readfirstlane(anym);
  allm = __builtin_amdgcn_readfirstlane(allm);
  if (tid < 32) { if ((anym >> tid) & 1u) jlist[__builtin_popcount(anym & ((1u << tid) - 1u))] = tid; }
  f32x16 o[2];
#pragma unroll
  for (int r = 0; r < 16; ++r) { o[0][r] = 0.f; o[1][r] = 0.f; }
  float m = M_INIT, lsum = 0.f;
#pragma unroll
  for (int r = 0; r < 16; ++r) { yst[r * 256 + tid] = ya[0][r]; yst[(16 + r) * 256 + tid] = ya[1][r]; }
  __syncthreads();
  attn_stream(tid, proj, C_KSLC, C_VSLC, __builtin_popcount(anym),
              [&](int ti, int row) { return b * S_ + jlist[ti] * 64 + row; },
              [&](int ti) { const int jb = jlist[ti]; return (jb < cur) && ((allm >> jb) & 1u); },
              [&](int ti, int kr) { const int jb = jlist[ti]; return ((mymask >> jb) & 1u) && (jb * 64 + kr <= t); },
              qr, o, m, lsum, lds);
#pragma unroll
  for (int r = 0; r < 16; ++r) { ya[0][r] = yst[r * 256 + tid]; ya[1][r] = yst[(16 + r) * 256 + tid]; }
  lsum += __shfl_xor(lsum, 32, 64);
  const float il = g1 / lsum;
  const u16* ow = (const u16*)(ws_ + OFF_OWIN);
  u16* y = (u16*)(ws_ + OFF_XB);
#pragma unroll
  for (int db = 0; db < 2; ++db)
#pragma unroll
    for (int g = 0; g < 4; ++g) {
      const int col = h * 64 + 32 * db + 8 * g + 4 * hi;
      const u32x2 w = *(const u32x2*)(ow + tok * 256 + col), az = *(const u32x2*)(proj + tok * NP + C_AZ + col);
      const float v0 = (ya[db][4 * g] + o[db][4 * g] * il + g2 * lo16(w[0])) * siluf_(lo16(az[0]));
      const float v1 = (ya[db][4 * g + 1] + o[db][4 * g + 1] * il + g2 * hi16(w[0])) * siluf_(hi16(az[0]));
      const float v2 = (ya[db][4 * g + 2] + o[db][4 * g + 2] * il + g2 * lo16(w[1])) * siluf_(lo16(az[1]));
      const float v3 = (ya[db][4 * g + 3] + o[db][4 * g + 3] * il + g2 * hi16(w[1])) * siluf_(hi16(az[1]));
      u32x2 v; v[0] = pk2(v0, v1); v[1] = pk2(v2, v3);
      *(u32x2*)(y + tok * 1024 + col) = v;
    }
}

DI void dilcomb_item(const Params& p, int it) {
  char* const ws_ = opq(p.ws);
  const u16* proj = (const u16*)(ws_ + OFF_PROJ);
  const u16* od = (const u16*)(ws_ + OFF_ODIL);
  const float* lse = (const float*)(ws_ + OFF_LSE);
  u16* y = (u16*)(ws_ + OFF_XB);
#pragma unroll
  for (int i = 0; i < 4; ++i) {
    const int idx = it * 1024 + i * 256 + threadIdx.x;
    const size_t tok = idx >> 5; const int c8 = idx & 31, h = c8 >> 3;
    const float l0 = lse[((size_t)0 * T_ + tok) * 4 + h], l1 = lse[((size_t)1 * T_ + tok) * 4 + h], l2 = lse[((size_t)2 * T_ + tok) * 4 + h];
    const float mx = fmaxf(l0, fmaxf(l1, l2));
    float w0 = __expf(l0 - mx), w1 = __expf(l1 - mx), w2 = __expf(l2 - mx);
    const float iw = 1.f / (w0 + w1 + w2); w0 *= iw; w1 *= iw; w2 *= iw;
    const u32x4 a = *(const u32x4*)(od + ((size_t)0 * T_ + tok) * 256 + c8 * 8), bq = *(const u32x4*)(od + ((size_t)1 * T_ + tok) * 256 + c8 * 8), cq = *(const u32x4*)(od + ((size_t)2 * T_ + tok) * 256 + c8 * 8);
    const u32x4 z = *(const u32x4*)(proj + tok * NP + C_BZ + c8 * 8);
    u32x4 r;
#pragma unroll
    for (int e = 0; e < 4; ++e) {
      const float v0 = (w0 * lo16(a[e]) + w1 * lo16(bq[e]) + w2 * lo16(cq[e])) * siluf_(lo16(z[e]));
      const float v1 = (w0 * hi16(a[e]) + w1 * hi16(bq[e]) + w2 * hi16(cq[e])) * siluf_(hi16(z[e]));
      r[e] = pk2(v0, v1);
    }
    *(u32x4*)(y + tok * 1024 + 256 + c8 * 8) = r;
  }
}

__global__ void __launch_bounds__(256, 2) hybrid_megakernel(Params p) {
  __shared__ __attribute__((aligned(16))) char lds[73728];
  __shared__ uint4 xb_words;
  __shared__ uint4 xg_words;
  cg::grid_group grid = cg::this_grid();
  char* const ws_ = p.ws;
  if (p.ws == nullptr) grid.sync();
  if (threadIdx.x == 0) { xb_words = make_uint4(0u, 0u, 0u, 0u); xg_words = make_uint4(0u, 0u, 0u, 0u); }
  __syncthreads();
  const XcdBarrier xb = xcd_barrier_post((unsigned*)(ws_ + OFF_BAR), (volatile LAS unsigned*)&xb_words, gridDim.x);
  const bool grp = (gridDim.x % 8u) == 0u;
  const XcdBarrier xg = grp ? xcd_barrier_post((unsigned*)(ws_ + OFF_BAR) + (1 + (blockIdx.x & 7)) * 4096, (volatile LAS unsigned*)&xg_words, gridDim.x / 8u) : xb;
  const int nb = gridDim.x, bid = blockIdx.x;
  const int wid = threadIdx.x >> 6;
  for (int it = bid; it < 3328 + 1024 + 1024 + 32 + 16 + 64; it += nb) {
    if (it < 3328) { const int l = it / 832, r = it % 832, ntile = r >> 4, ktile = r & 15;
      tr_tile(p.w_in + (size_t)l * 1024 * 3212, 3212, (u16*)(ws_ + OFF_WIN) + (size_t)l * NP * 1024, 1024, ktile * 64, ntile * 64, p.g_pre + l * 1024, 1, lds); }
    else if (it < 4352) { const int i2 = it - 3328, l = i2 >> 8, r = i2 & 255, ntile = r >> 4, ktile = r & 15;
      tr_tile(p.w_out + (size_t)l * 1024 * 1024, 1024, (u16*)(ws_ + OFF_WOUT) + (size_t)l * 1024 * 1024, 1024, ktile * 64, ntile * 64, nullptr, 0, lds); }
    else if (it < 5376) { const int i2 = it - 4352, mtx = i2 >> 7, r = i2 & 127, ntile = r >> 5, ktile = r & 31;
      tr_tile(p.w_cmp1 + (size_t)mtx * 2048 * 256, 256, (u16*)(ws_ + OFF_W1) + (size_t)mtx * 256 * 2048, 2048, ktile * 64, ntile * 64, nullptr, 0, lds); }
    else if (it < 5408) { const int i2 = it - 5376, mtx = i2 >> 2, ktile = i2 & 3;
      tr_tile(p.w_cmp2 + (size_t)mtx * 256 * 64, 64, (u16*)(ws_ + OFF_W2) + (size_t)mtx * 64 * 256, 256, ktile * 64, 0, nullptr, 0, lds); }
    else if (it < 5424) { const int mtx = it - 5408;
      tr_tile(p.w_pool + (size_t)mtx * 4096, 64, (u16*)(ws_ + OFF_WPT) + (size_t)mtx * 4096, 64, 0, 0, nullptr, 0, lds); }
    else { const int i2 = it - 5424, mtx = i2 >> 2, qd = i2 & 3;
      const float* src = p.w_sp + (size_t)mtx * 16384 + qd * 4096; u16* dst = (u16*)(ws_ + OFF_WSP) + (size_t)mtx * 16384 + qd * 4096;
      f32x4 v[4];
#pragma unroll
      for (int k = 0; k < 4; ++k) v[k] = *(const f32x4*)(src + (threadIdx.x + 256 * k) * 4);
#pragma unroll
      for (int k = 0; k < 4; ++k) {
        const int e = qd * 4096 + (threadIdx.x + 256 * k) * 4, i = e >> 7, j = e & 127;
        u32x2 o; o[0] = pk2(j <= i ? v[k][0] : 0.f, j + 1 <= i ? v[k][1] : 0.f); o[1] = pk2(j + 2 <= i ? v[k][2] : 0.f, j + 3 <= i ? v[k][3] : 0.f);
        *(u32x2*)(dst + (threadIdx.x + 256 * k) * 4) = o;
      } }
  }
  for (int it = bid; it < T_ / 32; it += nb) {
    const int row = it * 32 + wid * 8;
    rows_convert<8>(p.x + (size_t)row * 1024, (u16*)(ws_ + OFF_XB) + (size_t)row * 1024, (float*)(ws_ + OFF_RN) + row);
  }
  xcd_barrier(xb);
  for (int l = 0; l < 4; ++l) {
    for (int it = bid; it < 1024; it += nb) { const int q = it >> 3; inproj_tile<4>(p, l, (it & 7) * 16 + (q & 15), q >> 4, lds); }
    xcd_barrier(xg);
    for (int vb = bid; vb < 512; vb += nb) {
      { const int q2 = vb >> 3; inproj_tile<4>(p, l, (vb & 7) * 16 + (q2 & 15), 8 + (q2 >> 4), lds); }
      if (vb < 64) cmp_item(p, l, vb, lds);
      else {
        const int j = vb - 64;
        if (vb >= 256) { const int i2 = (vb - 256) >> 3; inproj_tile<2>(p, l, (vb & 7) * 16 + (i2 & 15), 24 + (i2 >> 4), lds); }
        win_item(p, j, lds);
        if (j + 448 < 512) win_item(p, j + 448, lds);
        for (int it = j; it < 1536; it += 448) dil_item(p, it, lds);
      }
    }
    xcd_barrier(xg);
    for (int vb = bid; vb < 512; vb += nb) {
      nsa_item(p, vb, lds);
      const int gi = vb >> 4;
      int start = 0, mine = 0;
      for (int g2 = 0; g2 <= gi; ++g2) {
        const int n = 32 - g2;
        const int d = (n <= 10) ? 2 : (n <= 22) ? 1 : 0;
        if (g2 < gi) start += 2 * d; else mine = d;
      }
      start += ((vb >> 3) & 1) * mine;
      const int x = vb & 7;
      for (int k = 0; k < mine; ++k) { const int slot = start + k; sgu_item(p, l, slot * 8 + x, lds); pool_item(p, l, slot * 8 + x, lds); dilcomb_item(p, x * 64 + slot); }
    }
    xcd_barrier(xg);
    for (int it = bid; it < 512; it += nb) outproj_item(p, l, it, lds);
    xcd_barrier(xg);
    const float* xin = (l == 0) ? p.x : p.out;
    for (int vb = bid; vb < 512; vb += nb)
      for (int j = vb >> 3; j < 128; j += 64) resid_rows<4>(p, l, (vb & 7) * 2048 + j * 16 + wid * 4, xin);
    if (l < 3) xcd_barrier(xg);
  }
}

extern "C" void kernel_launch(void* const* d_in, const int* in_sizes, int n_in, void* d_out, int out_size, void* d_ws, size_t ws_size, hipStream_t stream) {
  static int grid_blocks = 0;
  if (!grid_blocks) {
    int dev = 0, cus = 0, per_cu = 0;
    hipGetDevice(&dev);
    hipDeviceGetAttribute(&cus, hipDeviceAttributeMultiprocessorCount, dev);
    hipOccupancyMaxActiveBlocksPerMultiprocessor(&per_cu, hybrid_megakernel, 256, 0);
    if (per_cu > 2) per_cu = 2;
    if (per_cu < 1) per_cu = 1;
    grid_blocks = cus * per_cu;
  }
  if (ws_size < WS_TOTAL) { fprintf(stderr, "workspace too small: %zu < %zu\n", ws_size, (size_t)WS_TOTAL); return; }
  Params p{};
  p.x = (const float*)d_in[0]; p.g_pre = (const float*)d_in[1]; p.w_in = (const float*)d_in[2]; p.pe_cmp = (const float*)d_in[3];
  p.w_cmp1 = (const float*)d_in[4]; p.w_cmp2 = (const float*)d_in[5]; p.w_pool = (const float*)d_in[6]; p.pool_scale = (const float*)d_in[7];
  p.sg_ln_g = (const float*)d_in[8]; p.sg_ln_b = (const float*)d_in[9]; p.w_sp = (const float*)d_in[10]; p.b_sp = (const float*)d_in[11];
  p.w_out = (const float*)d_in[12]; p.g_post = (const float*)d_in[13];
  p.out = (float*)d_out; p.ws = (char*)d_ws;
  hipMemsetAsync((char*)d_ws + OFF_BAR, 0, 9 * 16384, stream);
  void* args[] = {&p};
  hipError_t e = hipLaunchCooperativeKernel((void*)hybrid_megakernel, dim3(grid_blocks), dim3(256), args, 0, stream);
  if (e != hipSuccess) fprintf(stderr, "cooperative launch failed: %s (grid %d)\n", hipGetErrorString(e), grid_blocks);
}
```
